# Optimizing an MI355X kernel written in HIP

```python
import jax, jax.numpy as jnp
from jax import lax
import numpy as np

D_MODEL = 1024
BATCH = 32
SEQ = 2048
DEPTH = 1
DEC_BATCH = 32
DEC_SEQ = 64
PAST_LEN = 1024

CHUNK = 64
N_META = 16
D_MIX = D_MODEL
D_GLA = D_MIX // 2
N_GLA_HEADS = 4
GLA_DV = D_GLA // N_GLA_HEADS
GLA_DK = GLA_DV // 2
D_GLA_K = N_GLA_HEADS * GLA_DK
GATE_RANK = 16
GATE_TAU = 16.0
D_CONV = D_MIX - D_GLA
CONV_W = 3
D_FF = 2816
EPS = 1e-6

SPLIT_POINTS = (
    D_GLA_K,
    2 * D_GLA_K,
    2 * D_GLA_K + D_GLA,
    2 * D_GLA_K + 2 * D_GLA,
    2 * D_GLA_K + 2 * D_GLA + GATE_RANK,
    2 * D_GLA_K + 2 * D_GLA + GATE_RANK + D_CONV,
    2 * D_GLA_K + 2 * D_GLA + GATE_RANK + 2 * D_CONV,
)
D_IN = 2 * D_GLA_K + 2 * D_GLA + GATE_RANK + 3 * D_CONV

kernel_name = 'hymba_gla_shortconv_macaron_stream_step'


def rms_norm(x, g):
    xf = x.astype(jnp.float32)
    y = xf * lax.rsqrt(jnp.mean(xf * xf, axis=-1, keepdims=True) + EPS)
    return (y * g.astype(jnp.float32)).astype(x.dtype)


def swiglu_ffn(x, w_up, w_down):
    gate, up = jnp.split(x @ w_up, 2, axis=-1)
    return (jax.nn.silu(gate) * up) @ w_down


def gla_blocked(q, k, v, log_a, s0, block):
    b, l, h, _ = q.shape
    dv = v.shape[-1]
    n = l // block

    def to_blocks(t):
        return jnp.moveaxis(t.reshape(b, n, block, h, t.shape[-1]), 1, 0)

    causal = jnp.tril(jnp.ones((block, block), dtype=bool))[None, :, :, None, None]

    def step(s, inp):
        qc, kc, vc, lc = inp
        g = jnp.cumsum(lc, axis=1)
        g_last = g[:, -1]
        diff = jnp.where(causal, g[:, :, None] - g[:, None, :], -jnp.inf)
        att = jnp.einsum('bihd,bjhd,bijhd->bijh', qc, kc, jnp.exp(diff))
        o_intra = jnp.einsum('bijh,bjhv->bihv', att, vc)
        o_inter = jnp.einsum('bihk,bhkv->bihv', qc * jnp.exp(g), s)
        s_new = jnp.exp(g_last)[..., None] * s + jnp.einsum(
            'bjhk,bjhv->bhkv', kc * jnp.exp(g_last[:, None] - g), vc)
        return s_new, o_intra + o_inter

    s_fin, o = lax.scan(step, s0, (to_blocks(q), to_blocks(k), to_blocks(v), to_blocks(log_a)))
    return jnp.moveaxis(o, 0, 1).reshape(b, l, h, dv), s_fin


def token_mix(h, s_gla, conv_buf, w_in, w_a2, b_a, g_head, w_conv, w_out):
    b, l, _ = h.shape
    f32 = jnp.float32
    q, k, v, r, a_lr, gate_b, gate_c, hc = jnp.split(h @ w_in, SPLIT_POINTS, axis=-1)

    log_a = jax.nn.log_sigmoid((a_lr @ w_a2 + b_a).astype(f32)) / GATE_TAU
    qh = q.astype(f32).reshape(b, l, N_GLA_HEADS, GLA_DK) * GLA_DK ** -0.5
    kh = k.astype(f32).reshape(b, l, N_GLA_HEADS, GLA_DK)
    vh = v.astype(f32).reshape(b, l, N_GLA_HEADS, GLA_DV)
    lah = log_a.reshape(b, l, N_GLA_HEADS, GLA_DK)
    pad = (-l) % CHUNK
    front = lambda t: jnp.pad(t, ((0, 0), (pad, 0), (0, 0), (0, 0)))
    o, s_new = gla_blocked(front(qh), front(kh), front(vh), front(lah), s_gla.astype(f32), CHUNK)
    o = o[:, pad:]
    o = o * lax.rsqrt(jnp.mean(o * o, axis=-1, keepdims=True) + EPS) * g_head.astype(f32)
    o_gla = (o.reshape(b, l, D_GLA) * jax.nn.silu(r.astype(f32))).astype(h.dtype)

    u = gate_c * hc
    u_ext = jnp.concatenate([conv_buf.astype(u.dtype), u], axis=1)
    conv = sum(w_conv[i] * u_ext[:, i:i + l] for i in range(CONV_W))
    o_conv = gate_b * conv
    new_buf = u_ext[:, -(CONV_W - 1):]

    y = jnp.concatenate([o_gla, o_conv], axis=-1) @ w_out
    return y, s_new, new_buf


def layer(x, s_gla, conv_buf, n1, wu1, wd1, n2, w_in, w_a2, b_a, g_head, w_conv, w_out, n3, wu2, wd2):
    x = x + 0.5 * swiglu_ffn(rms_norm(x, n1), wu1, wd1)
    y, s_new, c_new = token_mix(rms_norm(x, n2), s_gla, conv_buf, w_in, w_a2, b_a, g_head, w_conv, w_out)
    x = x + y
    x = x + 0.5 * swiglu_ffn(rms_norm(x, n3), wu2, wd2)
    return x, s_new, c_new


def setup_inputs(seed: int = 0) -> dict:
    key = jax.random.key(seed)
    ks = jax.random.split(key, 20)
    f32 = jnp.float32
    nrm = lambda kk, shape, scale: jax.random.normal(kk, shape, f32) * scale
    gain = lambda kk, shape: 1.0 + 0.01 * jax.random.normal(kk, shape, f32)
    return {
        'x_prompt': nrm(ks[0], (BATCH, SEQ, D_MODEL), 1.0),
        'x_sample': nrm(ks[1], (DEC_BATCH, DEC_SEQ, D_MODEL), 1.0),
        'state_gla': nrm(ks[2], (DEPTH, DEC_BATCH, N_GLA_HEADS, GLA_DK, GLA_DV), 1.0),
        'cache_conv': nrm(ks[3], (DEPTH, DEC_BATCH, CONV_W - 1, D_CONV), 1.0),
        'meta': nrm(ks[4], (N_META, D_MODEL), 1.0),
        'norm_ffn1': gain(ks[5], (DEPTH, D_MODEL)),
        'w_up1': nrm(ks[6], (DEPTH, D_MODEL, 2 * D_FF), D_MODEL ** -0.5),
        'w_down1': nrm(ks[7], (DEPTH, D_FF, D_MODEL), D_FF ** -0.5),
        'norm_mix': gain(ks[8], (DEPTH, D_MODEL)),
        'w_in': nrm(ks[9], (DEPTH, D_MODEL, D_IN), D_MODEL ** -0.5),
        'w_a2': nrm(ks[10], (DEPTH, GATE_RANK, D_GLA_K), GATE_RANK ** -0.5),
        'b_a': nrm(ks[11], (DEPTH, D_GLA_K), 0.1),
        'g_head': gain(ks[12], (DEPTH, GLA_DV)),
        'w_conv': nrm(ks[13], (DEPTH, CONV_W, D_CONV), CONV_W ** -0.5),
        'w_out': nrm(ks[14], (DEPTH, D_MIX, D_MODEL), D_MIX ** -0.5),
        'norm_ffn2': gain(ks[15], (DEPTH, D_MODEL)),
        'w_up2': nrm(ks[16], (DEPTH, D_MODEL, 2 * D_FF), D_MODEL ** -0.5),
        'w_down2': nrm(ks[17], (DEPTH, D_FF, D_MODEL), D_FF ** -0.5),
        'norm_final': gain(ks[18], (D_MODEL,)),
    }


def reference(x_prompt, x_sample, state_gla, cache_conv, meta, norm_ffn1, w_up1, w_down1,
              norm_mix, w_in, w_a2, b_a, g_head, w_conv, w_out, norm_ffn2, w_up2, w_down2,
              norm_final):
    bp = x_prompt.shape[0]
    meta_b = jnp.broadcast_to(meta.astype(x_prompt.dtype)[None], (bp, N_META, D_MODEL))
    xp = jnp.concatenate([meta_b, x_prompt], axis=1)
    xs = x_sample
    s0_p = jnp.zeros((bp, N_GLA_HEADS, GLA_DK, GLA_DV), jnp.float32)
    c0_p = jnp.zeros((bp, CONV_W - 1, D_CONV), x_prompt.dtype)
    sp_l, cp_l, ss_l, cs_l = [], [], [], []
    for i in range(DEPTH):
        lw = (norm_ffn1[i], w_up1[i], w_down1[i], norm_mix[i], w_in[i], w_a2[i], b_a[i],
              g_head[i], w_conv[i], w_out[i], norm_ffn2[i], w_up2[i], w_down2[i])
        xp, sp, cp = layer(xp, s0_p, c0_p, *lw)
        xs, ss, cs = layer(xs, state_gla[i], cache_conv[i], *lw)
        sp_l.append(sp.astype(state_gla.dtype))
        cp_l.append(cp.astype(cache_conv.dtype))
        ss_l.append(ss.astype(state_gla.dtype))
        cs_l.append(cs.astype(cache_conv.dtype))
    y_prompt = rms_norm(xp[:, N_META:], norm_final)
    y_sample = rms_norm(xs, norm_final)
    return (y_prompt, y_sample, jnp.stack(sp_l), jnp.stack(cp_l), jnp.stack(ss_l), jnp.stack(cs_l))
```

```cpp
#include <hip/hip_runtime.h>
#include <hip/hip_cooperative_groups.h>
#include <cstdio>
#include <cstdint>
namespace cg = cooperative_groups;
namespace pg8 {
#define PG8_LAS __attribute__((address_space(3)))
typedef unsigned short bf16_t;
typedef short bf16x8 __attribute__((ext_vector_type(8)));
typedef float f32x4 __attribute__((ext_vector_type(4)));
typedef unsigned u32x4 __attribute__((ext_vector_type(4)));
constexpr int BM = 256, BK = 64, HALF = 128, HTB = HALF * BK * 2  , STAGE_BYTES = 8 * HTB, NXCD = 8, WGM = 8;

__host__ __device__ __forceinline__ int lds_byte(int r, int c) { const int st = (r >> 4) * 2 + (c >> 5), rr = r & 15, cc = c & 31, ob = rr * 64 + cc * 2; return st * 1024 + (ob ^ (((ob >> 9) & 1) << 5)); }
__host__ __device__ __forceinline__ void stage_rc(int b, int& R, int& C) { const int st = b / 1024, sb = b % 1024, swz = sb ^ (((sb >> 9) & 1) << 5); R = (st >> 1) * 16 + swz / 64; C = (st & 1) * 32 + (swz % 64) / 2; }
__host__ __device__ __forceinline__ int perm32(int rho) { const int n = rho >> 4, i = rho & 15; return 8 * (i >> 2) + 4 * n + (i & 3); }

struct Unit { int pm, pn; };
struct Gemm { const bf16_t* A; const bf16_t* Bt; int M, N, K; };

struct StaticOrder {
    int nM, nN, nwg, G, c;
    __host__ __device__ void init(int M, int N, int G_, int c_) { nM = M / BM; nN = N / BM; nwg = nM * nN; G = G_; c = c_; }
    __host__ __device__ bool next(int i, Unit& u) const {
        const long L = (long)i * G + c; if (L >= nwg) return false;
        int wgid = (int)L; { const int q = nwg / NXCD, r = nwg % NXCD, xcd = wgid % NXCD, off = wgid / NXCD; wgid = (xcd < r ? xcd * (q + 1) : r * (q + 1) + (xcd - r) * q) + off; }
        const int nig = WGM * nN, gid = wgid / nig, fm = gid * WGM, gsz = (nM - fm) < WGM ? (nM - fm) : WGM;
        u.pm = fm + ((wgid % nig) % gsz); u.pn = (wgid % nig) / gsz; return true;
    }
    __device__ __forceinline__ void a_ready(const Unit&) const {}
    __device__ __forceinline__ void done(const Unit&) const {}
};

__device__ __forceinline__ unsigned cvt_pk_bf16(float lo, float hi) { unsigned r; asm volatile("v_cvt_pk_bf16_f32 %0, %1, %2" : "=v"(r) : "v"(lo), "v"(hi)); return r; }
template <class Epi, class Sched, bool ALIGN_EPI = false, bool SP2 = false>
__device__ __forceinline__ void gemm_phase(PG8_LAS unsigned char* lds, const Gemm g, const Sched& S, const Epi& E) {
    const int tid = threadIdx.x, wid = __builtin_amdgcn_readfirstlane(tid >> 6), lane = tid & 63, wr = wid >> 2, wc = wid & 3, fr = lane & 15, fq = lane >> 4;
    const int K = g.K, nt = K / BK;
    unsigned voffA[2], voffB[2];
#pragma unroll
    for (int i = 0; i < 2; ++i) { int R, C; stage_rc(tid * 16 + i * 8192, R, C); const int Rb = Epi::PERM ? ((R & ~31) + perm32(R & 31)) : R;
        voffA[i] = (unsigned)(R * K + C) * 2u; voffB[i] = (unsigned)(Rb * K + C) * 2u; }
    const size_t kstep = (size_t)(BK * 2);
    const size_t hstep = (size_t)HALF * K * 2;
    const size_t tstep = 2 * hstep;
    const unsigned ldsw = (unsigned)wid * 1024u;
    const int aoff = lds_byte(wr * 64 + fr, fq * 8), boff = lds_byte(wc * 32 + fr, fq * 8);
#define PG8_SA(b, h) (((b) * 2 + (h)) * HTB)
#define PG8_SB(b, h) ((4 + (b) * 2 + (h)) * HTB)
#define PG8_STAGE(bufoff, gbase, voff) do { _Pragma("unroll") for (int _i = 0; _i < 2; ++_i) \
        __builtin_amdgcn_global_load_lds((const unsigned*)((const char*)(gbase) + (voff)[_i]), (PG8_LAS unsigned*)(lds + (bufoff) + ldsw + _i * 8192), 16, 0, 0); } while (0)
#define PG8_LDA(dst, b, h) do { _Pragma("unroll") for (int m = 0; m < 4; ++m) _Pragma("unroll") for (int k = 0; k < 2; ++k) dst[m][k] = *(const PG8_LAS bf16x8*)(lds + PG8_SA(b, h) + aoff + m * 2048 + k * 1024); } while (0)
#define PG8_LDB(dst, b, h) do { _Pragma("unroll") for (int n = 0; n < 2; ++n) _Pragma("unroll") for (int k = 0; k < 2; ++k) dst[n][k] = *(const PG8_LAS bf16x8*)(lds + PG8_SB(b, h) + boff + n * 2048 + k * 1024); } while (0)
#define PG8_MMA(ai, bj, At, Bt) do { __builtin_amdgcn_s_setprio(1); _Pragma("unroll") for (int m = 0; m < 4; ++m) _Pragma("unroll") for (int n = 0; n < 2; ++n) _Pragma("unroll") for (int k = 0; k < 2; ++k) \
        acc[ai][bj][m][n] = __builtin_amdgcn_mfma_f32_16x16x32_bf16(Bt[n][k], At[m][k], acc[ai][bj][m][n], 0, 0, 0); __builtin_amdgcn_s_setprio(0); } while (0)
#define PG8_WAIT_V(n) asm volatile("s_waitcnt vmcnt(" #n ")" ::: "memory")
#define PG8_WAIT_L(n) asm volatile("s_waitcnt lgkmcnt(" #n ")" ::: "memory")
#define PG8_BAR __builtin_amdgcn_s_barrier()
#define PG8_SCHED __builtin_amdgcn_sched_barrier(0)
    Unit cur, nxt; int ui = 0;
    if (!S.next(0, cur)) return;
    f32x4 acc[2][2][4][2];
#pragma unroll
    for (int a = 0; a < 2; ++a)
#pragma unroll
        for (int b = 0; b < 2; ++b)
#pragma unroll
            for (int m = 0; m < 4; ++m)
#pragma unroll
                for (int n = 0; n < 2; ++n) acc[a][b][m][n] = (f32x4){0.f, 0.f, 0.f, 0.f};
    bf16x8 At[4][2], B0[2][2], B1[2][2];
    const char* cA = (const char*)g.A + (size_t)cur.pm * tstep; const char* cB = (const char*)g.Bt + (size_t)cur.pn * tstep;
    S.a_ready(cur);
    if constexpr (SP2) {
        PG8_STAGE(PG8_SB(0, 0), cB, voffB); PG8_STAGE(PG8_SB(0, 1), cB + hstep, voffB); PG8_STAGE(PG8_SA(0, 0), cA, voffA); PG8_STAGE(PG8_SA(0, 1), cA + hstep, voffA);
        if (wr == 1) PG8_BAR;
        PG8_WAIT_V(2); PG8_BAR;
        PG8_STAGE(PG8_SB(1, 0), cB + kstep, voffB); PG8_STAGE(PG8_SA(1, 0), cA + kstep, voffA); PG8_STAGE(PG8_SB(1, 1), cB + hstep + kstep, voffB);
        PG8_WAIT_V(6); PG8_BAR;
    } else {
        PG8_STAGE(PG8_SB(0, 0), cB, voffB); PG8_STAGE(PG8_SA(0, 0), cA, voffA); PG8_STAGE(PG8_SB(0, 1), cB + hstep, voffB); PG8_STAGE(PG8_SA(0, 1), cA + hstep, voffA);
        if (wr == 1) PG8_BAR;
        PG8_WAIT_V(4); PG8_BAR;
        PG8_STAGE(PG8_SB(1, 0), cB + kstep, voffB); PG8_STAGE(PG8_SA(1, 0), cA + kstep, voffA); PG8_STAGE(PG8_SB(1, 1), cB + hstep + kstep, voffB);
        PG8_WAIT_V(6); PG8_BAR;
    }
    for (;;) {
        const bool has_next = S.next(ui + 1, nxt);
        const char* nA = has_next ? (const char*)g.A + (size_t)nxt.pm * tstep : cA; const char* nB = has_next ? (const char*)g.Bt + (size_t)nxt.pn * tstep : cB;
        for (int t = 0; t < nt; t += 2) {
            const bool last = (t == nt - 2);
            const char* a1 = cA + (size_t)(t + 1) * kstep;
            const char* a2 = last ? nA : cA + (size_t)(t + 2) * kstep; const char* b2 = last ? nB : cB + (size_t)(t + 2) * kstep;
            const char* a3 = a2 + kstep; const char* b3 = b2 + kstep;
            if (last && has_next) S.a_ready(nxt);
            if constexpr (SP2) {
            PG8_LDB(B0, 0, 0); PG8_LDB(B1, 0, 1); PG8_SCHED; PG8_LDA(At, 0, 0); PG8_STAGE(PG8_SA(1, 1), a1 + hstep, voffA);
            PG8_WAIT_V(8); PG8_WAIT_L(0); PG8_BAR; PG8_MMA(0, 0, At, B0); PG8_MMA(0, 1, At, B1); PG8_BAR; PG8_SCHED;
            PG8_LDA(At, 0, 1); PG8_STAGE(PG8_SB(0, 0), b2, voffB); PG8_STAGE(PG8_SB(0, 1), b2 + hstep, voffB); PG8_STAGE(PG8_SA(0, 0), a2, voffA);
            PG8_WAIT_V(8); PG8_WAIT_L(0); PG8_BAR; PG8_MMA(1, 0, At, B0); PG8_MMA(1, 1, At, B1); PG8_BAR; PG8_SCHED;
            PG8_LDB(B0, 1, 0); PG8_LDB(B1, 1, 1); PG8_SCHED; PG8_LDA(At, 1, 0); PG8_STAGE(PG8_SA(0, 1), a2 + hstep, voffA);
            PG8_WAIT_V(8); PG8_WAIT_L(0); PG8_BAR; PG8_MMA(0, 0, At, B0); PG8_MMA(0, 1, At, B1); PG8_BAR; PG8_SCHED;
            PG8_LDA(At, 1, 1); PG8_STAGE(PG8_SB(1, 0), b3, voffB); PG8_STAGE(PG8_SB(1, 1), b3 + hstep, voffB); PG8_STAGE(PG8_SA(1, 0), a3, voffA);
            PG8_WAIT_V(8); PG8_WAIT_L(0); PG8_BAR; PG8_MMA(1, 0, At, B0); PG8_MMA(1, 1, At, B1); PG8_BAR; PG8_SCHED;
            } else {
            PG8_LDB(B0, 0, 0); PG8_SCHED; PG8_LDA(At, 0, 0); PG8_STAGE(PG8_SA(1, 1), a1 + hstep, voffA);
            PG8_WAIT_L(8); PG8_BAR; PG8_WAIT_L(0); PG8_MMA(0, 0, At, B0); PG8_BAR; PG8_SCHED;
            PG8_LDB(B1, 0, 1); PG8_STAGE(PG8_SB(0, 0), b2, voffB);
            PG8_BAR; PG8_WAIT_L(0); PG8_MMA(0, 1, At, B1); PG8_BAR;
            PG8_LDA(At, 0, 1); PG8_STAGE(PG8_SA(0, 0), a2, voffA);
            PG8_BAR; PG8_WAIT_L(0); PG8_MMA(1, 0, At, B0); PG8_BAR; PG8_SCHED;
            PG8_STAGE(PG8_SB(0, 1), b2 + hstep, voffB);
            PG8_WAIT_V(6); PG8_BAR; PG8_MMA(1, 1, At, B1); PG8_BAR;
            PG8_LDB(B0, 1, 0); PG8_SCHED; PG8_LDA(At, 1, 0); PG8_STAGE(PG8_SA(0, 1), a2 + hstep, voffA);
            PG8_WAIT_L(8); PG8_BAR; PG8_WAIT_L(0); PG8_MMA(0, 0, At, B0); PG8_BAR; PG8_SCHED;
            PG8_LDB(B1, 1, 1); PG8_STAGE(PG8_SB(1, 0), b3, voffB);
            PG8_BAR; PG8_WAIT_L(0); PG8_MMA(0, 1, At, B1); PG8_BAR;
            PG8_LDA(At, 1, 1); PG8_STAGE(PG8_SA(1, 0), a3, voffA);
            PG8_BAR; PG8_WAIT_L(0); PG8_MMA(1, 0, At, B0); PG8_BAR; PG8_SCHED;
            PG8_STAGE(PG8_SB(1, 1), b3 + hstep, voffB);
            PG8_WAIT_V(6); PG8_BAR; PG8_MMA(1, 1, At, B1); PG8_BAR;
            }
        }
        if constexpr (ALIGN_EPI) { if (wr == 0) PG8_BAR; }
        if constexpr (!Epi::AFTER_DRAIN) { E(acc, cur, wr, wc, fr, fq); S.done(cur); }
        if (!has_next) break;
#pragma unroll
        for (int a = 0; a < 2; ++a)
#pragma unroll
            for (int b = 0; b < 2; ++b)
#pragma unroll
                for (int m = 0; m < 4; ++m)
#pragma unroll
                    for (int n = 0; n < 2; ++n) acc[a][b][m][n] = (f32x4){0.f, 0.f, 0.f, 0.f};
        cur = nxt; cA = nA; cB = nB; ++ui;
        if constexpr (ALIGN_EPI) { if (wr == 1) PG8_BAR; }
    }
    PG8_WAIT_V(0);
    if constexpr (!ALIGN_EPI) { if (wr == 0) PG8_BAR; }
    PG8_BAR;
    if constexpr (Epi::AFTER_DRAIN) { E.fused(acc, cur, wr, wc, fr, fq, lds, wid, lane); S.done(cur); }
#undef PG8_SA
#undef PG8_SB
#undef PG8_STAGE
#undef PG8_LDA
#undef PG8_LDB
#undef PG8_MMA
#undef PG8_WAIT_V
#undef PG8_WAIT_L
#undef PG8_BAR
#undef PG8_SCHED
}
}
using pg8::bf16_t; using pg8::f32x4; using pg8::bf16x8; using pg8::u32x4; using pg8::Unit; using pg8::cvt_pk_bf16;
#define LAS __attribute__((address_space(3)))
typedef unsigned u32x2 __attribute__((ext_vector_type(2)));
typedef float f32x2 __attribute__((ext_vector_type(2)));
constexpr int DM = 1024, NBP = 32, SEQ = 2048, NMETA = 16, LP = SEQ + NMETA, NBS = 32, DSEQ = 64;
constexpr int MP = NBP * LP, MS = NBS * DSEQ, M = MP + MS;
constexpr int FF = 2816, NUP = 2 * FF, NIN = 3328, DIN = 3088;
constexpr int NH = 4, DK = 64, DV = 128;
constexpr float EPS = 1e-6f;
static_assert(M % 256 == 0, "M");
constexpr size_t OUT_YP = 0, OUT_YS = (size_t)NBP * SEQ * DM, OUT_SP = OUT_YS + (size_t)MS * DM, OUT_CP = OUT_SP + (size_t)NBP * NH * DK * DV,
                 OUT_SS = OUT_CP + (size_t)NBP * 2 * 512, OUT_CS = OUT_SS + (size_t)NBS * NH * DK * DV, OUT_END = OUT_CS + (size_t)NBS * 2 * 512;
constexpr size_t MiB = 1u << 20;
constexpr size_t WS_SS = 0, SS_STRIDE = 512 * 1024;
constexpr size_t WS_WUP1 = 2 * MiB, WS_WDN1 = 13 * MiB, WS_WIN = 19 * MiB, WS_WOUT = 26 * MiB, WS_WUP2 = 28 * MiB, WS_WDN2 = 39 * MiB;
constexpr size_t WS_XB = 48 * MiB;
constexpr size_t WS_ACT = 184 * MiB;
constexpr size_t WS_QK = 184 * MiB, WS_U = 450 * MiB, WS_LA = 517 * MiB;
constexpr size_t WS_MIX = 584 * MiB, WS_END = 718 * MiB;
static_assert(WS_ACT + (size_t)M * FF * 2 <= WS_MIX && WS_LA + (size_t)M * 256 * 4 <= WS_MIX && WS_U + (size_t)M * 512 * 2 <= WS_LA && WS_QK + (size_t)M * 2048 * 2 <= WS_U, "ws map");
static_assert(WS_XB + (size_t)M * DM * 2 <= WS_ACT && WS_MIX + (size_t)M * DM * 2 <= WS_END && WS_WDN2 + (size_t)DM * FF * 2 <= WS_XB, "ws map");

__device__ __forceinline__ const float* xin_row(const float* xp, const float* meta, const float* xs, int R) {
    if (R < MP) { const int b = R / LP, t = R - b * LP; return t < NMETA ? meta + (size_t)t * DM : xp + ((size_t)b * SEQ + (t - NMETA)) * DM; }
    return xs + (size_t)(R - MP) * DM;
}
__device__ __forceinline__ float* yout_row(float* out, int R) {
    if (R < MP) { const int b = R / LP, t = R - b * LP; return t < NMETA ? nullptr : out + ((size_t)b * SEQ + (t - NMETA)) * DM; }
    return out + OUT_YS + (size_t)(R - MP) * DM;
}
__device__ __forceinline__ float bf_lo(unsigned w) { return __uint_as_float(w << 16); }
__device__ __forceinline__ float bf_hi(unsigned w) { return __uint_as_float(w & 0xffff0000u); }
__device__ __forceinline__ float silu_f(float g) { return g * __builtin_amdgcn_rcpf(1.f + __expf(-g)); }
__device__ __forceinline__ float wave_sum(float v) {
#pragma unroll
    for (int o = 1; o < 64; o <<= 1) v += __shfl_xor(v, o);
    return v;
}

struct EpiUp {
    static constexpr bool PERM = true, AFTER_DRAIN = false;
    bf16_t* O; const float* ss;
    __device__ __forceinline__ void operator()(const f32x4 (&acc)[2][2][4][2], const Unit& u, int wr, int wc, int fr, int fq) const {
        const int row0 = u.pm * 256 + wr * 64 + fr, col0 = u.pn * 128 + wc * 32 + 8 * fq;
#pragma unroll
        for (int ai = 0; ai < 2; ++ai)
#pragma unroll
            for (int m = 0; m < 4; ++m) {
                const int row = row0 + ai * 128 + m * 16;
                const float rs = rsqrtf(ss[row] * (1.0f / DM) + EPS);
                float o[8];
#pragma unroll
                for (int n = 0; n < 2; ++n)
#pragma unroll
                    for (int j = 0; j < 4; ++j) { const float g = acc[ai][0][m][n][j] * rs, up = acc[ai][1][m][n][j] * rs; o[4 * n + j] = silu_f(g) * up; }
                u32x4 w; w.x = cvt_pk_bf16(o[0], o[1]); w.y = cvt_pk_bf16(o[2], o[3]); w.z = cvt_pk_bf16(o[4], o[5]); w.w = cvt_pk_bf16(o[6], o[7]);
                *(u32x4*)(O + (size_t)row * FF + col0) = w;
            }
    }
};
template <int MODE> struct EpiRes {
    static constexpr bool PERM = true, AFTER_DRAIN = false;
    const float *xp, *meta, *xs; bf16_t* XB; float* out; float* ss;
    __device__ __forceinline__ void operator()(const f32x4 (&acc)[2][2][4][2], const Unit& u, int wr, int wc, int fr, int fq) const {
        const float alpha = (MODE == 1) ? 1.0f : 0.5f;
#pragma unroll
        for (int ai = 0; ai < 2; ++ai)
#pragma unroll
            for (int m = 0; m < 4; ++m) {
                const int row = u.pm * 256 + ai * 128 + wr * 64 + m * 16 + fr;
                const float* xr = nullptr; float* yr = nullptr;
                if (MODE == 0) xr = xin_row(xp, meta, xs, row);
                if (MODE == 2) yr = yout_row(out, row);
                float sq = 0.f;
#pragma unroll
                for (int bj = 0; bj < 2; ++bj) {
                    const int col = u.pn * 256 + bj * 128 + wc * 32 + 8 * fq;
                    f32x4 b0, b1;
                    if (MODE == 0) { b0 = *(const f32x4*)(xr + col); b1 = *(const f32x4*)(xr + col + 4); }
                    else { const u32x4 w = *(const u32x4*)(XB + (size_t)row * DM + col);
                        b0 = (f32x4){bf_lo(w.x), bf_hi(w.x), bf_lo(w.y), bf_hi(w.y)}; b1 = (f32x4){bf_lo(w.z), bf_hi(w.z), bf_lo(w.w), bf_hi(w.w)}; }
                    const f32x4 v0 = b0 + acc[ai][bj][m][0] * alpha, v1 = b1 + acc[ai][bj][m][1] * alpha;
                    sq += (v0[0] * v0[0] + v0[1] * v0[1]) + (v0[2] * v0[2] + v0[3] * v0[3]) + (v1[0] * v1[0] + v1[1] * v1[1]) + (v1[2] * v1[2] + v1[3] * v1[3]);
                    if (MODE < 2) { u32x4 w; w.x = cvt_pk_bf16(v0[0], v0[1]); w.y = cvt_pk_bf16(v0[2], v0[3]); w.z = cvt_pk_bf16(v1[0], v1[1]); w.w = cvt_pk_bf16(v1[2], v1[3]);
                        *(u32x4*)(XB + (size_t)row * DM + col) = w; }
                    else if (yr) { *(f32x4*)(yr + col) = v0; *(f32x4*)(yr + col + 4) = v1; }
                }
                sq += __shfl_xor(sq, 16); sq += __shfl_xor(sq, 32);
                if (fq == 0) unsafeAtomicAdd(ss + row, sq);
            }
    }
};
__device__ __forceinline__ float log_sigmoid_f(float z) { const float e = __expf(-fabsf(z)); return fminf(z, 0.f) - __logf(1.f + e); }
struct EpiWin {
    static constexpr bool PERM = true, AFTER_DRAIN = false;
    bf16_t* QK; bf16_t* U; float* LA; const float* ss; const float* b_a;
    __device__ __forceinline__ void operator()(const f32x4 (&acc)[2][2][4][2], const Unit& u, int wr, int wc, int fr, int fq) const {
        const int pn = u.pn;
#pragma unroll
        for (int ai = 0; ai < 2; ++ai)
#pragma unroll
            for (int m = 0; m < 4; ++m) {
                const int row = u.pm * 256 + ai * 128 + wr * 64 + m * 16 + fr;
                const float rs = rsqrtf(ss[row] * (1.0f / DM) + EPS);
                if (pn < 8) {
                    const float sc = (pn == 0) ? rs * 0.125f : rs;
#pragma unroll
                    for (int bj = 0; bj < 2; ++bj) { const f32x4 v0 = acc[ai][bj][m][0] * sc, v1 = acc[ai][bj][m][1] * sc;
                        u32x4 w; w.x = cvt_pk_bf16(v0[0], v0[1]); w.y = cvt_pk_bf16(v0[2], v0[3]); w.z = cvt_pk_bf16(v1[0], v1[1]); w.w = cvt_pk_bf16(v1[2], v1[3]);
                        *(u32x4*)(QK + (size_t)row * 2048 + pn * 256 + bj * 128 + wc * 32 + 8 * fq) = w; }
                } else if (pn < 12) {
                    const float r2 = rs * rs;
                    const f32x4 v0 = acc[ai][0][m][0] * acc[ai][1][m][0] * r2, v1 = acc[ai][0][m][1] * acc[ai][1][m][1] * r2;
                    u32x4 w; w.x = cvt_pk_bf16(v0[0], v0[1]); w.y = cvt_pk_bf16(v0[2], v0[3]); w.z = cvt_pk_bf16(v1[0], v1[1]); w.w = cvt_pk_bf16(v1[2], v1[3]);
                    *(u32x4*)(U + (size_t)row * 512 + (pn - 8) * 128 + wc * 32 + 8 * fq) = w;
                } else {
#pragma unroll
                    for (int bj = 0; bj < 2; ++bj)
#pragma unroll
                        for (int n = 0; n < 2; ++n) { const int c = bj * 128 + wc * 32 + 8 * fq + 4 * n; const f32x4 bb = *(const f32x4*)(b_a + c); f32x4 o;
#pragma unroll
                            for (int j = 0; j < 4; ++j) o[j] = log_sigmoid_f(acc[ai][bj][m][n][j] * rs + bb[j]) * (1.0f / 16.0f);
                            *(f32x4*)(LA + (size_t)row * 256 + c) = o; }
                }
            }
    }
};
__device__ __forceinline__ void tr_item(const float* W, int ldw, int src_col0, const float* gain, bf16_t* WT, int K, int dst_row0, int k0, LAS float* scr, int lane) {
#pragma unroll 8
    for (int i = 0; i < 32; ++i) { const int kk = 2 * i + (lane >> 5); float w = W[(size_t)(k0 + kk) * ldw + src_col0 + (lane & 31)]; if (gain) w *= gain[k0 + kk]; scr[kk * 33 + (lane & 31)] = w; }
    asm volatile("s_waitcnt lgkmcnt(0)" ::: "memory");
    const int c = lane & 7;
#pragma unroll
    for (int j = 0; j < 4; ++j) { const int n = (lane >> 3) + 8 * j; const LAS float* s = scr + (8 * c) * 33 + n;
        u32x4 o; o.x = cvt_pk_bf16(s[0 * 33], s[1 * 33]); o.y = cvt_pk_bf16(s[2 * 33], s[3 * 33]); o.z = cvt_pk_bf16(s[4 * 33], s[5 * 33]); o.w = cvt_pk_bf16(s[6 * 33], s[7 * 33]);
        *(u32x4*)(WT + (size_t)(dst_row0 + n) * K + k0 + 8 * c) = o; }
    asm volatile("s_waitcnt lgkmcnt(0)" ::: "memory");
}
__device__ __forceinline__ int up_src_col(int n) { const int pn = n >> 8, within = n & 255; return (within >> 7) * FF + 128 * pn + (within & 127); }
__device__ __forceinline__ int win_src_col(int n) {
    if (n < 1536) return n;
    if (n < 2048) return n + 16;
    const int j = (n - 2048) >> 8, within = (n - 2048) & 255;
    return ((within >> 7) ? 2576 : 2064) + 128 * j + (within & 127);
}
struct P0Args { const float *xp, *xs, *meta, *n1, *wu1, *wd1, *n2, *win, *wa2, *wout, *n3, *wu2, *wd2; unsigned char* ws; };
__device__ __forceinline__ void p0_prologue(const P0Args& a, LAS unsigned char* lds, int gw, int NGW, int wave, int lane) {
    LAS float* scr = (LAS float*)(lds + wave * 8704);
    constexpr int I_UP = (DM / 64) * (NUP / 32), I_DN = (FF / 64) * (DM / 32), I_IN = (DM / 64) * (3072 / 32), I_OUT = (DM / 64) * (DM / 32);
    constexpr int NITEMS = 2 * I_UP + 2 * I_DN + I_IN + I_OUT;
    bf16_t* WUP1 = (bf16_t*)(a.ws + WS_WUP1); bf16_t* WDN1 = (bf16_t*)(a.ws + WS_WDN1); bf16_t* WIN = (bf16_t*)(a.ws + WS_WIN);
    bf16_t* WOUT = (bf16_t*)(a.ws + WS_WOUT); bf16_t* WUP2 = (bf16_t*)(a.ws + WS_WUP2); bf16_t* WDN2 = (bf16_t*)(a.ws + WS_WDN2);
    for (int it = gw; it < NITEMS; it += NGW) {
        int r = it;
        if (r < 2 * I_UP) { const bool second = r >= I_UP; if (second) r -= I_UP; const int nblk = NUP / 32, kb = r / nblk, nb = r % nblk;
            tr_item(second ? a.wu2 : a.wu1, NUP, up_src_col(32 * nb), second ? a.n3 : a.n1, second ? WUP2 : WUP1, DM, 32 * nb, 64 * kb, scr, lane); continue; }
        r -= 2 * I_UP;
        if (r < 2 * I_DN) { const bool second = r >= I_DN; if (second) r -= I_DN; const int nblk = DM / 32, kb = r / nblk, nb = r % nblk;
            tr_item(second ? a.wd2 : a.wd1, DM, 32 * nb, nullptr, second ? WDN2 : WDN1, FF, 32 * nb, 64 * kb, scr, lane); continue; }
        r -= 2 * I_DN;
        if (r < I_IN) { const int nblk = 3072 / 32, kb = r / nblk, nb = r % nblk;
            tr_item(a.win, DIN, win_src_col(32 * nb), a.n2, WIN, DM, 32 * nb, 64 * kb, scr, lane); continue; }
        r -= I_IN;
        { const int nblk = DM / 32, kb = r / nblk, nb = r % nblk; tr_item(a.wout, DM, 32 * nb, nullptr, WOUT, DM, 32 * nb, 64 * kb, scr, lane); }
    }
    for (int e = gw * 64 + lane; e < 256 * DM; e += NGW * 64) { const int n = e >> 10, k = e & 1023; const float* wr_ = a.win + (size_t)k * DIN + 1536; float s = 0.f;
#pragma unroll
        for (int r = 0; r < 16; ++r) s += wr_[r] * a.wa2[r * 256 + n];
        s *= a.n2[k]; const unsigned short b = (unsigned short)(cvt_pk_bf16(s, 0.f) & 0xffffu); WIN[(size_t)(3072 + n) * DM + k] = b; }
    bf16_t* XB = (bf16_t*)(a.ws + WS_XB); float* ss0 = (float*)(a.ws + WS_SS);
    for (int R = gw; R < M; R += NGW) {
        const f32x4* xr = (const f32x4*)xin_row(a.xp, a.meta, a.xs, R) + lane; f32x4 v[4]; float s = 0.f;
#pragma unroll
        for (int j = 0; j < 4; ++j) { v[j] = xr[64 * j]; s += (v[j][0] * v[j][0] + v[j][1] * v[j][1]) + (v[j][2] * v[j][2] + v[j][3] * v[j][3]); }
        s = wave_sum(s);
        u32x2* o8 = (u32x2*)(XB + (size_t)R * DM) + lane;
#pragma unroll
        for (int j = 0; j < 4; ++j) { u32x2 w; w.x = cvt_pk_bf16(v[j][0], v[j][1]); w.y = cvt_pk_bf16(v[j][2], v[j][3]); o8[64 * j] = w; }
        if (lane == 0) { ss0[R] = s; ss0[R + SS_STRIDE / 4] = 0.f; ss0[R + 2 * (SS_STRIDE / 4)] = 0.f; ss0[R + 3 * (SS_STRIDE / 4)] = 0.f; }
    }
}

struct GlaArgs { const bf16_t* QK; const float* LA; const bf16_t* U; bf16_t* MIX; const float* state_in; const float* cache_conv; const float* g_head; const float* w_conv; float* out; };
constexpr int GT = 16;
__device__ __forceinline__ void gla_unit(const GlaArgs& a, LAS unsigned char* lds, int unit, int tid, int wave, int lane) {
    const bool samp = unit >= 128; const int s = (unit & 127) >> 2, h = unit & 3;
    const int L = samp ? DSEQ : LP; const int row0 = samp ? MP + s * DSEQ : s * LP;
    LAS float* qs = (LAS float*)lds;
    LAS float* ks = qs + GT * 64;
    LAS float* as = ks + GT * 64;
    LAS float* vs = as + GT * 64;
    LAS float* ob = vs + GT * 128;
    const int col = 16 * wave + (lane & 15), gq = lane >> 4;
    float S[16];
    float* sout = a.out + (samp ? OUT_SS : OUT_SP) + ((size_t)(s * NH + h) * DK + 16 * gq) * DV + col;
    if (samp) { const float* sp = a.state_in + ((size_t)(s * NH + h) * DK + 16 * gq) * DV + col;
#pragma unroll
        for (int i = 0; i < 16; ++i) S[i] = sp[(size_t)i * DV]; }
    else {
#pragma unroll
        for (int i = 0; i < 16; ++i) S[i] = 0.f; }
    u32x4 pa; f32x4 pl;
    const int lrow_qk = (tid & 127) >> 3, lch_qk = tid & 7, lrow_a = (tid & 255) >> 4, lch_a = tid & 15;
    auto issue = [&](int t0) {
        if (tid < 256) {
            pa = *(const u32x4*)(a.QK + (size_t)(row0 + t0 + lrow_qk) * 2048 + (tid < 128 ? 0 : 256) + h * 64 + lch_qk * 8);
            pl = *(const f32x4*)(a.LA + (size_t)(row0 + t0 + lrow_a) * 256 + h * 64 + lch_a * 4);
        } else {
            pa = *(const u32x4*)(a.QK + (size_t)(row0 + t0 + lrow_a) * 2048 + 512 + h * 128 + lch_a * 8);
        }
    };
    issue(0);
    for (int t0 = 0; t0 < L; t0 += GT) {
        {
            const f32x4 lo = (f32x4){bf_lo(pa.x), bf_hi(pa.x), bf_lo(pa.y), bf_hi(pa.y)}, hi = (f32x4){bf_lo(pa.z), bf_hi(pa.z), bf_lo(pa.w), bf_hi(pa.w)};
            if (tid < 256) {
                LAS float* d = (tid < 128 ? qs : ks) + lrow_qk * 64 + lch_qk * 8; *(LAS f32x4*)d = lo; *(LAS f32x4*)(d + 4) = hi;
                f32x4 e; e[0] = __expf(pl[0]); e[1] = __expf(pl[1]); e[2] = __expf(pl[2]); e[3] = __expf(pl[3]);
                *(LAS f32x4*)(as + lrow_a * 64 + lch_a * 4) = e;
            } else { LAS float* d = vs + lrow_a * 128 + lch_a * 8; *(LAS f32x4*)d = lo; *(LAS f32x4*)(d + 4) = hi; }
        }
        __syncthreads();
        if (t0 + GT < L) issue(t0 + GT);
#pragma unroll 2
        for (int tt = 0; tt < GT; ++tt) {
            const LAS f32x4* ap = (const LAS f32x4*)(as + tt * 64 + 16 * gq); const LAS f32x4* kp = (const LAS f32x4*)(ks + tt * 64 + 16 * gq); const LAS f32x4* qp = (const LAS f32x4*)(qs + tt * 64 + 16 * gq);
            const float vv = vs[tt * 128 + col]; float o = 0.f;
#pragma unroll
            for (int i4 = 0; i4 < 4; ++i4) { const f32x4 av = ap[i4], kv = kp[i4], qv = qp[i4];
#pragma unroll
                for (int j = 0; j < 4; ++j) { const int i = 4 * i4 + j; S[i] = S[i] * av[j] + kv[j] * vv; o += qv[j] * S[i]; } }
            o += __shfl_xor(o, 16); o += __shfl_xor(o, 32);
            if (gq == 0) ob[tt * 128 + col] = o;
        }
        __syncthreads();
        {
            const int tt = tid >> 5, c4 = (tid & 31) * 4; const int row = row0 + t0 + tt;
            const f32x4 ov = *(const LAS f32x4*)(ob + tt * 128 + c4);
            float sq = (ov[0] * ov[0] + ov[1] * ov[1]) + (ov[2] * ov[2] + ov[3] * ov[3]);
#pragma unroll
            for (int o = 1; o < 32; o <<= 1) sq += __shfl_xor(sq, o);
            const float rs = rsqrtf(sq * (1.0f / DV) + EPS);
            const u32x2 rw = *(const u32x2*)(a.QK + (size_t)row * 2048 + 1024 + h * 128 + c4);
            const f32x4 gh = *(const f32x4*)(a.g_head + c4);
            const float r0 = bf_lo(rw.x), r1 = bf_hi(rw.x), r2 = bf_lo(rw.y), r3 = bf_hi(rw.y);
            u32x2 w; w.x = cvt_pk_bf16(ov[0] * rs * gh[0] * silu_f(r0), ov[1] * rs * gh[1] * silu_f(r1)); w.y = cvt_pk_bf16(ov[2] * rs * gh[2] * silu_f(r2), ov[3] * rs * gh[3] * silu_f(r3));
            *(u32x2*)(a.MIX + (size_t)row * DM + h * 128 + c4) = w;
        }
    }
#pragma unroll
    for (int i = 0; i < 16; ++i) sout[(size_t)i * DV] = S[i];
    __syncthreads();
}
__device__ __forceinline__ void conv_pass(const GlaArgs& a, int gtid, int nthreads) {
    for (int item = gtid; item < M * 64; item += nthreads) {
        const int R = item >> 6, c8 = (item & 63) * 8;
        int b, t, L; bool samp = R >= MP;
        if (!samp) { b = R / LP; t = R - b * LP; L = LP; } else { const int r2 = R - MP; b = r2 >> 6; t = r2 & 63; L = DSEQ; }
        float u2[8], u1[8], u0[8], bb[8];
        { const u32x4 w = *(const u32x4*)(a.U + (size_t)R * 512 + c8); u2[0] = bf_lo(w.x); u2[1] = bf_hi(w.x); u2[2] = bf_lo(w.y); u2[3] = bf_hi(w.y); u2[4] = bf_lo(w.z); u2[5] = bf_hi(w.z); u2[6] = bf_lo(w.w); u2[7] = bf_hi(w.w); }
        if (t >= 1) { const u32x4 w = *(const u32x4*)(a.U + (size_t)(R - 1) * 512 + c8); u1[0] = bf_lo(w.x); u1[1] = bf_hi(w.x); u1[2] = bf_lo(w.y); u1[3] = bf_hi(w.y); u1[4] = bf_lo(w.z); u1[5] = bf_hi(w.z); u1[6] = bf_lo(w.w); u1[7] = bf_hi(w.w); }
        else {
#pragma unroll
            for (int j = 0; j < 8; ++j) u1[j] = samp ? a.cache_conv[((size_t)b * 2 + 1) * 512 + c8 + j] : 0.f; }
        if (t >= 2) { const u32x4 w = *(const u32x4*)(a.U + (size_t)(R - 2) * 512 + c8); u0[0] = bf_lo(w.x); u0[1] = bf_hi(w.x); u0[2] = bf_lo(w.y); u0[3] = bf_hi(w.y); u0[4] = bf_lo(w.z); u0[5] = bf_hi(w.z); u0[6] = bf_lo(w.w); u0[7] = bf_hi(w.w); }
        else {
#pragma unroll
            for (int j = 0; j < 8; ++j) u0[j] = samp ? a.cache_conv[((size_t)b * 2 + t) * 512 + c8 + j] : 0.f; }
        { const u32x4 w = *(const u32x4*)(a.QK + (size_t)R * 2048 + 1536 + c8); bb[0] = bf_lo(w.x); bb[1] = bf_hi(w.x); bb[2] = bf_lo(w.y); bb[3] = bf_hi(w.y); bb[4] = bf_lo(w.z); bb[5] = bf_hi(w.z); bb[6] = bf_lo(w.w); bb[7] = bf_hi(w.w); }
        float o[8];
#pragma unroll
        for (int j = 0; j < 8; ++j) o[j] = bb[j] * (a.w_conv[c8 + j] * u0[j] + a.w_conv[512 + c8 + j] * u1[j] + a.w_conv[1024 + c8 + j] * u2[j]);
        u32x4 w; w.x = cvt_pk_bf16(o[0], o[1]); w.y = cvt_pk_bf16(o[2], o[3]); w.z = cvt_pk_bf16(o[4], o[5]); w.w = cvt_pk_bf16(o[6], o[7]);
        *(u32x4*)(a.MIX + (size_t)R * DM + 512 + c8) = w;
        if (t >= L - 2) { float* oc = a.out + (samp ? OUT_CS : OUT_CP) + ((size_t)b * 2 + (t - (L - 2))) * 512 + c8;
            *(f32x4*)oc = (f32x4){u2[0], u2[1], u2[2], u2[3]}; *(f32x4*)(oc + 4) = (f32x4){u2[4], u2[5], u2[6], u2[7]}; }
    }
}
__device__ __forceinline__ void final_norm(float* out, const float* ss3, const float* gfin, int gw, int NGW, int lane) {
    constexpr int NR = NBP * SEQ + MS;
    f32x4 g[4];
#pragma unroll
    for (int j = 0; j < 4; ++j) g[j] = ((const f32x4*)gfin)[lane + 64 * j];
    for (int Rp = gw; Rp < NR; Rp += NGW) {
        int R; if (Rp < NBP * SEQ) { const int b = Rp >> 11, t = Rp & 2047; R = b * LP + NMETA + t; } else R = MP + (Rp - NBP * SEQ);
        const float rs = rsqrtf(ss3[R] * (1.0f / DM) + EPS);
        f32x4* yr = (f32x4*)(out + (size_t)Rp * DM) + lane;
#pragma unroll
        for (int j = 0; j < 4; ++j) { f32x4 v = yr[64 * j]; v = v * rs * g[j]; yr[64 * j] = v; }
    }
}

struct Args { const float* in[19]; float* out; unsigned char* ws; int ph_lo, ph_hi; };
constexpr int LDS_BYTES = 147456;
__global__ void __launch_bounds__(512, 2) fwd_kernel(Args args) {
    extern __shared__ __attribute__((aligned(16))) unsigned char lds_raw[];
    LAS unsigned char* lds = (LAS unsigned char*)lds_raw;
    cg::grid_group grid = cg::this_grid();
    const int tid = threadIdx.x, lane = tid & 63, wave = __builtin_amdgcn_readfirstlane(tid >> 6);
    const int G = gridDim.x, bx = blockIdx.x;
    const int gw = bx * 8 + wave, NGW = G * 8;
    unsigned char* ws = args.ws;
    const float *x_prompt = args.in[0], *x_sample = args.in[1], *state_gla = args.in[2], *cache_conv = args.in[3], *meta = args.in[4], *norm_ffn1 = args.in[5], *w_up1 = args.in[6], *w_down1 = args.in[7],
                *norm_mix = args.in[8], *w_in = args.in[9], *w_a2 = args.in[10], *b_a = args.in[11], *g_head = args.in[12], *w_conv = args.in[13], *w_out = args.in[14], *norm_ffn2 = args.in[15],
                *w_up2 = args.in[16], *w_down2 = args.in[17], *norm_final = args.in[18];
    bf16_t* XB = (bf16_t*)(ws + WS_XB); bf16_t* ACT = (bf16_t*)(ws + WS_ACT); bf16_t* QK = (bf16_t*)(ws + WS_QK); bf16_t* U = (bf16_t*)(ws + WS_U); float* LA = (float*)(ws + WS_LA); bf16_t* MIX = (bf16_t*)(ws + WS_MIX);
    float* ss0 = (float*)(ws + WS_SS); float* ss1 = ss0 + SS_STRIDE / 4; float* ss2 = ss1 + SS_STRIDE / 4; float* ss3 = ss2 + SS_STRIDE / 4;
    const int lo = args.ph_lo, hi = args.ph_hi;
#define IN(k) (lo <= (k) && (k) < hi)
#define SEAM(k) do { if (IN(k) && IN((k) + 1)) grid.sync(); } while (0)
    if (IN(0)) {
        P0Args pa{x_prompt, x_sample, meta, norm_ffn1, w_up1, w_down1, norm_mix, w_in, w_a2, w_out, norm_ffn2, w_up2, w_down2, ws};
        p0_prologue(pa, lds, gw, NGW, wave, lane);
    }
    SEAM(0);
    if (IN(1)) {
        pg8::Gemm g{XB, (const bf16_t*)(ws + WS_WUP1), M, NUP, DM}; pg8::StaticOrder S; S.init(M, NUP, G, bx);
        EpiUp E{ACT, ss0};
        pg8::gemm_phase<EpiUp, pg8::StaticOrder, true, true>(lds, g, S, E);
    }
    SEAM(1);
    if (IN(2)) {
        pg8::Gemm g{ACT, (const bf16_t*)(ws + WS_WDN1), M, DM, FF}; pg8::StaticOrder S; S.init(M, DM, G, bx);
        EpiRes<0> E{x_prompt, meta, x_sample, XB, args.out, ss1};
        pg8::gemm_phase<EpiRes<0>, pg8::StaticOrder, true, true>(lds, g, S, E);
    }
    SEAM(2);
    if (IN(3)) {
        pg8::Gemm g{XB, (const bf16_t*)(ws + WS_WIN), M, NIN, DM}; pg8::StaticOrder S; S.init(M, NIN, G, bx);
        EpiWin E{QK, U, LA, ss1, b_a};
        pg8::gemm_phase<EpiWin, pg8::StaticOrder, true, true>(lds, g, S, E);
    }
    SEAM(3);
    if (IN(4)) {
        GlaArgs ga{QK, LA, U, MIX, state_gla, cache_conv, g_head, w_conv, args.out};
        for (int unit = bx; unit < 256; unit += G) gla_unit(ga, lds, unit, tid, wave, lane);
        conv_pass(ga, bx * 512 + tid, G * 512);
    }
    SEAM(4);
    if (IN(5)) {
        pg8::Gemm g{MIX, (const bf16_t*)(ws + WS_WOUT), M, DM, DM}; pg8::StaticOrder S; S.init(M, DM, G, bx);
        EpiRes<1> E{x_prompt, meta, x_sample, XB, args.out, ss2};
        pg8::gemm_phase<EpiRes<1>, pg8::StaticOrder, true, true>(lds, g, S, E);
    }
    SEAM(5);
    if (IN(6)) {
        pg8::Gemm g{XB, (const bf16_t*)(ws + WS_WUP2), M, NUP, DM}; pg8::StaticOrder S; S.init(M, NUP, G, bx);
        EpiUp E{ACT, ss2};
        pg8::gemm_phase<EpiUp, pg8::StaticOrder, true, true>(lds, g, S, E);
    }
    SEAM(6);
    if (IN(7)) {
        pg8::Gemm g{ACT, (const bf16_t*)(ws + WS_WDN2), M, DM, FF}; pg8::StaticOrder S; S.init(M, DM, G, bx);
        EpiRes<2> E{x_prompt, meta, x_sample, XB, args.out, ss3};
        pg8::gemm_phase<EpiRes<2>, pg8::StaticOrder, true, true>(lds, g, S, E);
    }
    SEAM(7);
    if (IN(8)) final_norm(args.out, ss3, norm_final, gw, NGW, lane);
#undef IN
#undef SEAM
}

#ifndef N_LAUNCH_MODE
#define N_LAUNCH_MODE 1
#endif
extern "C" void kernel_launch(void* const* d_in, const int* in_sizes, int n_in, void* d_out, int out_size, void* d_ws, size_t ws_size, hipStream_t stream) {
    static int grid = 0;
    if (grid == 0) {
        if (n_in != 19 || ws_size < WS_END || (size_t)out_size != OUT_END) { fprintf(stderr, "kernel_launch: unexpected sizes n_in %d ws %zu out %d\n", n_in, ws_size, out_size); grid = -1; return; }
        int dev = 0, cus = 0, per_cu = 0;
        hipGetDevice(&dev); hipDeviceGetAttribute(&cus, hipDeviceAttributeMultiprocessorCount, dev);
        if (hipFuncSetAttribute((const void*)fwd_kernel, hipFuncAttributeMaxDynamicSharedMemorySize, LDS_BYTES) != hipSuccess) { fprintf(stderr, "kernel_launch: hipFuncSetAttribute failed\n"); grid = -1; return; }
        if (hipOccupancyMaxActiveBlocksPerMultiprocessor(&per_cu, (const void*)fwd_kernel, 512, LDS_BYTES) != hipSuccess || per_cu < 1) { fprintf(stderr, "kernel_launch: occupancy query says %d\n", per_cu); per_cu = 1; }
        (void)hipGetLastError();
        grid = cus * per_cu;
    }
    if (grid < 0) return;
    Args a{};
    for (int i = 0; i < 19; ++i) a.in[i] = (const float*)d_in[i];
    a.out = (float*)d_out; a.ws = (unsigned char*)d_ws;
#if N_LAUNCH_MODE == 1
    a.ph_lo = 0; a.ph_hi = 9;
    void* kargs[] = {&a};
    hipError_t e = hipLaunchCooperativeKernel((const void*)fwd_kernel, dim3(grid), dim3(512), kargs, LDS_BYTES, stream);
    if (e != hipSuccess) fprintf(stderr, "cooperative launch failed: %s (grid %d)\n", hipGetErrorString(e), grid);
#else
    for (int p = 0; p < 9; ++p) { a.ph_lo = p; a.ph_hi = p + 1; hipLaunchKernelGGL(fwd_kernel, dim3(grid), dim3(512), LDS_BYTES, stream, a); }
#endif
}
```

```cpp
#include <hip/hip_runtime.h>
#include <hip/hip_cooperative_groups.h>
#include <cstdio>
#include <cstdint>
namespace cg = cooperative_groups;
namespace pg8 {
#define PG8_LAS __attribute__((address_space(3)))
typedef unsigned short bf16_t;
typedef short bf16x8 __attribute__((ext_vector_type(8)));
typedef float f32x4 __attribute__((ext_vector_type(4)));
typedef unsigned u32x4 __attribute__((ext_vector_type(4)));
constexpr int BM = 256, BK = 64, HALF = 128, HTB = HALF * BK * 2  , STAGE_BYTES = 8 * HTB, NXCD = 8, WGM = 8;

__host__ __device__ __forceinline__ int lds_byte(int r, int c) { const int st = (r >> 4) * 2 + (c >> 5), rr = r & 15, cc = c & 31, ob = rr * 64 + cc * 2; return st * 1024 + (ob ^ (((ob >> 9) & 1) << 5)); }
__host__ __device__ __forceinline__ void stage_rc(int b, int& R, int& C) { const int st = b / 1024, sb = b % 1024, swz = sb ^ (((sb >> 9) & 1) << 5); R = (st >> 1) * 16 + swz / 64; C = (st & 1) * 32 + (swz % 64) / 2; }
__host__ __device__ __forceinline__ int perm32(int rho) { const int n = rho >> 4, i = rho & 15; return 8 * (i >> 2) + 4 * n + (i & 3); }

struct Unit { int pm, pn; };
struct Gemm { const bf16_t* A; const bf16_t* Bt; int M, N, K; };

struct StaticOrder {
    int nM, nN, nwg, G, c;
    __host__ __device__ void init(int M, int N, int G_, int c_) { nM = M / BM; nN = N / BM; nwg = nM * nN; G = G_; c = c_; }
    __host__ __device__ bool next(int i, Unit& u) const {
        const long L = (long)i * G + c; if (L >= nwg) return false;
        int wgid = (int)L; { const int q = nwg / NXCD, r = nwg % NXCD, xcd = wgid % NXCD, off = wgid / NXCD; wgid = (xcd < r ? xcd * (q + 1) : r * (q + 1) + (xcd - r) * q) + off; }
        const int nig = WGM * nN, gid = wgid / nig, fm = gid * WGM, gsz = (nM - fm) < WGM ? (nM - fm) : WGM;
        u.pm = fm + ((wgid % nig) % gsz); u.pn = (wgid % nig) / gsz; return true;
    }
    __device__ __forceinline__ void a_ready(const Unit&) const {}
    __device__ __forceinline__ void done(const Unit&) const {}
};

typedef float cvt_f32x2_t __attribute__((ext_vector_type(2))); typedef __bf16 cvt_bf16x2_t __attribute__((ext_vector_type(2)));
__device__ __forceinline__ unsigned cvt_pk_bf16(float lo, float hi) { cvt_f32x2_t v = {lo, hi}; cvt_bf16x2_t b = __builtin_convertvector(v, cvt_bf16x2_t); return __builtin_bit_cast(unsigned, b); }
template <class Epi, class Sched, bool ALIGN_EPI = false, bool SP2 = false>
__device__ __forceinline__ void gemm_phase(PG8_LAS unsigned char* lds, const Gemm g, const Sched& S, const Epi& E) {
    const int tid = threadIdx.x, wid = __builtin_amdgcn_readfirstlane(tid >> 6), lane = tid & 63, wr = wid >> 2, wc = wid & 3, fr = lane & 15, fq = lane >> 4;
    const int K = g.K, nt = K / BK;
    unsigned voffA[2], voffB[2];
#pragma unroll
    for (int i = 0; i < 2; ++i) { int R, C; stage_rc(tid * 16 + i * 8192, R, C); const int Rb = Epi::PERM ? ((R & ~31) + perm32(R & 31)) : R;
        voffA[i] = (unsigned)(R * K + C) * 2u; voffB[i] = (unsigned)(Rb * K + C) * 2u; }
    const size_t kstep = (size_t)(BK * 2);
    const size_t hstep = (size_t)HALF * K * 2;
    const size_t tstep = 2 * hstep;
    const unsigned ldsw = (unsigned)wid * 1024u;
    const int aoff = lds_byte(wr * 64 + fr, fq * 8), boff = lds_byte(wc * 32 + fr, fq * 8);
#define PG8_SA(b, h) (((b) * 2 + (h)) * HTB)
#define PG8_SB(b, h) ((4 + (b) * 2 + (h)) * HTB)
#define PG8_STAGE(bufoff, gbase, voff) do { _Pragma("unroll") for (int _i = 0; _i < 2; ++_i) \
        __builtin_amdgcn_global_load_lds((const unsigned*)((const char*)(gbase) + (voff)[_i]), (PG8_LAS unsigned*)(lds + (bufoff) + ldsw + _i * 8192), 16, 0, 0); } while (0)
#define PG8_LDA(dst, b, h) do { _Pragma("unroll") for (int m = 0; m < 4; ++m) _Pragma("unroll") for (int k = 0; k < 2; ++k) dst[m][k] = *(const PG8_LAS bf16x8*)(lds + PG8_SA(b, h) + aoff + m * 2048 + k * 1024); } while (0)
#define PG8_LDB(dst, b, h) do { _Pragma("unroll") for (int n = 0; n < 2; ++n) _Pragma("unroll") for (int k = 0; k < 2; ++k) dst[n][k] = *(const PG8_LAS bf16x8*)(lds + PG8_SB(b, h) + boff + n * 2048 + k * 1024); } while (0)
#define PG8_MMA(ai, bj, At, Bt) do { __builtin_amdgcn_s_setprio(1); _Pragma("unroll") for (int m = 0; m < 4; ++m) _Pragma("unroll") for (int n = 0; n < 2; ++n) _Pragma("unroll") for (int k = 0; k < 2; ++k) \
        acc[ai][bj][m][n] = __builtin_amdgcn_mfma_f32_16x16x32_bf16(Bt[n][k], At[m][k], acc[ai][bj][m][n], 0, 0, 0); __builtin_amdgcn_s_setprio(0); } while (0)
#define PG8_WAIT_V(n) asm volatile("s_waitcnt vmcnt(" #n ")" ::: "memory")
#define PG8_WAIT_L(n) asm volatile("s_waitcnt lgkmcnt(" #n ")" ::: "memory")
#define PG8_BAR __builtin_amdgcn_s_barrier()
#define PG8_SCHED __builtin_amdgcn_sched_barrier(0)
    Unit cur, nxt; int ui = 0;
    if (!S.next(0, cur)) return;
    f32x4 acc[2][2][4][2];
#pragma unroll
    for (int a = 0; a < 2; ++a)
#pragma unroll
        for (int b = 0; b < 2; ++b)
#pragma unroll
            for (int m = 0; m < 4; ++m)
#pragma unroll
                for (int n = 0; n < 2; ++n) acc[a][b][m][n] = (f32x4){0.f, 0.f, 0.f, 0.f};
    bf16x8 At[4][2], B0[2][2], B1[2][2];
    const char* cA = (const char*)g.A + (size_t)cur.pm * tstep; const char* cB = (const char*)g.Bt + (size_t)cur.pn * tstep;
    S.a_ready(cur);
    if constexpr (SP2) {
        PG8_STAGE(PG8_SB(0, 0), cB, voffB); PG8_STAGE(PG8_SB(0, 1), cB + hstep, voffB); PG8_STAGE(PG8_SA(0, 0), cA, voffA); PG8_STAGE(PG8_SA(0, 1), cA + hstep, voffA);
        if (wr == 1) PG8_BAR;
        PG8_WAIT_V(2); PG8_BAR;
        PG8_STAGE(PG8_SB(1, 0), cB + kstep, voffB); PG8_STAGE(PG8_SA(1, 0), cA + kstep, voffA); PG8_STAGE(PG8_SB(1, 1), cB + hstep + kstep, voffB);
        PG8_WAIT_V(6); PG8_BAR;
    } else {
        PG8_STAGE(PG8_SB(0, 0), cB, voffB); PG8_STAGE(PG8_SA(0, 0), cA, voffA); PG8_STAGE(PG8_SB(0, 1), cB + hstep, voffB); PG8_STAGE(PG8_SA(0, 1), cA + hstep, voffA);
        if (wr == 1) PG8_BAR;
        PG8_WAIT_V(4); PG8_BAR;
        PG8_STAGE(PG8_SB(1, 0), cB + kstep, voffB); PG8_STAGE(PG8_SA(1, 0), cA + kstep, voffA); PG8_STAGE(PG8_SB(1, 1), cB + hstep + kstep, voffB);
        PG8_WAIT_V(6); PG8_BAR;
    }
    for (;;) {
        const bool has_next = S.next(ui + 1, nxt);
        const char* nA = has_next ? (const char*)g.A + (size_t)nxt.pm * tstep : cA; const char* nB = has_next ? (const char*)g.Bt + (size_t)nxt.pn * tstep : cB;
        for (int t = 0; t < nt; t += 2) {
            const bool last = (t == nt - 2);
            const char* a1 = cA + (size_t)(t + 1) * kstep;
            const char* a2 = last ? nA : cA + (size_t)(t + 2) * kstep; const char* b2 = last ? nB : cB + (size_t)(t + 2) * kstep;
            const char* a3 = a2 + kstep; const char* b3 = b2 + kstep;
            if (last && has_next) S.a_ready(nxt);
            if constexpr (SP2) {
            PG8_LDB(B0, 0, 0); PG8_LDB(B1, 0, 1); PG8_SCHED; PG8_LDA(At, 0, 0); PG8_STAGE(PG8_SA(1, 1), a1 + hstep, voffA);
            PG8_WAIT_V(8); PG8_WAIT_L(0); PG8_BAR; PG8_MMA(0, 0, At, B0); PG8_MMA(0, 1, At, B1); PG8_BAR; PG8_SCHED;
            PG8_LDA(At, 0, 1); PG8_STAGE(PG8_SB(0, 0), b2, voffB); PG8_STAGE(PG8_SB(0, 1), b2 + hstep, voffB); PG8_STAGE(PG8_SA(0, 0), a2, voffA);
            PG8_WAIT_V(8); PG8_WAIT_L(0); PG8_BAR; PG8_MMA(1, 0, At, B0); PG8_MMA(1, 1, At, B1); PG8_BAR; PG8_SCHED;
            PG8_LDB(B0, 1, 0); PG8_LDB(B1, 1, 1); PG8_SCHED; PG8_LDA(At, 1, 0); PG8_STAGE(PG8_SA(0, 1), a2 + hstep, voffA);
            PG8_WAIT_V(8); PG8_WAIT_L(0); PG8_BAR; PG8_MMA(0, 0, At, B0); PG8_MMA(0, 1, At, B1); PG8_BAR; PG8_SCHED;
            PG8_LDA(At, 1, 1); PG8_STAGE(PG8_SB(1, 0), b3, voffB); PG8_STAGE(PG8_SB(1, 1), b3 + hstep, voffB); PG8_STAGE(PG8_SA(1, 0), a3, voffA);
            PG8_WAIT_V(8); PG8_WAIT_L(0); PG8_BAR; PG8_MMA(1, 0, At, B0); PG8_MMA(1, 1, At, B1); PG8_BAR; PG8_SCHED;
            } else {
            PG8_LDB(B0, 0, 0); PG8_SCHED; PG8_LDA(At, 0, 0); PG8_STAGE(PG8_SA(1, 1), a1 + hstep, voffA);
            PG8_WAIT_L(8); PG8_BAR; PG8_WAIT_L(0); PG8_MMA(0, 0, At, B0); PG8_BAR; PG8_SCHED;
            PG8_LDB(B1, 0, 1); PG8_STAGE(PG8_SB(0, 0), b2, voffB);
            PG8_BAR; PG8_WAIT_L(0); PG8_MMA(0, 1, At, B1); PG8_BAR;
            PG8_LDA(At, 0, 1); PG8_STAGE(PG8_SA(0, 0), a2, voffA);
            PG8_BAR; PG8_WAIT_L(0); PG8_MMA(1, 0, At, B0); PG8_BAR; PG8_SCHED;
            PG8_STAGE(PG8_SB(0, 1), b2 + hstep, voffB);
            PG8_WAIT_V(6); PG8_BAR; PG8_MMA(1, 1, At, B1); PG8_BAR;
            PG8_LDB(B0, 1, 0); PG8_SCHED; PG8_LDA(At, 1, 0); PG8_STAGE(PG8_SA(0, 1), a2 + hstep, voffA);
            PG8_WAIT_L(8); PG8_BAR; PG8_WAIT_L(0); PG8_MMA(0, 0, At, B0); PG8_BAR; PG8_SCHED;
            PG8_LDB(B1, 1, 1); PG8_STAGE(PG8_SB(1, 0), b3, voffB);
            PG8_BAR; PG8_WAIT_L(0); PG8_MMA(0, 1, At, B1); PG8_BAR;
            PG8_LDA(At, 1, 1); PG8_STAGE(PG8_SA(1, 0), a3, voffA);
            PG8_BAR; PG8_WAIT_L(0); PG8_MMA(1, 0, At, B0); PG8_BAR; PG8_SCHED;
            PG8_STAGE(PG8_SB(1, 1), b3 + hstep, voffB);
            PG8_WAIT_V(6); PG8_BAR; PG8_MMA(1, 1, At, B1); PG8_BAR;
            }
        }
        if constexpr (ALIGN_EPI) { if (wr == 0) PG8_BAR; }
        if constexpr (!Epi::AFTER_DRAIN) { E(acc, cur, wr, wc, fr, fq); S.done(cur); }
        if (!has_next) break;
#pragma unroll
        for (int a = 0; a < 2; ++a)
#pragma unroll
            for (int b = 0; b < 2; ++b)
#pragma unroll
                for (int m = 0; m < 4; ++m)
#pragma unroll
                    for (int n = 0; n < 2; ++n) acc[a][b][m][n] = (f32x4){0.f, 0.f, 0.f, 0.f};
        cur = nxt; cA = nA; cB = nB; ++ui;
        if constexpr (ALIGN_EPI) { if (wr == 1) PG8_BAR; }
    }
    PG8_WAIT_V(0);
    if constexpr (!ALIGN_EPI) { if (wr == 0) PG8_BAR; }
    PG8_BAR;
    if constexpr (Epi::AFTER_DRAIN) { E.fused(acc, cur, wr, wc, fr, fq, lds, wid, lane); S.done(cur); }
#undef PG8_SA
#undef PG8_SB
#undef PG8_STAGE
#undef PG8_LDA
#undef PG8_LDB
#undef PG8_MMA
#undef PG8_WAIT_V
#undef PG8_WAIT_L
#undef PG8_BAR
#undef PG8_SCHED
}
}
using pg8::bf16_t; using pg8::f32x4; using pg8::bf16x8; using pg8::u32x4; using pg8::Unit; using pg8::cvt_pk_bf16;
#define LAS __attribute__((address_space(3)))
typedef unsigned u32x2 __attribute__((ext_vector_type(2)));
typedef float f32x2 __attribute__((ext_vector_type(2)));
constexpr int DM = 1024, NBP = 32, SEQ = 2048, NMETA = 16, LP = SEQ + NMETA, NBS = 32, DSEQ = 64;
constexpr int MP = NBP * LP, MS = NBS * DSEQ, M = MP + MS;
constexpr int FF = 2816, NUP = 2 * FF, NIN = 3328, DIN = 3088;
constexpr int NH = 4, DK = 64, DV = 128;
constexpr float EPS = 1e-6f;
static_assert(M % 256 == 0, "M");
constexpr size_t OUT_YP = 0, OUT_YS = (size_t)NBP * SEQ * DM, OUT_SP = OUT_YS + (size_t)MS * DM, OUT_CP = OUT_SP + (size_t)NBP * NH * DK * DV,
                 OUT_SS = OUT_CP + (size_t)NBP * 2 * 512, OUT_CS = OUT_SS + (size_t)NBS * NH * DK * DV, OUT_END = OUT_CS + (size_t)NBS * 2 * 512;
constexpr size_t MiB = 1u << 20;
constexpr size_t WS_SS = 0, SS_STRIDE = 512 * 1024;
constexpr size_t WS_WUP1 = 2 * MiB, WS_WDN1 = 13 * MiB, WS_WIN = 19 * MiB, WS_WOUT = 26 * MiB, WS_WUP2 = 28 * MiB, WS_WDN2 = 39 * MiB;
constexpr size_t WS_XB = 48 * MiB;
constexpr size_t WS_ACT = 184 * MiB;
constexpr size_t WS_QK = 184 * MiB, WS_U = 450 * MiB, WS_LA = 517 * MiB;
constexpr size_t WS_MIX = 584 * MiB, WS_END = 718 * MiB;
static_assert(WS_ACT + (size_t)M * FF * 2 <= WS_MIX && WS_LA + (size_t)M * 256 * 4 <= WS_MIX && WS_U + (size_t)M * 512 * 2 <= WS_LA && WS_QK + (size_t)M * 2048 * 2 <= WS_U, "ws map");
static_assert(WS_XB + (size_t)M * DM * 2 <= WS_ACT && WS_MIX + (size_t)M * DM * 2 <= WS_END && WS_WDN2 + (size_t)DM * FF * 2 <= WS_XB, "ws map");

__device__ __forceinline__ const float* xin_row(const float* xp, const float* meta, const float* xs, int R) {
    if (R < MP) { const int b = R / LP, t = R - b * LP; return t < NMETA ? meta + (size_t)t * DM : xp + ((size_t)b * SEQ + (t - NMETA)) * DM; }
    return xs + (size_t)(R - MP) * DM;
}
__device__ __forceinline__ float* yout_row(float* out, int R) {
    if (R < MP) { const int b = R / LP, t = R - b * LP; return t < NMETA ? nullptr : out + ((size_t)b * SEQ + (t - NMETA)) * DM; }
    return out + OUT_YS + (size_t)(R - MP) * DM;
}
__device__ __forceinline__ float bf_lo(unsigned w) { return __uint_as_float(w << 16); }
__device__ __forceinline__ float bf_hi(unsigned w) { return __uint_as_float(w & 0xffff0000u); }
__device__ __forceinline__ float silu_f(float g) { return g * __builtin_amdgcn_rcpf(1.f + __expf(-g)); }
__device__ __forceinline__ float wave_sum(float v) {
#pragma unroll
    for (int o = 1; o < 64; o <<= 1) v += __shfl_xor(v, o);
    return v;
}

struct EpiUp {
    static constexpr bool PERM = true, AFTER_DRAIN = false;
    bf16_t* O; const float* ss;
    __device__ __forceinline__ void operator()(const f32x4 (&acc)[2][2][4][2], const Unit& u, int wr, int wc, int fr, int fq) const {
        const int row0 = u.pm * 256 + wr * 64 + fr, col0 = u.pn * 128 + wc * 32 + 8 * fq;
#pragma unroll
        for (int ai = 0; ai < 2; ++ai)
#pragma unroll
            for (int m = 0; m < 4; ++m) {
                const int row = row0 + ai * 128 + m * 16;
                const float rs = rsqrtf(ss[row] * (1.0f / DM) + EPS);
                float o[8];
#pragma unroll
                for (int n = 0; n < 2; ++n)
#pragma unroll
                    for (int j = 0; j < 4; ++j) { const float g = acc[ai][0][m][n][j] * rs, up = acc[ai][1][m][n][j] * rs; o[4 * n + j] = silu_f(g) * up; }
                u32x4 w; w.x = cvt_pk_bf16(o[0], o[1]); w.y = cvt_pk_bf16(o[2], o[3]); w.z = cvt_pk_bf16(o[4], o[5]); w.w = cvt_pk_bf16(o[6], o[7]);
                *(u32x4*)(O + (size_t)row * FF + col0) = w;
            }
    }
};
template <int MODE> struct EpiRes {
    static constexpr bool PERM = true, AFTER_DRAIN = false;
    const float *xp, *meta, *xs; bf16_t* XB; float* out; float* ss;
    __device__ __forceinline__ void operator()(const f32x4 (&acc)[2][2][4][2], const Unit& u, int wr, int wc, int fr, int fq) const {
        const float alpha = (MODE == 1) ? 1.0f : 0.5f;
#pragma unroll
        for (int ai = 0; ai < 2; ++ai)
#pragma unroll
            for (int m = 0; m < 4; ++m) {
                const int row = u.pm * 256 + ai * 128 + wr * 64 + m * 16 + fr;
                const float* xr = nullptr; float* yr = nullptr;
                if (MODE == 0) xr = xin_row(xp, meta, xs, row);
                if (MODE == 2) yr = yout_row(out, row);
                float sq = 0.f;
#pragma unroll
                for (int bj = 0; bj < 2; ++bj) {
                    const int col = u.pn * 256 + bj * 128 + wc * 32 + 8 * fq;
                    f32x4 b0, b1;
                    if (MODE == 0) { b0 = *(const f32x4*)(xr + col); b1 = *(const f32x4*)(xr + col + 4); }
                    else { const u32x4 w = *(const u32x4*)(XB + (size_t)row * DM + col);
                        b0 = (f32x4){bf_lo(w.x), bf_hi(w.x), bf_lo(w.y), bf_hi(w.y)}; b1 = (f32x4){bf_lo(w.z), bf_hi(w.z), bf_lo(w.w), bf_hi(w.w)}; }
                    const f32x4 v0 = b0 + acc[ai][bj][m][0] * alpha, v1 = b1 + acc[ai][bj][m][1] * alpha;
                    sq += (v0[0] * v0[0] + v0[1] * v0[1]) + (v0[2] * v0[2] + v0[3] * v0[3]) + (v1[0] * v1[0] + v1[1] * v1[1]) + (v1[2] * v1[2] + v1[3] * v1[3]);
                    if (MODE < 2) { u32x4 w; w.x = cvt_pk_bf16(v0[0], v0[1]); w.y = cvt_pk_bf16(v0[2], v0[3]); w.z = cvt_pk_bf16(v1[0], v1[1]); w.w = cvt_pk_bf16(v1[2], v1[3]);
                        *(u32x4*)(XB + (size_t)row * DM + col) = w; }
                    else if (yr) { *(f32x4*)(yr + col) = v0; *(f32x4*)(yr + col + 4) = v1; }
                }
                sq += __shfl_xor(sq, 16); sq += __shfl_xor(sq, 32);
                if (fq == 0) unsafeAtomicAdd(ss + row, sq);
            }
    }
};
__device__ __forceinline__ float log_sigmoid_f(float z) { const float e = __expf(-fabsf(z)); return fminf(z, 0.f) - __logf(1.f + e); }
struct EpiWin {
    static constexpr bool PERM = true, AFTER_DRAIN = false;
    bf16_t* QK; bf16_t* U; float* LA; const float* ss; const float* b_a;
    __device__ __forceinline__ void operator()(const f32x4 (&acc)[2][2][4][2], const Unit& u, int wr, int wc, int fr, int fq) const {
        const int pn = u.pn;
#pragma unroll
        for (int ai = 0; ai < 2; ++ai)
#pragma unroll
            for (int m = 0; m < 4; ++m) {
                const int row = u.pm * 256 + ai * 128 + wr * 64 + m * 16 + fr;
                const float rs = rsqrtf(ss[row] * (1.0f / DM) + EPS);
                if (pn < 8) {
                    const float sc = (pn == 0) ? rs * 0.125f : rs;
#pragma unroll
                    for (int bj = 0; bj < 2; ++bj) { const f32x4 v0 = acc[ai][bj][m][0] * sc, v1 = acc[ai][bj][m][1] * sc;
                        u32x4 w; w.x = cvt_pk_bf16(v0[0], v0[1]); w.y = cvt_pk_bf16(v0[2], v0[3]); w.z = cvt_pk_bf16(v1[0], v1[1]); w.w = cvt_pk_bf16(v1[2], v1[3]);
                        *(u32x4*)(QK + (size_t)row * 2048 + pn * 256 + bj * 128 + wc * 32 + 8 * fq) = w; }
                } else if (pn < 12) {
                    const float r2 = rs * rs;
                    const f32x4 v0 = acc[ai][0][m][0] * acc[ai][1][m][0] * r2, v1 = acc[ai][0][m][1] * acc[ai][1][m][1] * r2;
                    u32x4 w; w.x = cvt_pk_bf16(v0[0], v0[1]); w.y = cvt_pk_bf16(v0[2], v0[3]); w.z = cvt_pk_bf16(v1[0], v1[1]); w.w = cvt_pk_bf16(v1[2], v1[3]);
                    *(u32x4*)(U + (size_t)row * 512 + (pn - 8) * 128 + wc * 32 + 8 * fq) = w;
                } else {
#pragma unroll
                    for (int bj = 0; bj < 2; ++bj)
#pragma unroll
                        for (int n = 0; n < 2; ++n) { const int c = bj * 128 + wc * 32 + 8 * fq + 4 * n; const f32x4 bb = *(const f32x4*)(b_a + c); f32x4 o;
#pragma unroll
                            for (int j = 0; j < 4; ++j) o[j] = log_sigmoid_f(acc[ai][bj][m][n][j] * rs + bb[j]) * (1.0f / 16.0f);
                            *(f32x4*)(LA + (size_t)row * 256 + c) = o; }
                }
            }
    }
};
__device__ __forceinline__ void tr_item(const float* W, int ldw, int src_col0, const float* gain, bf16_t* WT, int K, int dst_row0, int k0, LAS float* scr, int lane) {
#pragma unroll 8
    for (int i = 0; i < 32; ++i) { const int kk = 2 * i + (lane >> 5); float w = W[(size_t)(k0 + kk) * ldw + src_col0 + (lane & 31)]; if (gain) w *= gain[k0 + kk]; scr[kk * 33 + (lane & 31)] = w; }
    asm volatile("s_waitcnt lgkmcnt(0)" ::: "memory");
    const int c = lane & 7;
#pragma unroll
    for (int j = 0; j < 4; ++j) { const int n = (lane >> 3) + 8 * j; const LAS float* s = scr + (8 * c) * 33 + n;
        u32x4 o; o.x = cvt_pk_bf16(s[0 * 33], s[1 * 33]); o.y = cvt_pk_bf16(s[2 * 33], s[3 * 33]); o.z = cvt_pk_bf16(s[4 * 33], s[5 * 33]); o.w = cvt_pk_bf16(s[6 * 33], s[7 * 33]);
        *(u32x4*)(WT + (size_t)(dst_row0 + n) * K + k0 + 8 * c) = o; }
    asm volatile("s_waitcnt lgkmcnt(0)" ::: "memory");
}
__device__ __forceinline__ int up_src_col(int n) { const int pn = n >> 8, within = n & 255; return (within >> 7) * FF + 128 * pn + (within & 127); }
__device__ __forceinline__ int win_src_col(int n) {
    if (n < 1536) return n;
    if (n < 2048) return n + 16;
    const int j = (n - 2048) >> 8, within = (n - 2048) & 255;
    return ((within >> 7) ? 2576 : 2064) + 128 * j + (within & 127);
}
struct P0Args { const float *xp, *xs, *meta, *n1, *wu1, *wd1, *n2, *win, *wa2, *wout, *n3, *wu2, *wd2; unsigned char* ws; };
__device__ __forceinline__ void p0_prologue(const P0Args& a, LAS unsigned char* lds, int gw, int NGW, int wave, int lane) {
    LAS float* scr = (LAS float*)(lds + wave * 8704);
    constexpr int I_UP = (DM / 64) * (NUP / 32), I_DN = (FF / 64) * (DM / 32), I_IN = (DM / 64) * (3072 / 32), I_OUT = (DM / 64) * (DM / 32);
    constexpr int NITEMS = 2 * I_UP + 2 * I_DN + I_IN + I_OUT;
    bf16_t* WUP1 = (bf16_t*)(a.ws + WS_WUP1); bf16_t* WDN1 = (bf16_t*)(a.ws + WS_WDN1); bf16_t* WIN = (bf16_t*)(a.ws + WS_WIN);
    bf16_t* WOUT = (bf16_t*)(a.ws + WS_WOUT); bf16_t* WUP2 = (bf16_t*)(a.ws + WS_WUP2); bf16_t* WDN2 = (bf16_t*)(a.ws + WS_WDN2);
    for (int it = gw; it < NITEMS; it += NGW) {
        int r = it;
        if (r < 2 * I_UP) { const bool second = r >= I_UP; if (second) r -= I_UP; const int nblk = NUP / 32, kb = r / nblk, nb = r % nblk;
            tr_item(second ? a.wu2 : a.wu1, NUP, up_src_col(32 * nb), second ? a.n3 : a.n1, second ? WUP2 : WUP1, DM, 32 * nb, 64 * kb, scr, lane); continue; }
        r -= 2 * I_UP;
        if (r < 2 * I_DN) { const bool second = r >= I_DN; if (second) r -= I_DN; const int nblk = DM / 32, kb = r / nblk, nb = r % nblk;
            tr_item(second ? a.wd2 : a.wd1, DM, 32 * nb, nullptr, second ? WDN2 : WDN1, FF, 32 * nb, 64 * kb, scr, lane); continue; }
        r -= 2 * I_DN;
        if (r < I_IN) { const int nblk = 3072 / 32, kb = r / nblk, nb = r % nblk;
            tr_item(a.win, DIN, win_src_col(32 * nb), a.n2, WIN, DM, 32 * nb, 64 * kb, scr, lane); continue; }
        r -= I_IN;
        { const int nblk = DM / 32, kb = r / nblk, nb = r % nblk; tr_item(a.wout, DM, 32 * nb, nullptr, WOUT, DM, 32 * nb, 64 * kb, scr, lane); }
    }
    for (int e = gw * 64 + lane; e < 256 * DM; e += NGW * 64) { const int n = e >> 10, k = e & 1023; const float* wr_ = a.win + (size_t)k * DIN + 1536; float s = 0.f;
#pragma unroll
        for (int r = 0; r < 16; ++r) s += wr_[r] * a.wa2[r * 256 + n];
        s *= a.n2[k]; const unsigned short b = (unsigned short)(cvt_pk_bf16(s, 0.f) & 0xffffu); WIN[(size_t)(3072 + n) * DM + k] = b; }
    bf16_t* XB = (bf16_t*)(a.ws + WS_XB); float* ss0 = (float*)(a.ws + WS_SS);
    for (int R = gw; R < M; R += NGW) {
        const f32x4* xr = (const f32x4*)xin_row(a.xp, a.meta, a.xs, R) + lane; f32x4 v[4]; float s = 0.f;
#pragma unroll
        for (int j = 0; j < 4; ++j) { v[j] = xr[64 * j]; s += (v[j][0] * v[j][0] + v[j][1] * v[j][1]) + (v[j][2] * v[j][2] + v[j][3] * v[j][3]); }
        s = wave_sum(s);
        u32x2* o8 = (u32x2*)(XB + (size_t)R * DM) + lane;
#pragma unroll
        for (int j = 0; j < 4; ++j) { u32x2 w; w.x = cvt_pk_bf16(v[j][0], v[j][1]); w.y = cvt_pk_bf16(v[j][2], v[j][3]); o8[64 * j] = w; }
        if (lane == 0) { ss0[R] = s; ss0[R + SS_STRIDE / 4] = 0.f; ss0[R + 2 * (SS_STRIDE / 4)] = 0.f; ss0[R + 3 * (SS_STRIDE / 4)] = 0.f; }
    }
}

struct GlaArgs { const bf16_t* QK; const float* LA; const bf16_t* U; bf16_t* MIX; const float* state_in; const float* cache_conv; const float* g_head; const float* w_conv; float* out; };
constexpr int RS = 144;
constexpr int VRS = 272;
constexpr int L_G = 0, L_VR = 16384, L_QT = 0, L_ATT = 9216, L_KT = 18432, L_KTT = 27648, L_G2 = 36864, L_EGL = 53248, L_SSQ = 53504, L_VT = 54016, L_ST = 72448, ST_BYTES = 128 * RS;
__device__ __forceinline__ bf16x8 ldf(LAS const unsigned char* base, int row, int ks, int fq) { return *(const LAS bf16x8*)(base + row * RS + ks * 64 + fq * 16); }
__device__ __forceinline__ void gla_unit(const GlaArgs& a, LAS unsigned char* lds, int unit, int tid, int wave, int lane) {
    const bool samp = unit >= 128; const int s = (unit & 127) >> 2, h = unit & 3;
    const int L = samp ? DSEQ : LP; const int row0 = samp ? MP + s * DSEQ : s * LP;
    const int fr = lane & 15, fq = lane >> 4, rb = wave & 3, vh = wave >> 2;
    LAS float* G = (LAS float*)(lds + L_G); LAS float* G2 = (LAS float*)(lds + L_G2); LAS float* EGL = (LAS float*)(lds + L_EGL); LAS float* SSQ = (LAS float*)(lds + L_SSQ);
    f32x4 Sacc[4], gh[4];
    const size_t sbase = (size_t)(s * NH + h) * DK * DV;
#pragma unroll
    for (int vt = 0; vt < 4; ++vt) { const int v = 64 * vh + 16 * vt + fr;
#pragma unroll
        for (int jj = 0; jj < 4; ++jj) Sacc[vt][jj] = samp ? a.state_in[sbase + (size_t)(16 * rb + 4 * fq + jj) * DV + v] : 0.f;
        u32x2 w; w.x = cvt_pk_bf16(Sacc[vt][0], Sacc[vt][1]); w.y = cvt_pk_bf16(Sacc[vt][2], Sacc[vt][3]);
        *(LAS u32x2*)(lds + L_ST + v * RS + (16 * rb + 4 * fq) * 2) = w;
        gh[vt] = *(const f32x4*)(a.g_head + 64 * vh + 16 * vt + 4 * fq); }
    const int lt = tid >> 3, ld0 = (tid & 7) * 8;
    const int vt_t = tid >> 4, vc = tid & 15;
    u32x4 pq, pk, pv0, pv1; f32x4 pl0, pl1;
    const u32x4 z4 = (u32x4){0u, 0u, 0u, 0u}; const f32x4 zf = (f32x4){0.f, 0.f, 0.f, 0.f};
#define GLA_ISSUE(T0) do { \
        const int tq_ = (T0) + lt; if (tq_ < L) { const bf16_t* p_ = a.QK + (size_t)(row0 + tq_) * 2048 + h * 64 + ld0; pq = *(const u32x4*)p_; pk = *(const u32x4*)(p_ + 256); } else { pq = z4; pk = z4; } \
        const int ta_ = (T0) + vt_t; if (ta_ < L) { pv0 = *(const u32x4*)(a.QK + (size_t)(row0 + ta_) * 2048 + 512 + h * 128 + vc * 8); pl0 = *(const f32x4*)(a.LA + (size_t)(row0 + ta_) * 256 + h * 64 + vc * 4); } else { pv0 = z4; pl0 = zf; } \
        const int tb_ = ta_ + 32; if (tb_ < L) { pv1 = *(const u32x4*)(a.QK + (size_t)(row0 + tb_) * 2048 + 512 + h * 128 + vc * 8); pl1 = *(const f32x4*)(a.LA + (size_t)(row0 + tb_) * 256 + h * 64 + vc * 4); } else { pv1 = z4; pl1 = zf; } \
    } while (0)
    GLA_ISSUE(0);
    const int nch = (L + 63) >> 6;
    for (int c = 0; c < nch; ++c) {
        const int t0 = c * 64, cur = c & 1;
        __syncthreads();
        *(LAS f32x4*)(G + vt_t * 64 + vc * 4) = pl0; *(LAS f32x4*)(G + (vt_t + 32) * 64 + vc * 4) = pl1;
        *(LAS u32x4*)(lds + L_VR + vt_t * VRS + vc * 16) = pv0; *(LAS u32x4*)(lds + L_VR + (vt_t + 32) * VRS + vc * 16) = pv1;
        __syncthreads();
        { const int d = tid & 63; float run = 0.f;
            for (int t = 0; t < 8 * wave; ++t) run += G[t * 64 + d];
#pragma unroll
            for (int e = 0; e < 8; ++e) { run += G[(8 * wave + e) * 64 + d]; G2[(8 * wave + e) * 64 + d] = run; }
            if (wave == 7) EGL[d] = __expf(run); }
        { const int v = tid & 127, tg = tid >> 7; unsigned w[8];
#pragma unroll
            for (int e = 0; e < 8; ++e) { const unsigned lo = *(const LAS unsigned short*)(lds + L_VR + (16 * tg + 2 * e) * VRS + v * 2), hi = *(const LAS unsigned short*)(lds + L_VR + (16 * tg + 2 * e + 1) * VRS + v * 2); w[e] = lo | (hi << 16); }
            *(LAS u32x4*)(lds + L_VT + v * RS + tg * 32) = (u32x4){w[0], w[1], w[2], w[3]}; *(LAS u32x4*)(lds + L_VT + v * RS + tg * 32 + 16) = (u32x4){w[4], w[5], w[6], w[7]}; }
        __syncthreads();
        { const f32x4 g0 = *(const LAS f32x4*)(G2 + lt * 64 + ld0), g1 = *(const LAS f32x4*)(G2 + lt * 64 + ld0 + 4);
            const float gq[8] = {g0[0], g0[1], g0[2], g0[3], g1[0], g1[1], g1[2], g1[3]};
            const float qv[8] = {bf_lo(pq.x), bf_hi(pq.x), bf_lo(pq.y), bf_hi(pq.y), bf_lo(pq.z), bf_hi(pq.z), bf_lo(pq.w), bf_hi(pq.w)};
            const float kv[8] = {bf_lo(pk.x), bf_hi(pk.x), bf_lo(pk.y), bf_hi(pk.y), bf_lo(pk.z), bf_hi(pk.z), bf_lo(pk.w), bf_hi(pk.w)};
            float qt[8], kt[8];
#pragma unroll
            for (int e = 0; e < 8; ++e) { qt[e] = qv[e] * __expf(gq[e]); kt[e] = kv[e] * __expf(-gq[e]); }
            *(LAS u32x4*)(lds + L_QT + lt * RS + ld0 * 2) = (u32x4){cvt_pk_bf16(qt[0], qt[1]), cvt_pk_bf16(qt[2], qt[3]), cvt_pk_bf16(qt[4], qt[5]), cvt_pk_bf16(qt[6], qt[7])};
            *(LAS u32x4*)(lds + L_KT + lt * RS + ld0 * 2) = (u32x4){cvt_pk_bf16(kt[0], kt[1]), cvt_pk_bf16(kt[2], kt[3]), cvt_pk_bf16(kt[4], kt[5]), cvt_pk_bf16(kt[6], kt[7])}; }
        if (c + 1 < nch) GLA_ISSUE(t0 + 64);
        const int orow = t0 + 16 * rb + fr; const bool ovalid = orow < L;
        u32x2 rg[4];
#pragma unroll
        for (int vt = 0; vt < 4; ++vt) rg[vt] = ovalid ? *(const u32x2*)(a.QK + (size_t)(row0 + orow) * 2048 + 1024 + h * 128 + 64 * vh + 16 * vt + 4 * fq) : (u32x2){0u, 0u};
        __syncthreads();
        { const int d = tid & 63; unsigned w[4];
#pragma unroll
            for (int e = 0; e < 4; ++e) { const unsigned lo = *(const LAS unsigned short*)(lds + L_KT + (8 * wave + 2 * e) * RS + d * 2), hi = *(const LAS unsigned short*)(lds + L_KT + (8 * wave + 2 * e + 1) * RS + d * 2); w[e] = lo | (hi << 16); }
            *(LAS u32x4*)(lds + L_KTT + d * RS + wave * 16) = (u32x4){w[0], w[1], w[2], w[3]}; }
#pragma unroll
        for (int tt = 0; tt < 2; ++tt) { const int tile = 2 * wave + tt, ib = tile >> 2, jb = tile & 3; f32x4 acc = zf;
            if (jb <= ib) {
#pragma unroll
                for (int ks = 0; ks < 2; ++ks) acc = __builtin_amdgcn_mfma_f32_16x16x32_bf16(ldf(lds + L_KT, 16 * jb + fr, ks, fq), ldf(lds + L_QT, 16 * ib + fr, ks, fq), acc, 0, 0, 0);
                if (jb == ib) {
#pragma unroll
                    for (int jj = 0; jj < 4; ++jj) if (4 * fq + jj > fr) acc[jj] = 0.f; } }
            u32x2 w; w.x = cvt_pk_bf16(acc[0], acc[1]); w.y = cvt_pk_bf16(acc[2], acc[3]);
            *(LAS u32x2*)(lds + L_ATT + (16 * ib + fr) * RS + (16 * jb + 4 * fq) * 2) = w; }
        __syncthreads();
        f32x4 o[4]; float sq = 0.f;
        { const bf16x8 ya0 = ldf(lds + L_ATT, 16 * rb + fr, 0, fq), ya1 = ldf(lds + L_ATT, 16 * rb + fr, 1, fq), ya2 = ldf(lds + L_QT, 16 * rb + fr, 0, fq), ya3 = ldf(lds + L_QT, 16 * rb + fr, 1, fq);
            const bf16x8 kx0 = ldf(lds + L_KTT, 16 * rb + fr, 0, fq), kx1 = ldf(lds + L_KTT, 16 * rb + fr, 1, fq);
            const f32x4 eg = *(const LAS f32x4*)(EGL + 16 * rb + 4 * fq);
            LAS const unsigned char* STc = lds + L_ST + cur * ST_BYTES; LAS unsigned char* STn = lds + L_ST + (cur ^ 1) * ST_BYTES;
#pragma unroll
            for (int vt = 0; vt < 4; ++vt) { const int v0 = 64 * vh + 16 * vt;
                const bf16x8 vx0 = ldf(lds + L_VT, v0 + fr, 0, fq), vx1 = ldf(lds + L_VT, v0 + fr, 1, fq), sx0 = ldf(STc, v0 + fr, 0, fq), sx1 = ldf(STc, v0 + fr, 1, fq);
                f32x4 acc = zf;
                acc = __builtin_amdgcn_mfma_f32_16x16x32_bf16(vx0, ya0, acc, 0, 0, 0); acc = __builtin_amdgcn_mfma_f32_16x16x32_bf16(vx1, ya1, acc, 0, 0, 0);
                acc = __builtin_amdgcn_mfma_f32_16x16x32_bf16(sx0, ya2, acc, 0, 0, 0); acc = __builtin_amdgcn_mfma_f32_16x16x32_bf16(sx1, ya3, acc, 0, 0, 0);
                o[vt] = acc; sq += (acc[0] * acc[0] + acc[1] * acc[1]) + (acc[2] * acc[2] + acc[3] * acc[3]);
                f32x4 sa = Sacc[vt];
                sa = __builtin_amdgcn_mfma_f32_16x16x32_bf16(kx0, vx0, sa, 0, 0, 0); sa = __builtin_amdgcn_mfma_f32_16x16x32_bf16(kx1, vx1, sa, 0, 0, 0);
                sa = sa * eg; Sacc[vt] = sa;
                u32x2 w; w.x = cvt_pk_bf16(sa[0], sa[1]); w.y = cvt_pk_bf16(sa[2], sa[3]);
                *(LAS u32x2*)(STn + (v0 + fr) * RS + (16 * rb + 4 * fq) * 2) = w; } }
        sq += __shfl_xor(sq, 16); sq += __shfl_xor(sq, 32);
        if (fq == 0) SSQ[vh * 64 + 16 * rb + fr] = sq;
        __syncthreads();
        { const float rs = rsqrtf((SSQ[16 * rb + fr] + SSQ[64 + 16 * rb + fr]) * (1.0f / DV) + EPS);
            if (ovalid) {
#pragma unroll
                for (int vt = 0; vt < 4; ++vt) { const float r0 = bf_lo(rg[vt].x), r1 = bf_hi(rg[vt].x), r2 = bf_lo(rg[vt].y), r3 = bf_hi(rg[vt].y);
                    u32x2 w; w.x = cvt_pk_bf16(o[vt][0] * rs * gh[vt][0] * silu_f(r0), o[vt][1] * rs * gh[vt][1] * silu_f(r1)); w.y = cvt_pk_bf16(o[vt][2] * rs * gh[vt][2] * silu_f(r2), o[vt][3] * rs * gh[vt][3] * silu_f(r3));
                    *(u32x2*)(a.MIX + (size_t)(row0 + orow) * DM + h * 128 + 64 * vh + 16 * vt + 4 * fq) = w; } } }
    }
#undef GLA_ISSUE
    float* sout = a.out + (samp ? OUT_SS : OUT_SP) + sbase;
#pragma unroll
    for (int vt = 0; vt < 4; ++vt)
#pragma unroll
        for (int jj = 0; jj < 4; ++jj) sout[(size_t)(16 * rb + 4 * fq + jj) * DV + 64 * vh + 16 * vt + fr] = Sacc[vt][jj];
    __syncthreads();
}
__device__ __forceinline__ void conv_pass(const GlaArgs& a, int gtid, int nthreads) {
    for (int item = gtid; item < M * 64; item += nthreads) {
        const int R = item >> 6, c8 = (item & 63) * 8;
        int b, t, L; bool samp = R >= MP;
        if (!samp) { b = R / LP; t = R - b * LP; L = LP; } else { const int r2 = R - MP; b = r2 >> 6; t = r2 & 63; L = DSEQ; }
        float u2[8], u1[8], u0[8], bb[8];
        { const u32x4 w = *(const u32x4*)(a.U + (size_t)R * 512 + c8); u2[0] = bf_lo(w.x); u2[1] = bf_hi(w.x); u2[2] = bf_lo(w.y); u2[3] = bf_hi(w.y); u2[4] = bf_lo(w.z); u2[5] = bf_hi(w.z); u2[6] = bf_lo(w.w); u2[7] = bf_hi(w.w); }
        if (t >= 1) { const u32x4 w = *(const u32x4*)(a.U + (size_t)(R - 1) * 512 + c8); u1[0] = bf_lo(w.x); u1[1] = bf_hi(w.x); u1[2] = bf_lo(w.y); u1[3] = bf_hi(w.y); u1[4] = bf_lo(w.z); u1[5] = bf_hi(w.z); u1[6] = bf_lo(w.w); u1[7] = bf_hi(w.w); }
        else {
#pragma unroll
            for (int j = 0; j < 8; ++j) u1[j] = samp ? a.cache_conv[((size_t)b * 2 + 1) * 512 + c8 + j] : 0.f; }
        if (t >= 2) { const u32x4 w = *(const u32x4*)(a.U + (size_t)(R - 2) * 512 + c8); u0[0] = bf_lo(w.x); u0[1] = bf_hi(w.x); u0[2] = bf_lo(w.y); u0[3] = bf_hi(w.y); u0[4] = bf_lo(w.z); u0[5] = bf_hi(w.z); u0[6] = bf_lo(w.w); u0[7] = bf_hi(w.w); }
        else {
#pragma unroll
            for (int j = 0; j < 8; ++j) u0[j] = samp ? a.cache_conv[((size_t)b * 2 + t) * 512 + c8 + j] : 0.f; }
        { const u32x4 w = *(const u32x4*)(a.QK + (size_t)R * 2048 + 1536 + c8); bb[0] = bf_lo(w.x); bb[1] = bf_hi(w.x); bb[2] = bf_lo(w.y); bb[3] = bf_hi(w.y); bb[4] = bf_lo(w.z); bb[5] = bf_hi(w.z); bb[6] = bf_lo(w.w); bb[7] = bf_hi(w.w); }
        float o[8];
#pragma unroll
        for (int j = 0; j < 8; ++j) o[j] = bb[j] * (a.w_conv[c8 + j] * u0[j] + a.w_conv[512 + c8 + j] * u1[j] + a.w_conv[1024 + c8 + j] * u2[j]);
        u32x4 w; w.x = cvt_pk_bf16(o[0], o[1]); w.y = cvt_pk_bf16(o[2], o[3]); w.z = cvt_pk_bf16(o[4], o[5]); w.w = cvt_pk_bf16(o[6], o[7]);
        *(u32x4*)(a.MIX + (size_t)R * DM + 512 + c8) = w;
        if (t >= L - 2) { float* oc = a.out + (samp ? OUT_CS : OUT_CP) + ((size_t)b * 2 + (t - (L - 2))) * 512 + c8;
            *(f32x4*)oc = (f32x4){u2[0], u2[1], u2[2], u2[3]}; *(f32x4*)(oc + 4) = (f32x4){u2[4], u2[5], u2[6], u2[7]}; }
    }
}
__device__ __forceinline__ void final_norm(float* out, const float* ss3, const float* gfin, int gw, int NGW, int lane) {
    constexpr int NR = NBP * SEQ + MS;
    f32x4 g[4];
#pragma unroll
    for (int j = 0; j < 4; ++j) g[j] = ((const f32x4*)gfin)[lane + 64 * j];
    for (int Rp = gw; Rp < NR; Rp += NGW) {
        int R; if (Rp < NBP * SEQ) { const int b = Rp >> 11, t = Rp & 2047; R = b * LP + NMETA + t; } else R = MP + (Rp - NBP * SEQ);
        const float rs = rsqrtf(ss3[R] * (1.0f / DM) + EPS);
        f32x4* yr = (f32x4*)(out + (size_t)Rp * DM) + lane;
#pragma unroll
        for (int j = 0; j < 4; ++j) { f32x4 v = yr[64 * j]; v = v * rs * g[j]; yr[64 * j] = v; }
    }
}

struct Args { const float* in[19]; float* out; unsigned char* ws; int ph_lo, ph_hi; };
constexpr int LDS_BYTES = 147456;
__global__ void __launch_bounds__(512, 2) fwd_kernel(Args args) {
    extern __shared__ __attribute__((aligned(16))) unsigned char lds_raw[];
    LAS unsigned char* lds = (LAS unsigned char*)lds_raw;
    cg::grid_group grid = cg::this_grid();
    const int tid = threadIdx.x, lane = tid & 63, wave = __builtin_amdgcn_readfirstlane(tid >> 6);
    const int G = gridDim.x, bx = blockIdx.x;
    const int gw = bx * 8 + wave, NGW = G * 8;
    unsigned char* ws = args.ws;
    const float *x_prompt = args.in[0], *x_sample = args.in[1], *state_gla = args.in[2], *cache_conv = args.in[3], *meta = args.in[4], *norm_ffn1 = args.in[5], *w_up1 = args.in[6], *w_down1 = args.in[7],
                *norm_mix = args.in[8], *w_in = args.in[9], *w_a2 = args.in[10], *b_a = args.in[11], *g_head = args.in[12], *w_conv = args.in[13], *w_out = args.in[14], *norm_ffn2 = args.in[15],
                *w_up2 = args.in[16], *w_down2 = args.in[17], *norm_final = args.in[18];
    bf16_t* XB = (bf16_t*)(ws + WS_XB); bf16_t* ACT = (bf16_t*)(ws + WS_ACT); bf16_t* QK = (bf16_t*)(ws + WS_QK); bf16_t* U = (bf16_t*)(ws + WS_U); float* LA = (float*)(ws + WS_LA); bf16_t* MIX = (bf16_t*)(ws + WS_MIX);
    float* ss0 = (float*)(ws + WS_SS); float* ss1 = ss0 + SS_STRIDE / 4; float* ss2 = ss1 + SS_STRIDE / 4; float* ss3 = ss2 + SS_STRIDE / 4;
    const int lo = args.ph_lo, hi = args.ph_hi;
#define IN(k) (lo <= (k) && (k) < hi)
#define SEAM(k) do { if (IN(k) && IN((k) + 1)) { asm volatile("s_waitcnt vmcnt(0) lgkmcnt(0)" ::: "memory"); grid.sync(); __builtin_amdgcn_fence(__ATOMIC_ACQUIRE, "agent"); asm volatile("s_waitcnt vmcnt(0)" ::: "memory"); } } while (0)
    if (IN(0)) {
        P0Args pa{x_prompt, x_sample, meta, norm_ffn1, w_up1, w_down1, norm_mix, w_in, w_a2, w_out, norm_ffn2, w_up2, w_down2, ws};
        p0_prologue(pa, lds, gw, NGW, wave, lane);
    }
    SEAM(0);
    if (IN(1)) {
        pg8::Gemm g{XB, (const bf16_t*)(ws + WS_WUP1), M, NUP, DM}; pg8::StaticOrder S; S.init(M, NUP, G, bx);
        EpiUp E{ACT, ss0};
        pg8::gemm_phase<EpiUp, pg8::StaticOrder, true, true>(lds, g, S, E);
    }
    SEAM(1);
    if (IN(2)) {
        pg8::Gemm g{ACT, (const bf16_t*)(ws + WS_WDN1), M, DM, FF}; pg8::StaticOrder S; S.init(M, DM, G, bx);
        EpiRes<0> E{x_prompt, meta, x_sample, XB, args.out, ss1};
        pg8::gemm_phase<EpiRes<0>, pg8::StaticOrder, true, true>(lds, g, S, E);
    }
    SEAM(2);
    if (IN(3)) {
        pg8::Gemm g{XB, (const bf16_t*)(ws + WS_WIN), M, NIN, DM}; pg8::StaticOrder S; S.init(M, NIN, G, bx);
        EpiWin E{QK, U, LA, ss1, b_a};
        pg8::gemm_phase<EpiWin, pg8::StaticOrder, true, true>(lds, g, S, E);
    }
    SEAM(3);
    if (IN(4)) {
        GlaArgs ga{QK, LA, U, MIX, state_gla, cache_conv, g_head, w_conv, args.out};
        for (int unit = bx; unit < 256; unit += G) gla_unit(ga, lds, unit, tid, wave, lane);
        conv_pass(ga, bx * 512 + tid, G * 512);
    }
    SEAM(4);
    if (IN(5)) {
        pg8::Gemm g{MIX, (const bf16_t*)(ws + WS_WOUT), M, DM, DM}; pg8::StaticOrder S; S.init(M, DM, G, bx);
        EpiRes<1> E{x_prompt, meta, x_sample, XB, args.out, ss2};
        pg8::gemm_phase<EpiRes<1>, pg8::StaticOrder, true, true>(lds, g, S, E);
    }
    SEAM(5);
    if (IN(6)) {
        pg8::Gemm g{XB, (const bf16_t*)(ws + WS_WUP2), M, NUP, DM}; pg8::StaticOrder S; S.init(M, NUP, G, bx);
        EpiUp E{ACT, ss2};
        pg8::gemm_phase<EpiUp, pg8::StaticOrder, true, true>(lds, g, S, E);
    }
    SEAM(6);
    if (IN(7)) {
        pg8::Gemm g{ACT, (const bf16_t*)(ws + WS_WDN2), M, DM, FF}; pg8::StaticOrder S; S.init(M, DM, G, bx);
        EpiRes<2> E{x_prompt, meta, x_sample, XB, args.out, ss3};
        pg8::gemm_phase<EpiRes<2>, pg8::StaticOrder, true, true>(lds, g, S, E);
    }
    SEAM(7);
    if (IN(8)) final_norm(args.out, ss3, norm_final, gw, NGW, lane);
#undef IN
#undef SEAM
}

#ifndef N_LAUNCH_MODE
#define N_LAUNCH_MODE 1
#endif
extern "C" void kernel_launch(void* const* d_in, const int* in_sizes, int n_in, void* d_out, int out_size, void* d_ws, size_t ws_size, hipStream_t stream) {
    static int grid = 0;
    if (grid == 0) {
        if (n_in != 19 || ws_size < WS_END || (size_t)out_size != OUT_END) { fprintf(stderr, "kernel_launch: unexpected sizes n_in %d ws %zu out %d\n", n_in, ws_size, out_size); grid = -1; return; }
        int dev = 0, cus = 0, per_cu = 0;
        hipGetDevice(&dev); hipDeviceGetAttribute(&cus, hipDeviceAttributeMultiprocessorCount, dev);
        if (hipFuncSetAttribute((const void*)fwd_kernel, hipFuncAttributeMaxDynamicSharedMemorySize, LDS_BYTES) != hipSuccess) { fprintf(stderr, "kernel_launch: hipFuncSetAttribute failed\n"); grid = -1; return; }
        if (hipOccupancyMaxActiveBlocksPerMultiprocessor(&per_cu, (const void*)fwd_kernel, 512, LDS_BYTES) != hipSuccess || per_cu < 1) { fprintf(stderr, "kernel_launch: occupancy query says %d\n", per_cu); per_cu = 1; }
        (void)hipGetLastError();
        grid = cus * per_cu;
    }
    if (grid < 0) return;
    Args a{};
    for (int i = 0; i < 19; ++i) a.in[i] = (const float*)d_in[i];
    a.out = (float*)d_out; a.ws = (unsigned char*)d_ws;
#if N_LAUNCH_MODE == 1
    a.ph_lo = 0; a.ph_hi = 9;
    void* kargs[] = {&a};
    hipError_t e = hipLaunchCooperativeKernel((const void*)fwd_kernel, dim3(grid), dim3(512), kargs, LDS_BYTES, stream);
    if (e != hipSuccess) fprintf(stderr, "cooperative launch failed: %s (grid %d)\n", hipGetErrorString(e), grid);
#else
    for (int p = 0; p < 9; ++p) { a.ph_lo = p; a.ph_hi = p + 1; hipLaunchKernelGGL(fwd_kernel, dim3(grid), dim3(512), LDS_BYTES, stream, a); }
#endif
}
```

```cpp
#include <hip/hip_runtime.h>
#include <hip/hip_cooperative_groups.h>
#include <cstdio>
#include <cstdint>
namespace cg = cooperative_groups;
namespace pg8 {
#define PG8_LAS __attribute__((address_space(3)))
typedef unsigned short bf16_t;
typedef short bf16x8 __attribute__((ext_vector_type(8)));
typedef float f32x4 __attribute__((ext_vector_type(4)));
typedef unsigned u32x4 __attribute__((ext_vector_type(4)));
constexpr int BM = 256, BK = 64, HALF = 128, HTB = HALF * BK * 2  , STAGE_BYTES = 8 * HTB, NXCD = 8, WGM = 8;

__host__ __device__ __forceinline__ int lds_byte(int r, int c) { const int st = (r >> 4) * 2 + (c >> 5), rr = r & 15, cc = c & 31, ob = rr * 64 + cc * 2; return st * 1024 + (ob ^ (((ob >> 9) & 1) << 5)); }
__host__ __device__ __forceinline__ void stage_rc(int b, int& R, int& C) { const int st = b / 1024, sb = b % 1024, swz = sb ^ (((sb >> 9) & 1) << 5); R = (st >> 1) * 16 + swz / 64; C = (st & 1) * 32 + (swz % 64) / 2; }
__host__ __device__ __forceinline__ int perm32(int rho) { const int n = rho >> 4, i = rho & 15; return 8 * (i >> 2) + 4 * n + (i & 3); }

struct Unit { int pm, pn; };
struct Gemm { const bf16_t* A; const bf16_t* Bt; int M, N, K; };

struct StaticOrder {
    int nM, nN, nwg, G, c;
    __host__ __device__ void init(int M, int N, int G_, int c_) { nM = M / BM; nN = N / BM; nwg = nM * nN; G = G_; c = c_; }
    __host__ __device__ bool next(int i, Unit& u) const {
        const long L = (long)i * G + c; if (L >= nwg) return false;
        int wgid = (int)L; { const int q = nwg / NXCD, r = nwg % NXCD, xcd = wgid % NXCD, off = wgid / NXCD; wgid = (xcd < r ? xcd * (q + 1) : r * (q + 1) + (xcd - r) * q) + off; }
        const int nig = WGM * nN, gid = wgid / nig, fm = gid * WGM, gsz = (nM - fm) < WGM ? (nM - fm) : WGM;
        u.pm = fm + ((wgid % nig) % gsz); u.pn = (wgid % nig) / gsz; return true;
    }
    __device__ __forceinline__ void a_ready(const Unit&) const {}
    __device__ __forceinline__ void done(const Unit&) const {}
};

typedef float cvt_f32x2_t __attribute__((ext_vector_type(2))); typedef __bf16 cvt_bf16x2_t __attribute__((ext_vector_type(2)));
__device__ __forceinline__ unsigned cvt_pk_bf16(float lo, float hi) { cvt_f32x2_t v = {lo, hi}; cvt_bf16x2_t b = __builtin_convertvector(v, cvt_bf16x2_t); return __builtin_bit_cast(unsigned, b); }
template <class Epi, class Sched, bool ALIGN_EPI = false, bool SP2 = false>
__device__ __forceinline__ void gemm_phase(PG8_LAS unsigned char* lds, const Gemm g, const Sched& S, const Epi& E) {
    const int tid = threadIdx.x, wid = __builtin_amdgcn_readfirstlane(tid >> 6), lane = tid & 63, wr = wid >> 2, wc = wid & 3, fr = lane & 15, fq = lane >> 4;
    const int K = g.K, nt = K / BK;
    unsigned voffA[2], voffB[2];
#pragma unroll
    for (int i = 0; i < 2; ++i) { int R, C; stage_rc(tid * 16 + i * 8192, R, C); const int Rb = Epi::PERM ? ((R & ~31) + perm32(R & 31)) : R;
        voffA[i] = (unsigned)(R * K + C) * 2u; voffB[i] = (unsigned)(Rb * K + C) * 2u; }
    const size_t kstep = (size_t)(BK * 2);
    const size_t hstep = (size_t)HALF * K * 2;
    const size_t tstep = 2 * hstep;
    const unsigned ldsw = (unsigned)wid * 1024u;
    const int aoff = lds_byte(wr * 64 + fr, fq * 8), boff = lds_byte(wc * 32 + fr, fq * 8);
#define PG8_SA(b, h) (((b) * 2 + (h)) * HTB)
#define PG8_SB(b, h) ((4 + (b) * 2 + (h)) * HTB)
#define PG8_STAGE(bufoff, gbase, voff) do { _Pragma("unroll") for (int _i = 0; _i < 2; ++_i) \
        __builtin_amdgcn_global_load_lds((const unsigned*)((const char*)(gbase) + (voff)[_i]), (PG8_LAS unsigned*)(lds + (bufoff) + ldsw + _i * 8192), 16, 0, 0); } while (0)
#define PG8_LDA(dst, b, h) do { _Pragma("unroll") for (int m = 0; m < 4; ++m) _Pragma("unroll") for (int k = 0; k < 2; ++k) dst[m][k] = *(const PG8_LAS bf16x8*)(lds + PG8_SA(b, h) + aoff + m * 2048 + k * 1024); } while (0)
#define PG8_LDB(dst, b, h) do { _Pragma("unroll") for (int n = 0; n < 2; ++n) _Pragma("unroll") for (int k = 0; k < 2; ++k) dst[n][k] = *(const PG8_LAS bf16x8*)(lds + PG8_SB(b, h) + boff + n * 2048 + k * 1024); } while (0)
#define PG8_MMA(ai, bj, At, Bt) do { __builtin_amdgcn_s_setprio(1); _Pragma("unroll") for (int m = 0; m < 4; ++m) _Pragma("unroll") for (int n = 0; n < 2; ++n) _Pragma("unroll") for (int k = 0; k < 2; ++k) \
        acc[ai][bj][m][n] = __builtin_amdgcn_mfma_f32_16x16x32_bf16(Bt[n][k], At[m][k], acc[ai][bj][m][n], 0, 0, 0); __builtin_amdgcn_s_setprio(0); } while (0)
#define PG8_WAIT_V(n) asm volatile("s_waitcnt vmcnt(" #n ")" ::: "memory")
#define PG8_WAIT_L(n) asm volatile("s_waitcnt lgkmcnt(" #n ")" ::: "memory")
#define PG8_BAR __builtin_amdgcn_s_barrier()
#define PG8_SCHED __builtin_amdgcn_sched_barrier(0)
    Unit cur, nxt; int ui = 0;
    if (!S.next(0, cur)) return;
    f32x4 acc[2][2][4][2];
#pragma unroll
    for (int a = 0; a < 2; ++a)
#pragma unroll
        for (int b = 0; b < 2; ++b)
#pragma unroll
            for (int m = 0; m < 4; ++m)
#pragma unroll
                for (int n = 0; n < 2; ++n) acc[a][b][m][n] = (f32x4){0.f, 0.f, 0.f, 0.f};
    bf16x8 At[4][2], B0[2][2], B1[2][2];
    const char* cA = (const char*)g.A + (size_t)cur.pm * tstep; const char* cB = (const char*)g.Bt + (size_t)cur.pn * tstep;
    S.a_ready(cur);
    if constexpr (SP2) {
        PG8_STAGE(PG8_SB(0, 0), cB, voffB); PG8_STAGE(PG8_SB(0, 1), cB + hstep, voffB); PG8_STAGE(PG8_SA(0, 0), cA, voffA); PG8_STAGE(PG8_SA(0, 1), cA + hstep, voffA);
        if (wr == 1) PG8_BAR;
        PG8_WAIT_V(2); PG8_BAR;
        PG8_STAGE(PG8_SB(1, 0), cB + kstep, voffB); PG8_STAGE(PG8_SA(1, 0), cA + kstep, voffA); PG8_STAGE(PG8_SB(1, 1), cB + hstep + kstep, voffB);
        PG8_WAIT_V(6); PG8_BAR;
    } else {
        PG8_STAGE(PG8_SB(0, 0), cB, voffB); PG8_STAGE(PG8_SA(0, 0), cA, voffA); PG8_STAGE(PG8_SB(0, 1), cB + hstep, voffB); PG8_STAGE(PG8_SA(0, 1), cA + hstep, voffA);
        if (wr == 1) PG8_BAR;
        PG8_WAIT_V(4); PG8_BAR;
        PG8_STAGE(PG8_SB(1, 0), cB + kstep, voffB); PG8_STAGE(PG8_SA(1, 0), cA + kstep, voffA); PG8_STAGE(PG8_SB(1, 1), cB + hstep + kstep, voffB);
        PG8_WAIT_V(6); PG8_BAR;
    }
    for (;;) {
        const bool has_next = S.next(ui + 1, nxt);
        const char* nA = has_next ? (const char*)g.A + (size_t)nxt.pm * tstep : cA; const char* nB = has_next ? (const char*)g.Bt + (size_t)nxt.pn * tstep : cB;
        for (int t = 0; t < nt; t += 2) {
            const bool last = (t == nt - 2);
            const char* a1 = cA + (size_t)(t + 1) * kstep;
            const char* a2 = last ? nA : cA + (size_t)(t + 2) * kstep; const char* b2 = last ? nB : cB + (size_t)(t + 2) * kstep;
            const char* a3 = a2 + kstep; const char* b3 = b2 + kstep;
            if (last && has_next) S.a_ready(nxt);
            if constexpr (SP2) {
            PG8_LDB(B0, 0, 0); PG8_LDB(B1, 0, 1); PG8_SCHED; PG8_LDA(At, 0, 0); PG8_STAGE(PG8_SA(1, 1), a1 + hstep, voffA);
            PG8_WAIT_V(8); PG8_WAIT_L(0); PG8_BAR; PG8_MMA(0, 0, At, B0); PG8_MMA(0, 1, At, B1); PG8_BAR; PG8_SCHED;
            PG8_LDA(At, 0, 1); PG8_STAGE(PG8_SB(0, 0), b2, voffB); PG8_STAGE(PG8_SB(0, 1), b2 + hstep, voffB); PG8_STAGE(PG8_SA(0, 0), a2, voffA);
            PG8_WAIT_V(8); PG8_WAIT_L(0); PG8_BAR; PG8_MMA(1, 0, At, B0); PG8_MMA(1, 1, At, B1); PG8_BAR; PG8_SCHED;
            PG8_LDB(B0, 1, 0); PG8_LDB(B1, 1, 1); PG8_SCHED; PG8_LDA(At, 1, 0); PG8_STAGE(PG8_SA(0, 1), a2 + hstep, voffA);
            PG8_WAIT_V(8); PG8_WAIT_L(0); PG8_BAR; PG8_MMA(0, 0, At, B0); PG8_MMA(0, 1, At, B1); PG8_BAR; PG8_SCHED;
            PG8_LDA(At, 1, 1); PG8_STAGE(PG8_SB(1, 0), b3, voffB); PG8_STAGE(PG8_SB(1, 1), b3 + hstep, voffB); PG8_STAGE(PG8_SA(1, 0), a3, voffA);
            PG8_WAIT_V(8); PG8_WAIT_L(0); PG8_BAR; PG8_MMA(1, 0, At, B0); PG8_MMA(1, 1, At, B1); PG8_BAR; PG8_SCHED;
            } else {
            PG8_LDB(B0, 0, 0); PG8_SCHED; PG8_LDA(At, 0, 0); PG8_STAGE(PG8_SA(1, 1), a1 + hstep, voffA);
            PG8_WAIT_L(8); PG8_BAR; PG8_WAIT_L(0); PG8_MMA(0, 0, At, B0); PG8_BAR; PG8_SCHED;
            PG8_LDB(B1, 0, 1); PG8_STAGE(PG8_SB(0, 0), b2, voffB);
            PG8_BAR; PG8_WAIT_L(0); PG8_MMA(0, 1, At, B1); PG8_BAR;
            PG8_LDA(At, 0, 1); PG8_STAGE(PG8_SA(0, 0), a2, voffA);
            PG8_BAR; PG8_WAIT_L(0); PG8_MMA(1, 0, At, B0); PG8_BAR; PG8_SCHED;
            PG8_STAGE(PG8_SB(0, 1), b2 + hstep, voffB);
            PG8_WAIT_V(6); PG8_BAR; PG8_MMA(1, 1, At, B1); PG8_BAR;
            PG8_LDB(B0, 1, 0); PG8_SCHED; PG8_LDA(At, 1, 0); PG8_STAGE(PG8_SA(0, 1), a2 + hstep, voffA);
            PG8_WAIT_L(8); PG8_BAR; PG8_WAIT_L(0); PG8_MMA(0, 0, At, B0); PG8_BAR; PG8_SCHED;
            PG8_LDB(B1, 1, 1); PG8_STAGE(PG8_SB(1, 0), b3, voffB);
            PG8_BAR; PG8_WAIT_L(0); PG8_MMA(0, 1, At, B1); PG8_BAR;
            PG8_LDA(At, 1, 1); PG8_STAGE(PG8_SA(1, 0), a3, voffA);
            PG8_BAR; PG8_WAIT_L(0); PG8_MMA(1, 0, At, B0); PG8_BAR; PG8_SCHED;
            PG8_STAGE(PG8_SB(1, 1), b3 + hstep, voffB);
            PG8_WAIT_V(6); PG8_BAR; PG8_MMA(1, 1, At, B1); PG8_BAR;
            }
        }
        if constexpr (ALIGN_EPI) { if (wr == 0) PG8_BAR; }
        if constexpr (!Epi::AFTER_DRAIN) { E(acc, cur, wr, wc, fr, fq); S.done(cur); }
        if (!has_next) break;
#pragma unroll
        for (int a = 0; a < 2; ++a)
#pragma unroll
            for (int b = 0; b < 2; ++b)
#pragma unroll
                for (int m = 0; m < 4; ++m)
#pragma unroll
                    for (int n = 0; n < 2; ++n) acc[a][b][m][n] = (f32x4){0.f, 0.f, 0.f, 0.f};
        cur = nxt; cA = nA; cB = nB; ++ui;
        if constexpr (ALIGN_EPI) { if (wr == 1) PG8_BAR; }
    }
    PG8_WAIT_V(0);
    if constexpr (!ALIGN_EPI) { if (wr == 0) PG8_BAR; }
    PG8_BAR;
    if constexpr (Epi::AFTER_DRAIN) { E.fused(acc, cur, wr, wc, fr, fq, lds, wid, lane); S.done(cur); }
#undef PG8_SA
#undef PG8_SB
#undef PG8_STAGE
#undef PG8_LDA
#undef PG8_LDB
#undef PG8_MMA
#undef PG8_WAIT_V
#undef PG8_WAIT_L
#undef PG8_BAR
#undef PG8_SCHED
}
}
using pg8::bf16_t; using pg8::f32x4; using pg8::bf16x8; using pg8::u32x4; using pg8::Unit; using pg8::cvt_pk_bf16;
#define LAS __attribute__((address_space(3)))
typedef unsigned u32x2 __attribute__((ext_vector_type(2)));
typedef float f32x2 __attribute__((ext_vector_type(2)));
constexpr int DM = 1024, NBP = 32, SEQ = 2048, NMETA = 16, LP = SEQ + NMETA, NBS = 32, DSEQ = 64;
constexpr int MP = NBP * LP, MS = NBS * DSEQ, M = MP + MS;
constexpr int FF = 2816, NUP = 2 * FF, NIN = 3328, DIN = 3088;
constexpr int NH = 4, DK = 64, DV = 128;
constexpr float EPS = 1e-6f;
static_assert(M % 256 == 0, "M");
constexpr size_t OUT_YP = 0, OUT_YS = (size_t)NBP * SEQ * DM, OUT_SP = OUT_YS + (size_t)MS * DM, OUT_CP = OUT_SP + (size_t)NBP * NH * DK * DV,
                 OUT_SS = OUT_CP + (size_t)NBP * 2 * 512, OUT_CS = OUT_SS + (size_t)NBS * NH * DK * DV, OUT_END = OUT_CS + (size_t)NBS * 2 * 512;
constexpr size_t MiB = 1u << 20;
constexpr size_t WS_SS = 0, SS_STRIDE = 512 * 1024;
constexpr size_t WS_WUP1 = 2 * MiB, WS_WDN1 = 13 * MiB, WS_WIN = 19 * MiB, WS_WOUT = 26 * MiB, WS_WUP2 = 28 * MiB, WS_WDN2 = 39 * MiB;
constexpr size_t WS_XB = 48 * MiB;
constexpr size_t WS_ACT = 184 * MiB;
constexpr size_t WS_QK = 184 * MiB, WS_U = 450 * MiB, WS_LA = 517 * MiB;
constexpr size_t WS_MIX = 584 * MiB, WS_DUMMY = 718 * MiB, WS_END = 719 * MiB;
static_assert(WS_ACT + (size_t)M * FF * 2 <= WS_MIX && WS_LA + (size_t)M * 256 * 4 <= WS_MIX && WS_U + (size_t)M * 512 * 2 <= WS_LA && WS_QK + (size_t)M * 2048 * 2 <= WS_U, "ws map");
static_assert(WS_XB + (size_t)M * DM * 2 <= WS_ACT && WS_MIX + (size_t)M * DM * 2 <= WS_END && WS_WDN2 + (size_t)DM * FF * 2 <= WS_XB, "ws map");

__device__ __forceinline__ const float* xin_row(const float* xp, const float* meta, const float* xs, int R) {
    if (R < MP) { const int b = R / LP, t = R - b * LP; return t < NMETA ? meta + (size_t)t * DM : xp + ((size_t)b * SEQ + (t - NMETA)) * DM; }
    return xs + (size_t)(R - MP) * DM;
}
__device__ __forceinline__ float* yout_row(float* out, int R) {
    if (R < MP) { const int b = R / LP, t = R - b * LP; return t < NMETA ? nullptr : out + ((size_t)b * SEQ + (t - NMETA)) * DM; }
    return out + OUT_YS + (size_t)(R - MP) * DM;
}
__device__ __forceinline__ float bf_lo(unsigned w) { return __uint_as_float(w << 16); }
__device__ __forceinline__ float bf_hi(unsigned w) { return __uint_as_float(w & 0xffff0000u); }
__device__ __forceinline__ float silu_f(float g) { return g * __builtin_amdgcn_rcpf(1.f + __expf(-g)); }
__device__ __forceinline__ float wave_sum(float v) {
#pragma unroll
    for (int o = 1; o < 64; o <<= 1) v += __shfl_xor(v, o);
    return v;
}

struct EpiUp {
    static constexpr bool PERM = true, AFTER_DRAIN = false;
    bf16_t* O; const float* ss;
    __device__ __forceinline__ void operator()(const f32x4 (&acc)[2][2][4][2], const Unit& u, int wr, int wc, int fr, int fq) const {
        const int row0 = u.pm * 256 + wr * 64 + fr, col0 = u.pn * 128 + wc * 32 + 8 * fq;
#pragma unroll
        for (int ai = 0; ai < 2; ++ai)
#pragma unroll
            for (int m = 0; m < 4; ++m) {
                const int row = row0 + ai * 128 + m * 16;
                const float rs = rsqrtf(ss[row] * (1.0f / DM) + EPS);
                float o[8];
#pragma unroll
                for (int n = 0; n < 2; ++n)
#pragma unroll
                    for (int j = 0; j < 4; ++j) { const float g = acc[ai][0][m][n][j] * rs, up = acc[ai][1][m][n][j] * rs; o[4 * n + j] = silu_f(g) * up; }
                u32x4 w; w.x = cvt_pk_bf16(o[0], o[1]); w.y = cvt_pk_bf16(o[2], o[3]); w.z = cvt_pk_bf16(o[4], o[5]); w.w = cvt_pk_bf16(o[6], o[7]);
                *(u32x4*)(O + (size_t)row * FF + col0) = w;
            }
    }
};
template <int MODE> struct EpiRes {
    static constexpr bool PERM = true, AFTER_DRAIN = false;
    const float *xp, *meta, *xs; bf16_t* XB; float* out; float* ss;
    __device__ __forceinline__ void operator()(const f32x4 (&acc)[2][2][4][2], const Unit& u, int wr, int wc, int fr, int fq) const {
        const float alpha = (MODE == 1) ? 1.0f : 0.5f;
#pragma unroll
        for (int ai = 0; ai < 2; ++ai)
#pragma unroll
            for (int m = 0; m < 4; ++m) {
                const int row = u.pm * 256 + ai * 128 + wr * 64 + m * 16 + fr;
                const float* xr = nullptr;
                if (MODE == 0) xr = xin_row(xp, meta, xs, row);
                float sq = 0.f;
#pragma unroll
                for (int bj = 0; bj < 2; ++bj) {
                    const int col = u.pn * 256 + bj * 128 + wc * 32 + 8 * fq;
                    f32x4 b0, b1;
                    if (MODE == 0) { b0 = *(const f32x4*)(xr + col); b1 = *(const f32x4*)(xr + col + 4); }
                    else { const u32x4 w = *(const u32x4*)(XB + (size_t)row * DM + col);
                        b0 = (f32x4){bf_lo(w.x), bf_hi(w.x), bf_lo(w.y), bf_hi(w.y)}; b1 = (f32x4){bf_lo(w.z), bf_hi(w.z), bf_lo(w.w), bf_hi(w.w)}; }
                    const f32x4 v0 = b0 + acc[ai][bj][m][0] * alpha, v1 = b1 + acc[ai][bj][m][1] * alpha;
                    sq += (v0[0] * v0[0] + v0[1] * v0[1]) + (v0[2] * v0[2] + v0[3] * v0[3]) + (v1[0] * v1[0] + v1[1] * v1[1]) + (v1[2] * v1[2] + v1[3] * v1[3]);
                    { u32x4 w; w.x = cvt_pk_bf16(v0[0], v0[1]); w.y = cvt_pk_bf16(v0[2], v0[3]); w.z = cvt_pk_bf16(v1[0], v1[1]); w.w = cvt_pk_bf16(v1[2], v1[3]);
                        *(u32x4*)(XB + (size_t)row * DM + col) = w; }
                }
                sq += __shfl_xor(sq, 16); sq += __shfl_xor(sq, 32);
                if (fq == 0) unsafeAtomicAdd(ss + row, sq);
            }
    }
};
__device__ __forceinline__ float log_sigmoid_f(float z) { const float e = __expf(-fabsf(z)); return fminf(z, 0.f) - __logf(1.f + e); }
struct EpiWin {
    static constexpr bool PERM = true, AFTER_DRAIN = false;
    bf16_t* QK; bf16_t* U; float* LA; const float* ss; const float* b_a;
    __device__ __forceinline__ void operator()(const f32x4 (&acc)[2][2][4][2], const Unit& u, int wr, int wc, int fr, int fq) const {
        const int pn = u.pn;
#pragma unroll
        for (int ai = 0; ai < 2; ++ai)
#pragma unroll
            for (int m = 0; m < 4; ++m) {
                const int row = u.pm * 256 + ai * 128 + wr * 64 + m * 16 + fr;
                const float rs = rsqrtf(ss[row] * (1.0f / DM) + EPS);
                if (pn < 8) {
                    const float sc = (pn == 0) ? rs * 0.125f : rs;
#pragma unroll
                    for (int bj = 0; bj < 2; ++bj) { const f32x4 v0 = acc[ai][bj][m][0] * sc, v1 = acc[ai][bj][m][1] * sc;
                        u32x4 w; w.x = cvt_pk_bf16(v0[0], v0[1]); w.y = cvt_pk_bf16(v0[2], v0[3]); w.z = cvt_pk_bf16(v1[0], v1[1]); w.w = cvt_pk_bf16(v1[2], v1[3]);
                        *(u32x4*)(QK + (size_t)row * 2048 + pn * 256 + bj * 128 + wc * 32 + 8 * fq) = w; }
                } else if (pn < 12) {
                    const float r2 = rs * rs;
                    const f32x4 v0 = acc[ai][0][m][0] * acc[ai][1][m][0] * r2, v1 = acc[ai][0][m][1] * acc[ai][1][m][1] * r2;
                    u32x4 w; w.x = cvt_pk_bf16(v0[0], v0[1]); w.y = cvt_pk_bf16(v0[2], v0[3]); w.z = cvt_pk_bf16(v1[0], v1[1]); w.w = cvt_pk_bf16(v1[2], v1[3]);
                    *(u32x4*)(U + (size_t)row * 512 + (pn - 8) * 128 + wc * 32 + 8 * fq) = w;
                } else {
#pragma unroll
                    for (int bj = 0; bj < 2; ++bj)
#pragma unroll
                        for (int n = 0; n < 2; ++n) { const int c = bj * 128 + wc * 32 + 8 * fq + 4 * n; const f32x4 bb = *(const f32x4*)(b_a + c); f32x4 o;
#pragma unroll
                            for (int j = 0; j < 4; ++j) o[j] = log_sigmoid_f(acc[ai][bj][m][n][j] * rs + bb[j]) * (1.0f / 16.0f);
                            *(f32x4*)(LA + (size_t)row * 256 + c) = o; }
                }
            }
    }
};
__device__ __forceinline__ void tr_item(const float* W, int ldw, int src_col0, const float* gain, bf16_t* WT, int K, int dst_row0, int k0, LAS float* scr, int lane) {
#pragma unroll 8
    for (int i = 0; i < 32; ++i) { const int kk = 2 * i + (lane >> 5); float w = W[(size_t)(k0 + kk) * ldw + src_col0 + (lane & 31)]; if (gain) w *= gain[k0 + kk]; scr[kk * 33 + (lane & 31)] = w; }
    asm volatile("s_waitcnt lgkmcnt(0)" ::: "memory");
    const int c = lane & 7;
#pragma unroll
    for (int j = 0; j < 4; ++j) { const int n = (lane >> 3) + 8 * j; const LAS float* s = scr + (8 * c) * 33 + n;
        u32x4 o; o.x = cvt_pk_bf16(s[0 * 33], s[1 * 33]); o.y = cvt_pk_bf16(s[2 * 33], s[3 * 33]); o.z = cvt_pk_bf16(s[4 * 33], s[5 * 33]); o.w = cvt_pk_bf16(s[6 * 33], s[7 * 33]);
        *(u32x4*)(WT + (size_t)(dst_row0 + n) * K + k0 + 8 * c) = o; }
    asm volatile("s_waitcnt lgkmcnt(0)" ::: "memory");
}
__device__ __forceinline__ int up_src_col(int n) { const int pn = n >> 8, within = n & 255; return (within >> 7) * FF + 128 * pn + (within & 127); }
__device__ __forceinline__ int win_src_col(int n) {
    if (n < 1536) return n;
    if (n < 2048) return n + 16;
    const int j = (n - 2048) >> 8, within = (n - 2048) & 255;
    return ((within >> 7) ? 2576 : 2064) + 128 * j + (within & 127);
}
struct P0Args { const float *xp, *xs, *meta, *n1, *wu1, *wd1, *n2, *win, *wa2, *wout, *n3, *wu2, *wd2; unsigned char* ws; };
__device__ __forceinline__ void p0_prologue(const P0Args& a, LAS unsigned char* lds, int gw, int NGW, int wave, int lane) {
    LAS float* scr = (LAS float*)(lds + wave * 8704);
    constexpr int I_UP = (DM / 64) * (NUP / 32), I_DN = (FF / 64) * (DM / 32), I_IN = (DM / 64) * (3072 / 32), I_OUT = (DM / 64) * (DM / 32);
    constexpr int NITEMS = 2 * I_UP + 2 * I_DN + I_IN + I_OUT;
    bf16_t* WUP1 = (bf16_t*)(a.ws + WS_WUP1); bf16_t* WDN1 = (bf16_t*)(a.ws + WS_WDN1); bf16_t* WIN = (bf16_t*)(a.ws + WS_WIN);
    bf16_t* WOUT = (bf16_t*)(a.ws + WS_WOUT); bf16_t* WUP2 = (bf16_t*)(a.ws + WS_WUP2); bf16_t* WDN2 = (bf16_t*)(a.ws + WS_WDN2);
    for (int it = gw; it < NITEMS; it += NGW) {
        int r = it;
        if (r < 2 * I_UP) { const bool second = r >= I_UP; if (second) r -= I_UP; const int nblk = NUP / 32, kb = r / nblk, nb = r % nblk;
            tr_item(second ? a.wu2 : a.wu1, NUP, up_src_col(32 * nb), second ? a.n3 : a.n1, second ? WUP2 : WUP1, DM, 32 * nb, 64 * kb, scr, lane); continue; }
        r -= 2 * I_UP;
        if (r < 2 * I_DN) { const bool second = r >= I_DN; if (second) r -= I_DN; const int nblk = DM / 32, kb = r / nblk, nb = r % nblk;
            tr_item(second ? a.wd2 : a.wd1, DM, 32 * nb, nullptr, second ? WDN2 : WDN1, FF, 32 * nb, 64 * kb, scr, lane); continue; }
        r -= 2 * I_DN;
        if (r < I_IN) { const int nblk = 3072 / 32, kb = r / nblk, nb = r % nblk;
            tr_item(a.win, DIN, win_src_col(32 * nb), a.n2, WIN, DM, 32 * nb, 64 * kb, scr, lane); continue; }
        r -= I_IN;
        { const int nblk = DM / 32, kb = r / nblk, nb = r % nblk; tr_item(a.wout, DM, 32 * nb, nullptr, WOUT, DM, 32 * nb, 64 * kb, scr, lane); }
    }
    for (int e = gw * 64 + lane; e < 256 * DM; e += NGW * 64) { const int n = e >> 10, k = e & 1023; const float* wr_ = a.win + (size_t)k * DIN + 1536; float s = 0.f;
#pragma unroll
        for (int r = 0; r < 16; ++r) s += wr_[r] * a.wa2[r * 256 + n];
        s *= a.n2[k]; const unsigned short b = (unsigned short)(cvt_pk_bf16(s, 0.f) & 0xffffu); WIN[(size_t)(3072 + n) * DM + k] = b; }
    bf16_t* XB = (bf16_t*)(a.ws + WS_XB); float* ss0 = (float*)(a.ws + WS_SS);
    for (int R = gw; R < M; R += NGW) {
        const f32x4* xr = (const f32x4*)xin_row(a.xp, a.meta, a.xs, R) + lane; f32x4 v[4]; float s = 0.f;
#pragma unroll
        for (int j = 0; j < 4; ++j) { v[j] = xr[64 * j]; s += (v[j][0] * v[j][0] + v[j][1] * v[j][1]) + (v[j][2] * v[j][2] + v[j][3] * v[j][3]); }
        s = wave_sum(s);
        u32x2* o8 = (u32x2*)(XB + (size_t)R * DM) + lane;
#pragma unroll
        for (int j = 0; j < 4; ++j) { u32x2 w; w.x = cvt_pk_bf16(v[j][0], v[j][1]); w.y = cvt_pk_bf16(v[j][2], v[j][3]); o8[64 * j] = w; }
        if (lane == 0) { ss0[R] = s; ss0[R + SS_STRIDE / 4] = 0.f; ss0[R + 2 * (SS_STRIDE / 4)] = 0.f; ss0[R + 3 * (SS_STRIDE / 4)] = 0.f; }
    }
}

struct GlaArgs { const bf16_t* QK; const float* LA; const bf16_t* U; bf16_t* MIX; const float* state_in; const float* cache_conv; const float* g_head; const float* w_conv; float* out; bf16_t* dummy; };
constexpr int RS = 144;
constexpr int VRS = 272;
constexpr int L_G = 0, L_VR = 16384, L_QT = 0, L_ATT = 9216, L_KT = 18432, L_KTT = 27648, L_G2 = 36864, L_EGL = 53248, L_SSQ = 53504, L_VT = 54016, L_ST = 72448, ST_BYTES = 128 * RS, L_SEG = 109312, L_QR = 111360, L_KR = 119552;
__device__ __forceinline__ bf16x8 ldf(LAS const unsigned char* base, int row, int ks, int fq) { return *(const LAS bf16x8*)(base + row * RS + ks * 64 + fq * 16); }
__device__ __forceinline__ void gla_unit(const GlaArgs& a, LAS unsigned char* lds, int unit, int tid, int wave, int lane) {
    const bool samp = unit >= 128; const int s = (unit & 127) >> 2, h = unit & 3;
    const int L = samp ? DSEQ : LP; const int row0 = samp ? MP + s * DSEQ : s * LP;
    const int fr = lane & 15, fq = lane >> 4, rb = wave & 3, vh = wave >> 2;
    LAS float* G = (LAS float*)(lds + L_G); LAS float* G2 = (LAS float*)(lds + L_G2); LAS float* EGL = (LAS float*)(lds + L_EGL); LAS float* SSQ = (LAS float*)(lds + L_SSQ);
    f32x4 Sacc[4], gh[4];
    const size_t sbase = (size_t)(s * NH + h) * DK * DV;
#pragma unroll
    for (int vt = 0; vt < 4; ++vt) { const int v = 64 * vh + 16 * vt + fr;
#pragma unroll
        for (int jj = 0; jj < 4; ++jj) Sacc[vt][jj] = samp ? a.state_in[sbase + (size_t)(16 * rb + 4 * fq + jj) * DV + v] : 0.f;
        u32x2 w; w.x = cvt_pk_bf16(Sacc[vt][0], Sacc[vt][1]); w.y = cvt_pk_bf16(Sacc[vt][2], Sacc[vt][3]);
        *(LAS u32x2*)(lds + L_ST + v * RS + (16 * rb + 4 * fq) * 2) = w;
        gh[vt] = *(const f32x4*)(a.g_head + 64 * vh + 16 * vt + 4 * fq); }
    const int lt = tid >> 3, ld0 = (tid & 7) * 8;
    const int vt_t = tid >> 4, vc = tid & 15;
    u32x4 pq, pk, pv0, pv1; f32x4 pl0, pl1; u32x2 rg0, rg1, rg2, rg3;
    const u32x4 z4 = (u32x4){0u, 0u, 0u, 0u}; const f32x4 zf = (f32x4){0.f, 0.f, 0.f, 0.f};
#define GL16(dst, ptr) dst = *(const u32x4*)(ptr)
#define GL16F(dst, ptr) dst = *(const f32x4*)(ptr)
#define GL8(dst, ptr) dst = *(const u32x2*)(ptr)
#define GLA_ISSUE_P(T0) do { \
        const int tq_ = min((T0) + lt, L - 1), ta_ = min((T0) + vt_t, L - 1), tb_ = min((T0) + vt_t + 32, L - 1); \
        const bf16_t* p_ = a.QK + (size_t)(row0 + tq_) * 2048 + h * 64 + ld0; GL16(pq, p_); GL16(pk, p_ + 256); \
        GL16(pv0, a.QK + (size_t)(row0 + ta_) * 2048 + 512 + h * 128 + vc * 8); GL16F(pl0, a.LA + (size_t)(row0 + ta_) * 256 + h * 64 + vc * 4); \
        GL16(pv1, a.QK + (size_t)(row0 + tb_) * 2048 + 512 + h * 128 + vc * 8); GL16F(pl1, a.LA + (size_t)(row0 + tb_) * 256 + h * 64 + vc * 4); } while (0)
#define GLA_ISSUE_R(T0) do { const bf16_t* r_ = a.QK + (size_t)(row0 + min((T0) + 16 * rb + fr, L - 1)) * 2048 + 1024 + h * 128 + 64 * vh + 4 * fq; \
        GL8(rg0, r_); GL8(rg1, r_ + 16); GL8(rg2, r_ + 32); GL8(rg3, r_ + 48); } while (0)
#define GLA_STAGE(T0) do { \
        if ((T0) + lt >= L) { pq = z4; pk = z4; } \
        if ((T0) + vt_t >= L) { pv0 = z4; pl0 = zf; } \
        if ((T0) + vt_t + 32 >= L) { pv1 = z4; pl1 = zf; } \
        *(LAS f32x4*)(G + vt_t * 64 + vc * 4) = pl0; *(LAS f32x4*)(G + (vt_t + 32) * 64 + vc * 4) = pl1; \
        *(LAS u32x4*)(lds + L_VR + vt_t * VRS + vc * 16) = pv0; *(LAS u32x4*)(lds + L_VR + (vt_t + 32) * VRS + vc * 16) = pv1; \
        *(LAS u32x4*)(lds + L_QR + tid * 16) = pq; *(LAS u32x4*)(lds + L_KR + tid * 16) = pk; } while (0)
    GLA_ISSUE_P(0); GLA_STAGE(0);
    const int nch = (L + 63) >> 6;
    for (int c = 0; c < nch; ++c) {
        const int t0 = c * 64, cur = c & 1;
        __syncthreads();
        GLA_ISSUE_R(t0); GLA_ISSUE_P(t0 + 64);
        { const int d = tid & 63; float c8[8];
#pragma unroll
            for (int e = 0; e < 8; ++e) c8[e] = G[(8 * wave + e) * 64 + d];
#pragma unroll
            for (int e = 1; e < 8; ++e) c8[e] += c8[e - 1];
#pragma unroll
            for (int e = 0; e < 8; ++e) G2[(8 * wave + e) * 64 + d] = c8[e];
            ((LAS float*)(lds + L_SEG))[wave * 64 + d] = c8[7]; }
        { const int v = tid & 127, tg = tid >> 7; unsigned w[8];
#pragma unroll
            for (int e = 0; e < 8; ++e) { const unsigned lo = *(const LAS unsigned short*)(lds + L_VR + (16 * tg + 2 * e) * VRS + v * 2), hi = *(const LAS unsigned short*)(lds + L_VR + (16 * tg + 2 * e + 1) * VRS + v * 2); w[e] = lo | (hi << 16); }
            *(LAS u32x4*)(lds + L_VT + v * RS + tg * 32) = (u32x4){w[0], w[1], w[2], w[3]}; *(LAS u32x4*)(lds + L_VT + v * RS + tg * 32 + 16) = (u32x4){w[4], w[5], w[6], w[7]}; }
        __syncthreads();
        { f32x4 g0 = *(const LAS f32x4*)(G2 + lt * 64 + ld0), g1 = *(const LAS f32x4*)(G2 + lt * 64 + ld0 + 4);
            { const LAS float* SEG = (const LAS float*)(lds + L_SEG) + ld0; const int seg = lt >> 3; f32x4 t0 = zf, t1 = zf;
#pragma unroll
                for (int s8 = 0; s8 < 8; ++s8) { const f32x4 a0 = *(const LAS f32x4*)(SEG + s8 * 64), a1 = *(const LAS f32x4*)(SEG + s8 * 64 + 4);
                    if (s8 < seg) { g0 += a0; g1 += a1; } t0 += a0; t1 += a1; }
                if (lt == 63) { f32x4 e0, e1;
#pragma unroll
                    for (int j = 0; j < 4; ++j) { e0[j] = __expf(t0[j]); e1[j] = __expf(t1[j]); }
                    *(LAS f32x4*)(EGL + ld0) = e0; *(LAS f32x4*)(EGL + ld0 + 4) = e1; } }
            const float gq[8] = {g0[0], g0[1], g0[2], g0[3], g1[0], g1[1], g1[2], g1[3]};
            const u32x4 rq = *(const LAS u32x4*)(lds + L_QR + tid * 16), rk = *(const LAS u32x4*)(lds + L_KR + tid * 16);
            const float qv[8] = {bf_lo(rq.x), bf_hi(rq.x), bf_lo(rq.y), bf_hi(rq.y), bf_lo(rq.z), bf_hi(rq.z), bf_lo(rq.w), bf_hi(rq.w)};
            const float kv[8] = {bf_lo(rk.x), bf_hi(rk.x), bf_lo(rk.y), bf_hi(rk.y), bf_lo(rk.z), bf_hi(rk.z), bf_lo(rk.w), bf_hi(rk.w)};
            float qt[8], kt[8];
#pragma unroll
            for (int e = 0; e < 8; ++e) { qt[e] = qv[e] * __expf(gq[e]); kt[e] = kv[e] * __expf(-gq[e]); }
            *(LAS u32x4*)(lds + L_QT + lt * RS + ld0 * 2) = (u32x4){cvt_pk_bf16(qt[0], qt[1]), cvt_pk_bf16(qt[2], qt[3]), cvt_pk_bf16(qt[4], qt[5]), cvt_pk_bf16(qt[6], qt[7])};
            *(LAS u32x4*)(lds + L_KT + lt * RS + ld0 * 2) = (u32x4){cvt_pk_bf16(kt[0], kt[1]), cvt_pk_bf16(kt[2], kt[3]), cvt_pk_bf16(kt[4], kt[5]), cvt_pk_bf16(kt[6], kt[7])}; }
        const int orow = t0 + 16 * rb + fr; const bool ovalid = orow < L;
        __syncthreads();
        { const int d = tid & 63; unsigned w[4];
#pragma unroll
            for (int e = 0; e < 4; ++e) { const unsigned lo = *(const LAS unsigned short*)(lds + L_KT + (8 * wave + 2 * e) * RS + d * 2), hi = *(const LAS unsigned short*)(lds + L_KT + (8 * wave + 2 * e + 1) * RS + d * 2); w[e] = lo | (hi << 16); }
            *(LAS u32x4*)(lds + L_KTT + d * RS + wave * 16) = (u32x4){w[0], w[1], w[2], w[3]}; }
#pragma unroll
        for (int tt = 0; tt < 2; ++tt) { const int tile = 2 * wave + tt, ib = tile >> 2, jb = tile & 3; f32x4 acc = zf;
            if (jb <= ib) {
#pragma unroll
                for (int ks = 0; ks < 2; ++ks) acc = __builtin_amdgcn_mfma_f32_16x16x32_bf16(ldf(lds + L_KT, 16 * jb + fr, ks, fq), ldf(lds + L_QT, 16 * ib + fr, ks, fq), acc, 0, 0, 0);
                if (jb == ib) {
#pragma unroll
                    for (int jj = 0; jj < 4; ++jj) if (4 * fq + jj > fr) acc[jj] = 0.f; } }
            u32x2 w; w.x = cvt_pk_bf16(acc[0], acc[1]); w.y = cvt_pk_bf16(acc[2], acc[3]);
            *(LAS u32x2*)(lds + L_ATT + (16 * ib + fr) * RS + (16 * jb + 4 * fq) * 2) = w; }
        __syncthreads();
        f32x4 o[4]; float sq = 0.f;
        { const bf16x8 ya0 = ldf(lds + L_ATT, 16 * rb + fr, 0, fq), ya1 = ldf(lds + L_ATT, 16 * rb + fr, 1, fq), ya2 = ldf(lds + L_QT, 16 * rb + fr, 0, fq), ya3 = ldf(lds + L_QT, 16 * rb + fr, 1, fq);
            const bf16x8 kx0 = ldf(lds + L_KTT, 16 * rb + fr, 0, fq), kx1 = ldf(lds + L_KTT, 16 * rb + fr, 1, fq);
            const f32x4 eg = *(const LAS f32x4*)(EGL + 16 * rb + 4 * fq);
            LAS const unsigned char* STc = lds + L_ST + cur * ST_BYTES; LAS unsigned char* STn = lds + L_ST + (cur ^ 1) * ST_BYTES;
#pragma unroll
            for (int vt = 0; vt < 4; ++vt) { const int v0 = 64 * vh + 16 * vt;
                const bf16x8 vx0 = ldf(lds + L_VT, v0 + fr, 0, fq), vx1 = ldf(lds + L_VT, v0 + fr, 1, fq), sx0 = ldf(STc, v0 + fr, 0, fq), sx1 = ldf(STc, v0 + fr, 1, fq);
                f32x4 acc = zf;
                acc = __builtin_amdgcn_mfma_f32_16x16x32_bf16(vx0, ya0, acc, 0, 0, 0); acc = __builtin_amdgcn_mfma_f32_16x16x32_bf16(vx1, ya1, acc, 0, 0, 0);
                acc = __builtin_amdgcn_mfma_f32_16x16x32_bf16(sx0, ya2, acc, 0, 0, 0); acc = __builtin_amdgcn_mfma_f32_16x16x32_bf16(sx1, ya3, acc, 0, 0, 0);
                o[vt] = acc; sq += (acc[0] * acc[0] + acc[1] * acc[1]) + (acc[2] * acc[2] + acc[3] * acc[3]);
                f32x4 sa = Sacc[vt];
                sa = __builtin_amdgcn_mfma_f32_16x16x32_bf16(kx0, vx0, sa, 0, 0, 0); sa = __builtin_amdgcn_mfma_f32_16x16x32_bf16(kx1, vx1, sa, 0, 0, 0);
                sa = sa * eg; Sacc[vt] = sa;
                u32x2 w; w.x = cvt_pk_bf16(sa[0], sa[1]); w.y = cvt_pk_bf16(sa[2], sa[3]);
                *(LAS u32x2*)(STn + (v0 + fr) * RS + (16 * rb + 4 * fq) * 2) = w; } }
        sq += __shfl_xor(sq, 16); sq += __shfl_xor(sq, 32);
        if (fq == 0) SSQ[vh * 64 + 16 * rb + fr] = sq;
        __syncthreads();
        { const float rs = rsqrtf((SSQ[16 * rb + fr] + SSQ[64 + 16 * rb + fr]) * (1.0f / DV) + EPS);
            GLA_STAGE(t0 + 64);
            const u32x2 rg[4] = {rg0, rg1, rg2, rg3};
            bf16_t* mrow = ovalid ? a.MIX + (size_t)(row0 + orow) * DM + h * 128 + 64 * vh + 4 * fq : a.dummy + tid * 64;
            {
#pragma unroll
                for (int vt = 0; vt < 4; ++vt) { const float r0 = bf_lo(rg[vt].x), r1 = bf_hi(rg[vt].x), r2 = bf_lo(rg[vt].y), r3 = bf_hi(rg[vt].y);
                    u32x2 w; w.x = cvt_pk_bf16(o[vt][0] * rs * gh[vt][0] * silu_f(r0), o[vt][1] * rs * gh[vt][1] * silu_f(r1)); w.y = cvt_pk_bf16(o[vt][2] * rs * gh[vt][2] * silu_f(r2), o[vt][3] * rs * gh[vt][3] * silu_f(r3));
                    *(u32x2*)(mrow + 16 * vt) = w; } } }
    }
#undef GLA_ISSUE_P
#undef GLA_ISSUE_R
#undef GLA_STAGE
#undef GL16
#undef GL16F
#undef GL8
    float* sout = a.out + (samp ? OUT_SS : OUT_SP) + sbase;
#pragma unroll
    for (int vt = 0; vt < 4; ++vt)
#pragma unroll
        for (int jj = 0; jj < 4; ++jj) sout[(size_t)(16 * rb + 4 * fq + jj) * DV + 64 * vh + 16 * vt + fr] = Sacc[vt][jj];
    __syncthreads();
}
__device__ __forceinline__ void conv_pass(const GlaArgs& a, int gtid, int nthreads) {
    for (int item = gtid; item < M * 64; item += nthreads) {
        const int R = item >> 6, c8 = (item & 63) * 8;
        int b, t, L; bool samp = R >= MP;
        if (!samp) { b = R / LP; t = R - b * LP; L = LP; } else { const int r2 = R - MP; b = r2 >> 6; t = r2 & 63; L = DSEQ; }
        float u2[8], u1[8], u0[8], bb[8];
        { const u32x4 w = *(const u32x4*)(a.U + (size_t)R * 512 + c8); u2[0] = bf_lo(w.x); u2[1] = bf_hi(w.x); u2[2] = bf_lo(w.y); u2[3] = bf_hi(w.y); u2[4] = bf_lo(w.z); u2[5] = bf_hi(w.z); u2[6] = bf_lo(w.w); u2[7] = bf_hi(w.w); }
        if (t >= 1) { const u32x4 w = *(const u32x4*)(a.U + (size_t)(R - 1) * 512 + c8); u1[0] = bf_lo(w.x); u1[1] = bf_hi(w.x); u1[2] = bf_lo(w.y); u1[3] = bf_hi(w.y); u1[4] = bf_lo(w.z); u1[5] = bf_hi(w.z); u1[6] = bf_lo(w.w); u1[7] = bf_hi(w.w); }
        else {
#pragma unroll
            for (int j = 0; j < 8; ++j) u1[j] = samp ? a.cache_conv[((size_t)b * 2 + 1) * 512 + c8 + j] : 0.f; }
        if (t >= 2) { const u32x4 w = *(const u32x4*)(a.U + (size_t)(R - 2) * 512 + c8); u0[0] = bf_lo(w.x); u0[1] = bf_hi(w.x); u0[2] = bf_lo(w.y); u0[3] = bf_hi(w.y); u0[4] = bf_lo(w.z); u0[5] = bf_hi(w.z); u0[6] = bf_lo(w.w); u0[7] = bf_hi(w.w); }
        else {
#pragma unroll
            for (int j = 0; j < 8; ++j) u0[j] = samp ? a.cache_conv[((size_t)b * 2 + t) * 512 + c8 + j] : 0.f; }
        { const u32x4 w = *(const u32x4*)(a.QK + (size_t)R * 2048 + 1536 + c8); bb[0] = bf_lo(w.x); bb[1] = bf_hi(w.x); bb[2] = bf_lo(w.y); bb[3] = bf_hi(w.y); bb[4] = bf_lo(w.z); bb[5] = bf_hi(w.z); bb[6] = bf_lo(w.w); bb[7] = bf_hi(w.w); }
        float o[8];
#pragma unroll
        for (int j = 0; j < 8; ++j) o[j] = bb[j] * (a.w_conv[c8 + j] * u0[j] + a.w_conv[512 + c8 + j] * u1[j] + a.w_conv[1024 + c8 + j] * u2[j]);
        u32x4 w; w.x = cvt_pk_bf16(o[0], o[1]); w.y = cvt_pk_bf16(o[2], o[3]); w.z = cvt_pk_bf16(o[4], o[5]); w.w = cvt_pk_bf16(o[6], o[7]);
        *(u32x4*)(a.MIX + (size_t)R * DM + 512 + c8) = w;
        if (t >= L - 2) { float* oc = a.out + (samp ? OUT_CS : OUT_CP) + ((size_t)b * 2 + (t - (L - 2))) * 512 + c8;
            *(f32x4*)oc = (f32x4){u2[0], u2[1], u2[2], u2[3]}; *(f32x4*)(oc + 4) = (f32x4){u2[4], u2[5], u2[6], u2[7]}; }
    }
}
__device__ __forceinline__ void final_norm(float* out, const bf16_t* XB, const float* ss3, const float* gfin, int gw, int NGW, int lane) {
    constexpr int NR = NBP * SEQ + MS;
    f32x4 g0 = ((const f32x4*)gfin)[2 * lane], g1 = ((const f32x4*)gfin)[2 * lane + 1], g2 = ((const f32x4*)gfin)[128 + 2 * lane], g3 = ((const f32x4*)gfin)[128 + 2 * lane + 1];
    for (int Rp = gw; Rp < NR; Rp += NGW) {
        int R; if (Rp < NBP * SEQ) { const int b = Rp >> 11, t = Rp & 2047; R = b * LP + NMETA + t; } else R = MP + (Rp - NBP * SEQ);
        const float rs = rsqrtf(ss3[R] * (1.0f / DM) + EPS);
        const u32x4 w0 = *((const u32x4*)(XB + (size_t)R * DM) + lane), w1 = *((const u32x4*)(XB + (size_t)R * DM) + 64 + lane);
        f32x4* yr = (f32x4*)(out + (size_t)Rp * DM);
        yr[2 * lane] = (f32x4){bf_lo(w0.x), bf_hi(w0.x), bf_lo(w0.y), bf_hi(w0.y)} * rs * g0; yr[2 * lane + 1] = (f32x4){bf_lo(w0.z), bf_hi(w0.z), bf_lo(w0.w), bf_hi(w0.w)} * rs * g1;
        yr[128 + 2 * lane] = (f32x4){bf_lo(w1.x), bf_hi(w1.x), bf_lo(w1.y), bf_hi(w1.y)} * rs * g2; yr[128 + 2 * lane + 1] = (f32x4){bf_lo(w1.z), bf_hi(w1.z), bf_lo(w1.w), bf_hi(w1.w)} * rs * g3;
    }
}

struct Args { const float* in[19]; float* out; unsigned char* ws; int ph_lo, ph_hi; };
constexpr int LDS_BYTES = 147456;
__global__ void __launch_bounds__(512, 2) fwd_kernel(Args args) {
    extern __shared__ __attribute__((aligned(16))) unsigned char lds_raw[];
    LAS unsigned char* lds = (LAS unsigned char*)lds_raw;
    cg::grid_group grid = cg::this_grid();
    const int tid = threadIdx.x, lane = tid & 63, wave = __builtin_amdgcn_readfirstlane(tid >> 6);
    const int G = gridDim.x, bx = blockIdx.x;
    const int gw = bx * 8 + wave, NGW = G * 8;
    unsigned char* ws = args.ws;
    const float *x_prompt = args.in[0], *x_sample = args.in[1], *state_gla = args.in[2], *cache_conv = args.in[3], *meta = args.in[4], *norm_ffn1 = args.in[5], *w_up1 = args.in[6], *w_down1 = args.in[7],
                *norm_mix = args.in[8], *w_in = args.in[9], *w_a2 = args.in[10], *b_a = args.in[11], *g_head = args.in[12], *w_conv = args.in[13], *w_out = args.in[14], *norm_ffn2 = args.in[15],
                *w_up2 = args.in[16], *w_down2 = args.in[17], *norm_final = args.in[18];
    bf16_t* XB = (bf16_t*)(ws + WS_XB); bf16_t* ACT = (bf16_t*)(ws + WS_ACT); bf16_t* QK = (bf16_t*)(ws + WS_QK); bf16_t* U = (bf16_t*)(ws + WS_U); float* LA = (float*)(ws + WS_LA); bf16_t* MIX = (bf16_t*)(ws + WS_MIX);
    float* ss0 = (float*)(ws + WS_SS); float* ss1 = ss0 + SS_STRIDE / 4; float* ss2 = ss1 + SS_STRIDE / 4; float* ss3 = ss2 + SS_STRIDE / 4;
    const int lo = args.ph_lo, hi = args.ph_hi;
#define IN(k) (lo <= (k) && (k) < hi)
#define SEAM(k) do { if (IN(k) && IN((k) + 1)) { asm volatile("s_waitcnt vmcnt(0) lgkmcnt(0)" ::: "memory"); grid.sync(); __builtin_amdgcn_fence(__ATOMIC_ACQUIRE, "agent"); asm volatile("s_waitcnt vmcnt(0)" ::: "memory"); } } while (0)
    if (IN(0)) {
        P0Args pa{x_prompt, x_sample, meta, norm_ffn1, w_up1, w_down1, norm_mix, w_in, w_a2, w_out, norm_ffn2, w_up2, w_down2, ws};
        p0_prologue(pa, lds, gw, NGW, wave, lane);
    }
    SEAM(0);
    if (IN(1)) {
        pg8::Gemm g{XB, (const bf16_t*)(ws + WS_WUP1), M, NUP, DM}; pg8::StaticOrder S; S.init(M, NUP, G, bx);
        EpiUp E{ACT, ss0};
        pg8::gemm_phase<EpiUp, pg8::StaticOrder, true, true>(lds, g, S, E);
    }
    SEAM(1);
    if (IN(2)) {
        pg8::Gemm g{ACT, (const bf16_t*)(ws + WS_WDN1), M, DM, FF}; pg8::StaticOrder S; S.init(M, DM, G, bx);
        EpiRes<0> E{x_prompt, meta, x_sample, XB, args.out, ss1};
        pg8::gemm_phase<EpiRes<0>, pg8::StaticOrder, true, true>(lds, g, S, E);
    }
    SEAM(2);
    if (IN(3)) {
        pg8::Gemm g{XB, (const bf16_t*)(ws + WS_WIN), M, NIN, DM}; pg8::StaticOrder S; S.init(M, NIN, G, bx);
        EpiWin E{QK, U, LA, ss1, b_a};
        pg8::gemm_phase<EpiWin, pg8::StaticOrder, true, true>(lds, g, S, E);
    }
    SEAM(3);
    if (IN(4)) {
        GlaArgs ga{QK, LA, U, MIX, state_gla, cache_conv, g_head, w_conv, args.out, (bf16_t*)(ws + WS_DUMMY)};
        for (int unit = bx; unit < 256; unit += G) gla_unit(ga, lds, unit, tid, wave, lane);
        if (G == 256) { if (bx >= 128) conv_pass(ga, (bx - 128) * 512 + tid, 128 * 512); }
        else conv_pass(ga, bx * 512 + tid, G * 512);
    }
    SEAM(4);
    if (IN(5)) {
        pg8::Gemm g{MIX, (const bf16_t*)(ws + WS_WOUT), M, DM, DM}; pg8::StaticOrder S; S.init(M, DM, G, bx);
        EpiRes<1> E{x_prompt, meta, x_sample, XB, args.out, ss2};
        pg8::gemm_phase<EpiRes<1>, pg8::StaticOrder, true, true>(lds, g, S, E);
    }
    SEAM(5);
    if (IN(6)) {
        pg8::Gemm g{XB, (const bf16_t*)(ws + WS_WUP2), M, NUP, DM}; pg8::StaticOrder S; S.init(M, NUP, G, bx);
        EpiUp E{ACT, ss2};
        pg8::gemm_phase<EpiUp, pg8::StaticOrder, true, true>(lds, g, S, E);
    }
    SEAM(6);
    if (IN(7)) {
        pg8::Gemm g{ACT, (const bf16_t*)(ws + WS_WDN2), M, DM, FF}; pg8::StaticOrder S; S.init(M, DM, G, bx);
        EpiRes<2> E{x_prompt, meta, x_sample, XB, args.out, ss3};
        pg8::gemm_phase<EpiRes<2>, pg8::StaticOrder, true, true>(lds, g, S, E);
    }
    SEAM(7);
    if (IN(8)) final_norm(args.out, XB, ss3, norm_final, gw, NGW, lane);
#undef IN
#undef SEAM
}

#ifndef N_LAUNCH_MODE
#define N_LAUNCH_MODE 1
#endif
extern "C" void kernel_launch(void* const* d_in, const int* in_sizes, int n_in, void* d_out, int out_size, void* d_ws, size_t ws_size, hipStream_t stream) {
    static int grid = 0;
    if (grid == 0) {
        if (n_in != 19 || ws_size < WS_END || (size_t)out_size != OUT_END) { fprintf(stderr, "kernel_launch: unexpected sizes n_in %d ws %zu out %d\n", n_in, ws_size, out_size); grid = -1; return; }
        int dev = 0, cus = 0, per_cu = 0;
        hipGetDevice(&dev); hipDeviceGetAttribute(&cus, hipDeviceAttributeMultiprocessorCount, dev);
        if (hipFuncSetAttribute((const void*)fwd_kernel, hipFuncAttributeMaxDynamicSharedMemorySize, LDS_BYTES) != hipSuccess) { fprintf(stderr, "kernel_launch: hipFuncSetAttribute failed\n"); grid = -1; return; }
        if (hipOccupancyMaxActiveBlocksPerMultiprocessor(&per_cu, (const void*)fwd_kernel, 512, LDS_BYTES) != hipSuccess || per_cu < 1) { fprintf(stderr, "kernel_launch: occupancy query says %d\n", per_cu); per_cu = 1; }
        (void)hipGetLastError();
        grid = cus * per_cu;
    }
    if (grid < 0) return;
    Args a{};
    for (int i = 0; i < 19; ++i) a.in[i] = (const float*)d_in[i];
    a.out = (float*)d_out; a.ws = (unsigned char*)d_ws;
#if N_LAUNCH_MODE == 1
    a.ph_lo = 0; a.ph_hi = 9;
    void* kargs[] = {&a};
    hipError_t e = hipLaunchCooperativeKernel((const void*)fwd_kernel, dim3(grid), dim3(512), kargs, LDS_BYTES, stream);
    if (e != hipSuccess) fprintf(stderr, "cooperative launch failed: %s (grid %d)\n", hipGetErrorString(e), grid);
#else
    for (int p = 0; p < 9; ++p) { a.ph_lo = p; a.ph_hi = p + 1; hipLaunchKernelGGL(fwd_kernel, dim3(grid), dim3(512), LDS_BYTES, stream, a); }
#endif
}
```

```cpp
#include <hip/hip_runtime.h>
#include <hip/hip_cooperative_groups.h>
#include <cstdio>
#include <cstdint>
namespace cg = cooperative_groups;
namespace pg8 {
#define PG8_LAS __attribute__((address_space(3)))
typedef unsigned short bf16_t;
typedef short bf16x8 __attribute__((ext_vector_type(8)));
typedef float f32x4 __attribute__((ext_vector_type(4)));
typedef unsigned u32x4 __attribute__((ext_vector_type(4)));
constexpr int BM = 256, BK = 64, HALF = 128, HTB = HALF * BK * 2  , STAGE_BYTES = 8 * HTB, NXCD = 8, WGM = 8;

__host__ __device__ __forceinline__ int lds_byte(int r, int c) { const int st = (r >> 4) * 2 + (c >> 5), rr = r & 15, cc = c & 31, ob = rr * 64 + cc * 2; return st * 1024 + (ob ^ (((ob >> 9) & 1) << 5)); }
__host__ __device__ __forceinline__ void stage_rc(int b, int& R, int& C) { const int st = b / 1024, sb = b % 1024, swz = sb ^ (((sb >> 9) & 1) << 5); R = (st >> 1) * 16 + swz / 64; C = (st & 1) * 32 + (swz % 64) / 2; }
__host__ __device__ __forceinline__ int perm32(int rho) { const int n = rho >> 4, i = rho & 15; return 8 * (i >> 2) + 4 * n + (i & 3); }

struct Unit { int pm, pn; };
struct Gemm { const bf16_t* A; const bf16_t* Bt; int M, N, K; };

struct StaticOrder {
    int nM, nN, nwg, G, c;
    __host__ __device__ void init(int M, int N, int G_, int c_) { nM = M / BM; nN = N / BM; nwg = nM * nN; G = G_; c = c_; }
    __host__ __device__ bool next(int i, Unit& u) const {
        const long L = (long)i * G + c; if (L >= nwg) return false;
        int wgid = (int)L; { const int q = nwg / NXCD, r = nwg % NXCD, xcd = wgid % NXCD, off = wgid / NXCD; wgid = (xcd < r ? xcd * (q + 1) : r * (q + 1) + (xcd - r) * q) + off; }
        const int nig = WGM * nN, gid = wgid / nig, fm = gid * WGM, gsz = (nM - fm) < WGM ? (nM - fm) : WGM;
        u.pm = fm + ((wgid % nig) % gsz); u.pn = (wgid % nig) / gsz; return true;
    }
    __device__ __forceinline__ void a_ready(const Unit&) const {}
    __device__ __forceinline__ void done(const Unit&) const {}
};

typedef float cvt_f32x2_t __attribute__((ext_vector_type(2))); typedef __bf16 cvt_bf16x2_t __attribute__((ext_vector_type(2)));
__device__ __forceinline__ unsigned cvt_pk_bf16(float lo, float hi) { cvt_f32x2_t v = {lo, hi}; cvt_bf16x2_t b = __builtin_convertvector(v, cvt_bf16x2_t); return __builtin_bit_cast(unsigned, b); }
template <class Epi, class Sched, bool ALIGN_EPI = false, bool SP2 = false>
__device__ __forceinline__ void gemm_phase(PG8_LAS unsigned char* lds, const Gemm g, const Sched& S, const Epi& E) {
    const int tid = threadIdx.x, wid = __builtin_amdgcn_readfirstlane(tid >> 6), lane = tid & 63, wr = wid >> 2, wc = wid & 3, fr = lane & 15, fq = lane >> 4;
    const int K = g.K, nt = K / BK;
    unsigned voffA[2], voffB[2];
#pragma unroll
    for (int i = 0; i < 2; ++i) { int R, C; stage_rc(tid * 16 + i * 8192, R, C); const int Rb = Epi::PERM ? ((R & ~31) + perm32(R & 31)) : R;
        voffA[i] = (unsigned)(R * K + C) * 2u; voffB[i] = (unsigned)(Rb * K + C) * 2u; }
    const size_t kstep = (size_t)(BK * 2);
    const size_t hstep = (size_t)HALF * K * 2;
    const size_t tstep = 2 * hstep;
    const unsigned ldsw = (unsigned)wid * 1024u;
    const int aoff = lds_byte(wr * 64 + fr, fq * 8), boff = lds_byte(wc * 32 + fr, fq * 8);
#define PG8_SA(b, h) (((b) * 2 + (h)) * HTB)
#define PG8_SB(b, h) ((4 + (b) * 2 + (h)) * HTB)
#define PG8_STAGE(bufoff, gbase, voff) do { _Pragma("unroll") for (int _i = 0; _i < 2; ++_i) \
        __builtin_amdgcn_global_load_lds((const unsigned*)((const char*)(gbase) + (voff)[_i]), (PG8_LAS unsigned*)(lds + (bufoff) + ldsw + _i * 8192), 16, 0, 0); } while (0)
#define PG8_LDA(dst, b, h) do { _Pragma("unroll") for (int m = 0; m < 4; ++m) _Pragma("unroll") for (int k = 0; k < 2; ++k) dst[m][k] = *(const PG8_LAS bf16x8*)(lds + PG8_SA(b, h) + aoff + m * 2048 + k * 1024); } while (0)
#define PG8_LDB(dst, b, h) do { _Pragma("unroll") for (int n = 0; n < 2; ++n) _Pragma("unroll") for (int k = 0; k < 2; ++k) dst[n][k] = *(const PG8_LAS bf16x8*)(lds + PG8_SB(b, h) + boff + n * 2048 + k * 1024); } while (0)
#define PG8_MMA(ai, bj, At, Bt) do { __builtin_amdgcn_s_setprio(1); _Pragma("unroll") for (int m = 0; m < 4; ++m) _Pragma("unroll") for (int n = 0; n < 2; ++n) _Pragma("unroll") for (int k = 0; k < 2; ++k) \
        acc[ai][bj][m][n] = __builtin_amdgcn_mfma_f32_16x16x32_bf16(Bt[n][k], At[m][k], acc[ai][bj][m][n], 0, 0, 0); __builtin_amdgcn_s_setprio(0); } while (0)
#define PG8_WAIT_V(n) asm volatile("s_waitcnt vmcnt(" #n ")" ::: "memory")
#define PG8_WAIT_L(n) asm volatile("s_waitcnt lgkmcnt(" #n ")" ::: "memory")
#define PG8_BAR __builtin_amdgcn_s_barrier()
#define PG8_SCHED __builtin_amdgcn_sched_barrier(0)
    Unit cur, nxt; int ui = 0;
    if (!S.next(0, cur)) return;
    f32x4 acc[2][2][4][2];
#pragma unroll
    for (int a = 0; a < 2; ++a)
#pragma unroll
        for (int b = 0; b < 2; ++b)
#pragma unroll
            for (int m = 0; m < 4; ++m)
#pragma unroll
                for (int n = 0; n < 2; ++n) acc[a][b][m][n] = (f32x4){0.f, 0.f, 0.f, 0.f};
    bf16x8 At[4][2], B0[2][2], B1[2][2];
    const char* cA = (const char*)g.A + (size_t)cur.pm * tstep; const char* cB = (const char*)g.Bt + (size_t)cur.pn * tstep;
    S.a_ready(cur);
    if constexpr (SP2) {
        PG8_STAGE(PG8_SB(0, 0), cB, voffB); PG8_STAGE(PG8_SB(0, 1), cB + hstep, voffB); PG8_STAGE(PG8_SA(0, 0), cA, voffA); PG8_STAGE(PG8_SA(0, 1), cA + hstep, voffA);
        if (wr == 1) PG8_BAR;
        PG8_WAIT_V(2); PG8_BAR;
        PG8_STAGE(PG8_SB(1, 0), cB + kstep, voffB); PG8_STAGE(PG8_SA(1, 0), cA + kstep, voffA); PG8_STAGE(PG8_SB(1, 1), cB + hstep + kstep, voffB);
        PG8_WAIT_V(6); PG8_BAR;
    } else {
        PG8_STAGE(PG8_SB(0, 0), cB, voffB); PG8_STAGE(PG8_SA(0, 0), cA, voffA); PG8_STAGE(PG8_SB(0, 1), cB + hstep, voffB); PG8_STAGE(PG8_SA(0, 1), cA + hstep, voffA);
        if (wr == 1) PG8_BAR;
        PG8_WAIT_V(4); PG8_BAR;
        PG8_STAGE(PG8_SB(1, 0), cB + kstep, voffB); PG8_STAGE(PG8_SA(1, 0), cA + kstep, voffA); PG8_STAGE(PG8_SB(1, 1), cB + hstep + kstep, voffB);
        PG8_WAIT_V(6); PG8_BAR;
    }
    for (;;) {
        const bool has_next = S.next(ui + 1, nxt);
        const char* nA = has_next ? (const char*)g.A + (size_t)nxt.pm * tstep : cA; const char* nB = has_next ? (const char*)g.Bt + (size_t)nxt.pn * tstep : cB;
        for (int t = 0; t < nt; t += 2) {
            const bool last = (t == nt - 2);
            const char* a1 = cA + (size_t)(t + 1) * kstep;
            const char* a2 = last ? nA : cA + (size_t)(t + 2) * kstep; const char* b2 = last ? nB : cB + (size_t)(t + 2) * kstep;
            const char* a3 = a2 + kstep; const char* b3 = b2 + kstep;
            if (last && has_next) S.a_ready(nxt);
            if constexpr (SP2) {
            PG8_LDB(B0, 0, 0); PG8_LDB(B1, 0, 1); PG8_SCHED; PG8_LDA(At, 0, 0); PG8_STAGE(PG8_SA(1, 1), a1 + hstep, voffA);
            PG8_WAIT_V(8); PG8_WAIT_L(0); PG8_BAR; PG8_MMA(0, 0, At, B0); PG8_MMA(0, 1, At, B1); PG8_BAR; PG8_SCHED;
            PG8_LDA(At, 0, 1); PG8_STAGE(PG8_SB(0, 0), b2, voffB); PG8_STAGE(PG8_SB(0, 1), b2 + hstep, voffB); PG8_STAGE(PG8_SA(0, 0), a2, voffA);
            PG8_WAIT_V(8); PG8_WAIT_L(0); PG8_BAR; PG8_MMA(1, 0, At, B0); PG8_MMA(1, 1, At, B1); PG8_BAR; PG8_SCHED;
            PG8_LDB(B0, 1, 0); PG8_LDB(B1, 1, 1); PG8_SCHED; PG8_LDA(At, 1, 0); PG8_STAGE(PG8_SA(0, 1), a2 + hstep, voffA);
            PG8_WAIT_V(8); PG8_WAIT_L(0); PG8_BAR; PG8_MMA(0, 0, At, B0); PG8_MMA(0, 1, At, B1); PG8_BAR; PG8_SCHED;
            PG8_LDA(At, 1, 1); PG8_STAGE(PG8_SB(1, 0), b3, voffB); PG8_STAGE(PG8_SB(1, 1), b3 + hstep, voffB); PG8_STAGE(PG8_SA(1, 0), a3, voffA);
            PG8_WAIT_V(8); PG8_WAIT_L(0); PG8_BAR; PG8_MMA(1, 0, At, B0); PG8_MMA(1, 1, At, B1); PG8_BAR; PG8_SCHED;
            } else {
            PG8_LDB(B0, 0, 0); PG8_SCHED; PG8_LDA(At, 0, 0); PG8_STAGE(PG8_SA(1, 1), a1 + hstep, voffA);
            PG8_WAIT_L(8); PG8_BAR; PG8_WAIT_L(0); PG8_MMA(0, 0, At, B0); PG8_BAR; PG8_SCHED;
            PG8_LDB(B1, 0, 1); PG8_STAGE(PG8_SB(0, 0), b2, voffB);
            PG8_BAR; PG8_WAIT_L(0); PG8_MMA(0, 1, At, B1); PG8_BAR;
            PG8_LDA(At, 0, 1); PG8_STAGE(PG8_SA(0, 0), a2, voffA);
            PG8_BAR; PG8_WAIT_L(0); PG8_MMA(1, 0, At, B0); PG8_BAR; PG8_SCHED;
            PG8_STAGE(PG8_SB(0, 1), b2 + hstep, voffB);
            PG8_WAIT_V(6); PG8_BAR; PG8_MMA(1, 1, At, B1); PG8_BAR;
            PG8_LDB(B0, 1, 0); PG8_SCHED; PG8_LDA(At, 1, 0); PG8_STAGE(PG8_SA(0, 1), a2 + hstep, voffA);
            PG8_WAIT_L(8); PG8_BAR; PG8_WAIT_L(0); PG8_MMA(0, 0, At, B0); PG8_BAR; PG8_SCHED;
            PG8_LDB(B1, 1, 1); PG8_STAGE(PG8_SB(1, 0), b3, voffB);
            PG8_BAR; PG8_WAIT_L(0); PG8_MMA(0, 1, At, B1); PG8_BAR;
            PG8_LDA(At, 1, 1); PG8_STAGE(PG8_SA(1, 0), a3, voffA);
            PG8_BAR; PG8_WAIT_L(0); PG8_MMA(1, 0, At, B0); PG8_BAR; PG8_SCHED;
            PG8_STAGE(PG8_SB(1, 1), b3 + hstep, voffB);
            PG8_WAIT_V(6); PG8_BAR; PG8_MMA(1, 1, At, B1); PG8_BAR;
            }
        }
        if constexpr (ALIGN_EPI) { if (wr == 0) PG8_BAR; }
        if constexpr (!Epi::AFTER_DRAIN) { E(acc, cur, wr, wc, fr, fq); S.done(cur); }
        if (!has_next) break;
#pragma unroll
        for (int a = 0; a < 2; ++a)
#pragma unroll
            for (int b = 0; b < 2; ++b)
#pragma unroll
                for (int m = 0; m < 4; ++m)
#pragma unroll
                    for (int n = 0; n < 2; ++n) acc[a][b][m][n] = (f32x4){0.f, 0.f, 0.f, 0.f};
        cur = nxt; cA = nA; cB = nB; ++ui;
        if constexpr (ALIGN_EPI) { if (wr == 1) PG8_BAR; }
    }
    PG8_WAIT_V(0);
    if constexpr (!ALIGN_EPI) { if (wr == 0) PG8_BAR; }
    PG8_BAR;
    if constexpr (Epi::AFTER_DRAIN) { E.fused(acc, cur, wr, wc, fr, fq, lds, wid, lane); S.done(cur); }
#undef PG8_SA
#undef PG8_SB
#undef PG8_STAGE
#undef PG8_LDA
#undef PG8_LDB
#undef PG8_MMA
#undef PG8_WAIT_V
#undef PG8_WAIT_L
#undef PG8_BAR
#undef PG8_SCHED
}
}
using pg8::bf16_t; using pg8::f32x4; using pg8::bf16x8; using pg8::u32x4; using pg8::Unit; using pg8::cvt_pk_bf16;
#define LAS __attribute__((address_space(3)))
typedef unsigned u32x2 __attribute__((ext_vector_type(2)));
typedef float f32x2 __attribute__((ext_vector_type(2)));
constexpr int DM = 1024, NBP = 32, SEQ = 2048, NMETA = 16, LP = SEQ + NMETA, NBS = 32, DSEQ = 64;
constexpr int MP = NBP * LP, MS = NBS * DSEQ, M = MP + MS;
constexpr int FF = 2816, NUP = 2 * FF, NIN = 3328, DIN = 3088;
constexpr int NH = 4, DK = 64, DV = 128;
constexpr float EPS = 1e-6f;
static_assert(M % 256 == 0, "M");
constexpr size_t OUT_YP = 0, OUT_YS = (size_t)NBP * SEQ * DM, OUT_SP = OUT_YS + (size_t)MS * DM, OUT_CP = OUT_SP + (size_t)NBP * NH * DK * DV,
                 OUT_SS = OUT_CP + (size_t)NBP * 2 * 512, OUT_CS = OUT_SS + (size_t)NBS * NH * DK * DV, OUT_END = OUT_CS + (size_t)NBS * 2 * 512;
constexpr size_t MiB = 1u << 20;
constexpr size_t WS_SS = 0, SS_STRIDE = 512 * 1024;
constexpr size_t WS_WUP1 = 2 * MiB, WS_WDN1 = 13 * MiB, WS_WIN = 19 * MiB, WS_WOUT = 26 * MiB, WS_WUP2 = 28 * MiB, WS_WDN2 = 39 * MiB;
constexpr size_t WS_BAR = 46 * MiB, BAR_BYTES = 16384;
constexpr size_t WS_XB = 48 * MiB;
constexpr size_t WS_ACT = 184 * MiB;
constexpr size_t WS_QK = 184 * MiB, WS_U = 450 * MiB, WS_LA = 517 * MiB;
constexpr size_t WS_MIX = 584 * MiB, WS_DUMMY = 718 * MiB, WS_END = 719 * MiB;
static_assert(WS_ACT + (size_t)M * FF * 2 <= WS_MIX && WS_LA + (size_t)M * 256 * 4 <= WS_MIX && WS_U + (size_t)M * 512 * 2 <= WS_LA && WS_QK + (size_t)M * 2048 * 2 <= WS_U, "ws map");
static_assert(WS_XB + (size_t)M * DM * 2 <= WS_ACT && WS_MIX + (size_t)M * DM * 2 <= WS_END && WS_WDN2 + (size_t)DM * FF * 2 <= WS_XB, "ws map");

__device__ __forceinline__ const float* xin_row(const float* xp, const float* meta, const float* xs, int R) {
    if (R < MP) { const int b = R / LP, t = R - b * LP; return t < NMETA ? meta + (size_t)t * DM : xp + ((size_t)b * SEQ + (t - NMETA)) * DM; }
    return xs + (size_t)(R - MP) * DM;
}
__device__ __forceinline__ float* yout_row(float* out, int R) {
    if (R < MP) { const int b = R / LP, t = R - b * LP; return t < NMETA ? nullptr : out + ((size_t)b * SEQ + (t - NMETA)) * DM; }
    return out + OUT_YS + (size_t)(R - MP) * DM;
}
__device__ __forceinline__ float bf_lo(unsigned w) { return __uint_as_float(w << 16); }
__device__ __forceinline__ float bf_hi(unsigned w) { return __uint_as_float(w & 0xffff0000u); }
__device__ __forceinline__ float silu_f(float g) { return g * __builtin_amdgcn_rcpf(1.f + __expf(-g)); }
__device__ __forceinline__ float wave_sum(float v) {
#pragma unroll
    for (int o = 1; o < 64; o <<= 1) v += __shfl_xor(v, o);
    return v;
}

struct EpiUp {
    static constexpr bool PERM = true, AFTER_DRAIN = false;
    bf16_t* O; const float* ss;
    __device__ __forceinline__ void operator()(const f32x4 (&acc)[2][2][4][2], const Unit& u, int wr, int wc, int fr, int fq) const {
        const int row0 = u.pm * 256 + wr * 64 + fr, col0 = u.pn * 128 + wc * 32 + 8 * fq;
#pragma unroll
        for (int ai = 0; ai < 2; ++ai)
#pragma unroll
            for (int m = 0; m < 4; ++m) {
                const int row = row0 + ai * 128 + m * 16;
                const float rs = rsqrtf(ss[row] * (1.0f / DM) + EPS);
                float o[8];
#pragma unroll
                for (int n = 0; n < 2; ++n)
#pragma unroll
                    for (int j = 0; j < 4; ++j) { const float g = acc[ai][0][m][n][j] * rs, up = acc[ai][1][m][n][j] * rs; o[4 * n + j] = silu_f(g) * up; }
                u32x4 w; w.x = cvt_pk_bf16(o[0], o[1]); w.y = cvt_pk_bf16(o[2], o[3]); w.z = cvt_pk_bf16(o[4], o[5]); w.w = cvt_pk_bf16(o[6], o[7]);
                *(u32x4*)(O + (size_t)row * FF + col0) = w;
            }
    }
};
template <int MODE> struct EpiRes {
    static constexpr bool PERM = true, AFTER_DRAIN = false;
    const float *xp, *meta, *xs; bf16_t* XB; float* out; float* ss;
    __device__ __forceinline__ void operator()(const f32x4 (&acc)[2][2][4][2], const Unit& u, int wr, int wc, int fr, int fq) const {
        const float alpha = (MODE == 1) ? 1.0f : 0.5f;
#pragma unroll
        for (int ai = 0; ai < 2; ++ai)
#pragma unroll
            for (int m = 0; m < 4; ++m) {
                const int row = u.pm * 256 + ai * 128 + wr * 64 + m * 16 + fr;
                const float* xr = nullptr;
                if (MODE == 0) xr = xin_row(xp, meta, xs, row);
                float sq = 0.f;
#pragma unroll
                for (int bj = 0; bj < 2; ++bj) {
                    const int col = u.pn * 256 + bj * 128 + wc * 32 + 8 * fq;
                    f32x4 b0, b1;
                    if (MODE == 0) { b0 = *(const f32x4*)(xr + col); b1 = *(const f32x4*)(xr + col + 4); }
                    else { const u32x4 w = *(const u32x4*)(XB + (size_t)row * DM + col);
                        b0 = (f32x4){bf_lo(w.x), bf_hi(w.x), bf_lo(w.y), bf_hi(w.y)}; b1 = (f32x4){bf_lo(w.z), bf_hi(w.z), bf_lo(w.w), bf_hi(w.w)}; }
                    const f32x4 v0 = b0 + acc[ai][bj][m][0] * alpha, v1 = b1 + acc[ai][bj][m][1] * alpha;
                    sq += (v0[0] * v0[0] + v0[1] * v0[1]) + (v0[2] * v0[2] + v0[3] * v0[3]) + (v1[0] * v1[0] + v1[1] * v1[1]) + (v1[2] * v1[2] + v1[3] * v1[3]);
                    { u32x4 w; w.x = cvt_pk_bf16(v0[0], v0[1]); w.y = cvt_pk_bf16(v0[2], v0[3]); w.z = cvt_pk_bf16(v1[0], v1[1]); w.w = cvt_pk_bf16(v1[2], v1[3]);
                        *(u32x4*)(XB + (size_t)row * DM + col) = w; }
                }
                sq += __shfl_xor(sq, 16); sq += __shfl_xor(sq, 32);
                if (fq == 0) unsafeAtomicAdd(ss + row, sq);
            }
    }
};
__device__ __forceinline__ float log_sigmoid_f(float z) { const float e = __expf(-fabsf(z)); return fminf(z, 0.f) - __logf(1.f + e); }
struct EpiWin {
    static constexpr bool PERM = true, AFTER_DRAIN = false;
    bf16_t* QK; bf16_t* U; float* LA; const float* ss; const float* b_a;
    __device__ __forceinline__ void operator()(const f32x4 (&acc)[2][2][4][2], const Unit& u, int wr, int wc, int fr, int fq) const {
        const int pn = u.pn;
#pragma unroll
        for (int ai = 0; ai < 2; ++ai)
#pragma unroll
            for (int m = 0; m < 4; ++m) {
                const int row = u.pm * 256 + ai * 128 + wr * 64 + m * 16 + fr;
                const float rs = rsqrtf(ss[row] * (1.0f / DM) + EPS);
                if (pn < 8) {
                    const float sc = (pn == 0) ? rs * 0.125f : rs;
#pragma unroll
                    for (int bj = 0; bj < 2; ++bj) { const f32x4 v0 = acc[ai][bj][m][0] * sc, v1 = acc[ai][bj][m][1] * sc;
                        u32x4 w; w.x = cvt_pk_bf16(v0[0], v0[1]); w.y = cvt_pk_bf16(v0[2], v0[3]); w.z = cvt_pk_bf16(v1[0], v1[1]); w.w = cvt_pk_bf16(v1[2], v1[3]);
                        *(u32x4*)(QK + (size_t)row * 2048 + pn * 256 + bj * 128 + wc * 32 + 8 * fq) = w; }
                } else if (pn < 12) {
                    const float r2 = rs * rs;
                    const f32x4 v0 = acc[ai][0][m][0] * acc[ai][1][m][0] * r2, v1 = acc[ai][0][m][1] * acc[ai][1][m][1] * r2;
                    u32x4 w; w.x = cvt_pk_bf16(v0[0], v0[1]); w.y = cvt_pk_bf16(v0[2], v0[3]); w.z = cvt_pk_bf16(v1[0], v1[1]); w.w = cvt_pk_bf16(v1[2], v1[3]);
                    *(u32x4*)(U + (size_t)row * 512 + (pn - 8) * 128 + wc * 32 + 8 * fq) = w;
                } else {
#pragma unroll
                    for (int bj = 0; bj < 2; ++bj)
#pragma unroll
                        for (int n = 0; n < 2; ++n) { const int c = bj * 128 + wc * 32 + 8 * fq + 4 * n; const f32x4 bb = *(const f32x4*)(b_a + c); f32x4 o;
#pragma unroll
                            for (int j = 0; j < 4; ++j) o[j] = log_sigmoid_f(acc[ai][bj][m][n][j] * rs + bb[j]) * (1.0f / 16.0f);
                            *(f32x4*)(LA + (size_t)row * 256 + c) = o; }
                }
            }
    }
};
__device__ __forceinline__ void tr_item(const float* W, int ldw, int src_col0, const float* gain, bf16_t* WT, int K, int dst_row0, int k0, LAS float* scr, int lane) {
#pragma unroll 8
    for (int i = 0; i < 32; ++i) { const int kk = 2 * i + (lane >> 5); float w = W[(size_t)(k0 + kk) * ldw + src_col0 + (lane & 31)]; if (gain) w *= gain[k0 + kk]; scr[kk * 33 + (lane & 31)] = w; }
    asm volatile("s_waitcnt lgkmcnt(0)" ::: "memory");
    const int c = lane & 7;
#pragma unroll
    for (int j = 0; j < 4; ++j) { const int n = (lane >> 3) + 8 * j; const LAS float* s = scr + (8 * c) * 33 + n;
        u32x4 o; o.x = cvt_pk_bf16(s[0 * 33], s[1 * 33]); o.y = cvt_pk_bf16(s[2 * 33], s[3 * 33]); o.z = cvt_pk_bf16(s[4 * 33], s[5 * 33]); o.w = cvt_pk_bf16(s[6 * 33], s[7 * 33]);
        *(u32x4*)(WT + (size_t)(dst_row0 + n) * K + k0 + 8 * c) = o; }
    asm volatile("s_waitcnt lgkmcnt(0)" ::: "memory");
}
__device__ __forceinline__ int up_src_col(int n) { const int pn = n >> 8, within = n & 255; return (within >> 7) * FF + 128 * pn + (within & 127); }
__device__ __forceinline__ int win_src_col(int n) {
    if (n < 1536) return n;
    if (n < 2048) return n + 16;
    const int j = (n - 2048) >> 8, within = (n - 2048) & 255;
    return ((within >> 7) ? 2576 : 2064) + 128 * j + (within & 127);
}
struct P0Args { const float *xp, *xs, *meta, *n1, *wu1, *wd1, *n2, *win, *wa2, *wout, *n3, *wu2, *wd2; unsigned char* ws; };
__device__ __forceinline__ void p0_prologue(const P0Args& a, LAS unsigned char* lds, int gw, int NGW, int wave, int lane) {
    LAS float* scr = (LAS float*)(lds + wave * 8704);
    constexpr int I_UP = (DM / 64) * (NUP / 32), I_DN = (FF / 64) * (DM / 32), I_IN = (DM / 64) * (3072 / 32), I_OUT = (DM / 64) * (DM / 32);
    constexpr int NITEMS = 2 * I_UP + 2 * I_DN + I_IN + I_OUT;
    bf16_t* WUP1 = (bf16_t*)(a.ws + WS_WUP1); bf16_t* WDN1 = (bf16_t*)(a.ws + WS_WDN1); bf16_t* WIN = (bf16_t*)(a.ws + WS_WIN);
    bf16_t* WOUT = (bf16_t*)(a.ws + WS_WOUT); bf16_t* WUP2 = (bf16_t*)(a.ws + WS_WUP2); bf16_t* WDN2 = (bf16_t*)(a.ws + WS_WDN2);
    for (int it = gw; it < NITEMS; it += NGW) {
        int r = it;
        if (r < 2 * I_UP) { const bool second = r >= I_UP; if (second) r -= I_UP; const int nblk = NUP / 32, kb = r / nblk, nb = r % nblk;
            tr_item(second ? a.wu2 : a.wu1, NUP, up_src_col(32 * nb), second ? a.n3 : a.n1, second ? WUP2 : WUP1, DM, 32 * nb, 64 * kb, scr, lane); continue; }
        r -= 2 * I_UP;
        if (r < 2 * I_DN) { const bool second = r >= I_DN; if (second) r -= I_DN; const int nblk = DM / 32, kb = r / nblk, nb = r % nblk;
            tr_item(second ? a.wd2 : a.wd1, DM, 32 * nb, nullptr, second ? WDN2 : WDN1, FF, 32 * nb, 64 * kb, scr, lane); continue; }
        r -= 2 * I_DN;
        if (r < I_IN) { const int nblk = 3072 / 32, kb = r / nblk, nb = r % nblk;
            tr_item(a.win, DIN, win_src_col(32 * nb), a.n2, WIN, DM, 32 * nb, 64 * kb, scr, lane); continue; }
        r -= I_IN;
        { const int nblk = DM / 32, kb = r / nblk, nb = r % nblk; tr_item(a.wout, DM, 32 * nb, nullptr, WOUT, DM, 32 * nb, 64 * kb, scr, lane); }
    }
    for (int e = gw * 64 + lane; e < 256 * DM; e += NGW * 64) { const int n = e >> 10, k = e & 1023; const float* wr_ = a.win + (size_t)k * DIN + 1536; float s = 0.f;
#pragma unroll
        for (int r = 0; r < 16; ++r) s += wr_[r] * a.wa2[r * 256 + n];
        s *= a.n2[k]; const unsigned short b = (unsigned short)(cvt_pk_bf16(s, 0.f) & 0xffffu); WIN[(size_t)(3072 + n) * DM + k] = b; }
    bf16_t* XB = (bf16_t*)(a.ws + WS_XB); float* ss0 = (float*)(a.ws + WS_SS);
    for (int R = gw; R < M; R += NGW) {
        const f32x4* xr = (const f32x4*)xin_row(a.xp, a.meta, a.xs, R) + lane; f32x4 v[4]; float s = 0.f;
#pragma unroll
        for (int j = 0; j < 4; ++j) { v[j] = xr[64 * j]; s += (v[j][0] * v[j][0] + v[j][1] * v[j][1]) + (v[j][2] * v[j][2] + v[j][3] * v[j][3]); }
        s = wave_sum(s);
        u32x2* o8 = (u32x2*)(XB + (size_t)R * DM) + lane;
#pragma unroll
        for (int j = 0; j < 4; ++j) { u32x2 w; w.x = cvt_pk_bf16(v[j][0], v[j][1]); w.y = cvt_pk_bf16(v[j][2], v[j][3]); o8[64 * j] = w; }
        if (lane == 0) { ss0[R] = s; ss0[R + SS_STRIDE / 4] = 0.f; ss0[R + 2 * (SS_STRIDE / 4)] = 0.f; ss0[R + 3 * (SS_STRIDE / 4)] = 0.f; }
    }
}

struct GlaArgs { const bf16_t* QK; const float* LA; const bf16_t* U; bf16_t* MIX; const float* state_in; const float* cache_conv; const float* g_head; const float* w_conv; float* out; bf16_t* dummy; };
constexpr int RS = 144;
constexpr int VRS = 272;
constexpr int L_G = 0, L_VR = 16384, L_QT = 0, L_ATT = 9216, L_KT = 18432, L_KTT = 27648, L_G2 = 36864, L_EGL = 53248, L_SSQ = 53504, L_VT = 54016, L_ST = 72448, ST_BYTES = 128 * RS, L_SEG = 109312, L_QR = 111360, L_KR = 119552;
__device__ __forceinline__ bf16x8 ldf(LAS const unsigned char* base, int row, int ks, int fq) { return *(const LAS bf16x8*)(base + row * RS + ks * 64 + fq * 16); }
__device__ __forceinline__ void gla_unit(const GlaArgs& a, LAS unsigned char* lds, int unit, int tid, int wave, int lane) {
    const bool samp = unit >= 128; const int s = (unit & 127) >> 2, h = unit & 3;
    const int L = samp ? DSEQ : LP; const int row0 = samp ? MP + s * DSEQ : s * LP;
    const int fr = lane & 15, fq = lane >> 4, rb = wave & 3, vh = wave >> 2;
    LAS float* G = (LAS float*)(lds + L_G); LAS float* G2 = (LAS float*)(lds + L_G2); LAS float* EGL = (LAS float*)(lds + L_EGL); LAS float* SSQ = (LAS float*)(lds + L_SSQ);
    f32x4 Sacc[4], gh[4];
    const size_t sbase = (size_t)(s * NH + h) * DK * DV;
#pragma unroll
    for (int vt = 0; vt < 4; ++vt) { const int v = 64 * vh + 16 * vt + fr;
#pragma unroll
        for (int jj = 0; jj < 4; ++jj) Sacc[vt][jj] = samp ? a.state_in[sbase + (size_t)(16 * rb + 4 * fq + jj) * DV + v] : 0.f;
        u32x2 w; w.x = cvt_pk_bf16(Sacc[vt][0], Sacc[vt][1]); w.y = cvt_pk_bf16(Sacc[vt][2], Sacc[vt][3]);
        *(LAS u32x2*)(lds + L_ST + v * RS + (16 * rb + 4 * fq) * 2) = w;
        gh[vt] = *(const f32x4*)(a.g_head + 64 * vh + 16 * vt + 4 * fq); }
    const int lt = tid >> 3, ld0 = (tid & 7) * 8;
    const int vt_t = tid >> 4, vc = tid & 15;
    u32x4 pq, pk, pv0, pv1; f32x4 pl0, pl1; u32x2 rg0, rg1, rg2, rg3;
    const u32x4 z4 = (u32x4){0u, 0u, 0u, 0u}; const f32x4 zf = (f32x4){0.f, 0.f, 0.f, 0.f};
#define GL16(dst, ptr) dst = *(const u32x4*)(ptr)
#define GL16F(dst, ptr) dst = *(const f32x4*)(ptr)
#define GL8(dst, ptr) dst = *(const u32x2*)(ptr)
#define GLA_ISSUE_P(T0) do { \
        const int tq_ = min((T0) + lt, L - 1), ta_ = min((T0) + vt_t, L - 1), tb_ = min((T0) + vt_t + 32, L - 1); \
        const bf16_t* p_ = a.QK + (size_t)(row0 + tq_) * 2048 + h * 64 + ld0; GL16(pq, p_); GL16(pk, p_ + 256); \
        GL16(pv0, a.QK + (size_t)(row0 + ta_) * 2048 + 512 + h * 128 + vc * 8); GL16F(pl0, a.LA + (size_t)(row0 + ta_) * 256 + h * 64 + vc * 4); \
        GL16(pv1, a.QK + (size_t)(row0 + tb_) * 2048 + 512 + h * 128 + vc * 8); GL16F(pl1, a.LA + (size_t)(row0 + tb_) * 256 + h * 64 + vc * 4); } while (0)
#define GLA_ISSUE_R(T0) do { const bf16_t* r_ = a.QK + (size_t)(row0 + min((T0) + 16 * rb + fr, L - 1)) * 2048 + 1024 + h * 128 + 64 * vh + 4 * fq; \
        GL8(rg0, r_); GL8(rg1, r_ + 16); GL8(rg2, r_ + 32); GL8(rg3, r_ + 48); } while (0)
#define GLA_STAGE(T0) do { \
        if ((T0) + lt >= L) { pq = z4; pk = z4; } \
        if ((T0) + vt_t >= L) { pv0 = z4; pl0 = zf; } \
        if ((T0) + vt_t + 32 >= L) { pv1 = z4; pl1 = zf; } \
        *(LAS f32x4*)(G + vt_t * 64 + vc * 4) = pl0; *(LAS f32x4*)(G + (vt_t + 32) * 64 + vc * 4) = pl1; \
        *(LAS u32x4*)(lds + L_VR + vt_t * VRS + vc * 16) = pv0; *(LAS u32x4*)(lds + L_VR + (vt_t + 32) * VRS + vc * 16) = pv1; \
        *(LAS u32x4*)(lds + L_QR + tid * 16) = pq; *(LAS u32x4*)(lds + L_KR + tid * 16) = pk; } while (0)
    GLA_ISSUE_P(0); GLA_STAGE(0);
    const int nch = (L + 63) >> 6;
    for (int c = 0; c < nch; ++c) {
        const int t0 = c * 64, cur = c & 1;
        __syncthreads();
        GLA_ISSUE_R(t0); GLA_ISSUE_P(t0 + 64);
        { const int d = tid & 63; float c8[8];
#pragma unroll
            for (int e = 0; e < 8; ++e) c8[e] = G[(8 * wave + e) * 64 + d];
#pragma unroll
            for (int e = 1; e < 8; ++e) c8[e] += c8[e - 1];
#pragma unroll
            for (int e = 0; e < 8; ++e) G2[(8 * wave + e) * 64 + d] = c8[e];
            ((LAS float*)(lds + L_SEG))[wave * 64 + d] = c8[7]; }
        { const int v = tid & 127, tg = tid >> 7; unsigned w[8];
#pragma unroll
            for (int e = 0; e < 8; ++e) { const unsigned lo = *(const LAS unsigned short*)(lds + L_VR + (16 * tg + 2 * e) * VRS + v * 2), hi = *(const LAS unsigned short*)(lds + L_VR + (16 * tg + 2 * e + 1) * VRS + v * 2); w[e] = lo | (hi << 16); }
            *(LAS u32x4*)(lds + L_VT + v * RS + tg * 32) = (u32x4){w[0], w[1], w[2], w[3]}; *(LAS u32x4*)(lds + L_VT + v * RS + tg * 32 + 16) = (u32x4){w[4], w[5], w[6], w[7]}; }
        __syncthreads();
        { f32x4 g0 = *(const LAS f32x4*)(G2 + lt * 64 + ld0), g1 = *(const LAS f32x4*)(G2 + lt * 64 + ld0 + 4);
            { const LAS float* SEG = (const LAS float*)(lds + L_SEG) + ld0; const int seg = lt >> 3; f32x4 t0 = zf, t1 = zf;
#pragma unroll
                for (int s8 = 0; s8 < 8; ++s8) { const f32x4 a0 = *(const LAS f32x4*)(SEG + s8 * 64), a1 = *(const LAS f32x4*)(SEG + s8 * 64 + 4);
                    if (s8 < seg) { g0 += a0; g1 += a1; } t0 += a0; t1 += a1; }
                if (lt == 63) { f32x4 e0, e1;
#pragma unroll
                    for (int j = 0; j < 4; ++j) { e0[j] = __expf(t0[j]); e1[j] = __expf(t1[j]); }
                    *(LAS f32x4*)(EGL + ld0) = e0; *(LAS f32x4*)(EGL + ld0 + 4) = e1; } }
            const float gq[8] = {g0[0], g0[1], g0[2], g0[3], g1[0], g1[1], g1[2], g1[3]};
            const u32x4 rq = *(const LAS u32x4*)(lds + L_QR + tid * 16), rk = *(const LAS u32x4*)(lds + L_KR + tid * 16);
            const float qv[8] = {bf_lo(rq.x), bf_hi(rq.x), bf_lo(rq.y), bf_hi(rq.y), bf_lo(rq.z), bf_hi(rq.z), bf_lo(rq.w), bf_hi(rq.w)};
            const float kv[8] = {bf_lo(rk.x), bf_hi(rk.x), bf_lo(rk.y), bf_hi(rk.y), bf_lo(rk.z), bf_hi(rk.z), bf_lo(rk.w), bf_hi(rk.w)};
            float qt[8], kt[8];
#pragma unroll
            for (int e = 0; e < 8; ++e) { qt[e] = qv[e] * __expf(gq[e]); kt[e] = kv[e] * __expf(-gq[e]); }
            *(LAS u32x4*)(lds + L_QT + lt * RS + ld0 * 2) = (u32x4){cvt_pk_bf16(qt[0], qt[1]), cvt_pk_bf16(qt[2], qt[3]), cvt_pk_bf16(qt[4], qt[5]), cvt_pk_bf16(qt[6], qt[7])};
            *(LAS u32x4*)(lds + L_KT + lt * RS + ld0 * 2) = (u32x4){cvt_pk_bf16(kt[0], kt[1]), cvt_pk_bf16(kt[2], kt[3]), cvt_pk_bf16(kt[4], kt[5]), cvt_pk_bf16(kt[6], kt[7])}; }
        const int orow = t0 + 16 * rb + fr; const bool ovalid = orow < L;
        __syncthreads();
        { const int d = tid & 63; unsigned w[4];
#pragma unroll
            for (int e = 0; e < 4; ++e) { const unsigned lo = *(const LAS unsigned short*)(lds + L_KT + (8 * wave + 2 * e) * RS + d * 2), hi = *(const LAS unsigned short*)(lds + L_KT + (8 * wave + 2 * e + 1) * RS + d * 2); w[e] = lo | (hi << 16); }
            *(LAS u32x4*)(lds + L_KTT + d * RS + wave * 16) = (u32x4){w[0], w[1], w[2], w[3]}; }
#pragma unroll
        for (int tt = 0; tt < 2; ++tt) { const int tile = 2 * wave + tt, ib = tile >> 2, jb = tile & 3; f32x4 acc = zf;
            if (jb <= ib) {
#pragma unroll
                for (int ks = 0; ks < 2; ++ks) acc = __builtin_amdgcn_mfma_f32_16x16x32_bf16(ldf(lds + L_KT, 16 * jb + fr, ks, fq), ldf(lds + L_QT, 16 * ib + fr, ks, fq), acc, 0, 0, 0);
                if (jb == ib) {
#pragma unroll
                    for (int jj = 0; jj < 4; ++jj) if (4 * fq + jj > fr) acc[jj] = 0.f; } }
            u32x2 w; w.x = cvt_pk_bf16(acc[0], acc[1]); w.y = cvt_pk_bf16(acc[2], acc[3]);
            *(LAS u32x2*)(lds + L_ATT + (16 * ib + fr) * RS + (16 * jb + 4 * fq) * 2) = w; }
        __syncthreads();
        f32x4 o[4]; float sq = 0.f;
        { const bf16x8 ya0 = ldf(lds + L_ATT, 16 * rb + fr, 0, fq), ya1 = ldf(lds + L_ATT, 16 * rb + fr, 1, fq), ya2 = ldf(lds + L_QT, 16 * rb + fr, 0, fq), ya3 = ldf(lds + L_QT, 16 * rb + fr, 1, fq);
            const bf16x8 kx0 = ldf(lds + L_KTT, 16 * rb + fr, 0, fq), kx1 = ldf(lds + L_KTT, 16 * rb + fr, 1, fq);
            const f32x4 eg = *(const LAS f32x4*)(EGL + 16 * rb + 4 * fq);
            LAS const unsigned char* STc = lds + L_ST + cur * ST_BYTES; LAS unsigned char* STn = lds + L_ST + (cur ^ 1) * ST_BYTES;
#pragma unroll
            for (int vt = 0; vt < 4; ++vt) { const int v0 = 64 * vh + 16 * vt;
                const bf16x8 vx0 = ldf(lds + L_VT, v0 + fr, 0, fq), vx1 = ldf(lds + L_VT, v0 + fr, 1, fq), sx0 = ldf(STc, v0 + fr, 0, fq), sx1 = ldf(STc, v0 + fr, 1, fq);
                f32x4 acc = zf;
                acc = __builtin_amdgcn_mfma_f32_16x16x32_bf16(vx0, ya0, acc, 0, 0, 0); acc = __builtin_amdgcn_mfma_f32_16x16x32_bf16(vx1, ya1, acc, 0, 0, 0);
                acc = __builtin_amdgcn_mfma_f32_16x16x32_bf16(sx0, ya2, acc, 0, 0, 0); acc = __builtin_amdgcn_mfma_f32_16x16x32_bf16(sx1, ya3, acc, 0, 0, 0);
                o[vt] = acc; sq += (acc[0] * acc[0] + acc[1] * acc[1]) + (acc[2] * acc[2] + acc[3] * acc[3]);
                f32x4 sa = Sacc[vt];
                sa = __builtin_amdgcn_mfma_f32_16x16x32_bf16(kx0, vx0, sa, 0, 0, 0); sa = __builtin_amdgcn_mfma_f32_16x16x32_bf16(kx1, vx1, sa, 0, 0, 0);
                sa = sa * eg; Sacc[vt] = sa;
                u32x2 w; w.x = cvt_pk_bf16(sa[0], sa[1]); w.y = cvt_pk_bf16(sa[2], sa[3]);
                *(LAS u32x2*)(STn + (v0 + fr) * RS + (16 * rb + 4 * fq) * 2) = w; } }
        sq += __shfl_xor(sq, 16); sq += __shfl_xor(sq, 32);
        if (fq == 0) SSQ[vh * 64 + 16 * rb + fr] = sq;
        __syncthreads();
        { const float rs = rsqrtf((SSQ[16 * rb + fr] + SSQ[64 + 16 * rb + fr]) * (1.0f / DV) + EPS);
            GLA_STAGE(t0 + 64);
            const u32x2 rg[4] = {rg0, rg1, rg2, rg3};
            bf16_t* mrow = ovalid ? a.MIX + (size_t)(row0 + orow) * DM + h * 128 + 64 * vh + 4 * fq : a.dummy + tid * 64;
            {
#pragma unroll
                for (int vt = 0; vt < 4; ++vt) { const float r0 = bf_lo(rg[vt].x), r1 = bf_hi(rg[vt].x), r2 = bf_lo(rg[vt].y), r3 = bf_hi(rg[vt].y);
                    u32x2 w; w.x = cvt_pk_bf16(o[vt][0] * rs * gh[vt][0] * silu_f(r0), o[vt][1] * rs * gh[vt][1] * silu_f(r1)); w.y = cvt_pk_bf16(o[vt][2] * rs * gh[vt][2] * silu_f(r2), o[vt][3] * rs * gh[vt][3] * silu_f(r3));
                    *(u32x2*)(mrow + 16 * vt) = w; } } }
    }
#undef GLA_ISSUE_P
#undef GLA_ISSUE_R
#undef GLA_STAGE
#undef GL16
#undef GL16F
#undef GL8
    float* sout = a.out + (samp ? OUT_SS : OUT_SP) + sbase;
#pragma unroll
    for (int vt = 0; vt < 4; ++vt)
#pragma unroll
        for (int jj = 0; jj < 4; ++jj) sout[(size_t)(16 * rb + 4 * fq + jj) * DV + 64 * vh + 16 * vt + fr] = Sacc[vt][jj];
    __syncthreads();
}
__device__ __forceinline__ void conv_pass(const GlaArgs& a, int gtid, int nthreads) {
    for (int item = gtid; item < M * 64; item += nthreads) {
        const int R = item >> 6, c8 = (item & 63) * 8;
        int b, t, L; bool samp = R >= MP;
        if (!samp) { b = R / LP; t = R - b * LP; L = LP; } else { const int r2 = R - MP; b = r2 >> 6; t = r2 & 63; L = DSEQ; }
        float u2[8], u1[8], u0[8], bb[8];
        { const u32x4 w = *(const u32x4*)(a.U + (size_t)R * 512 + c8); u2[0] = bf_lo(w.x); u2[1] = bf_hi(w.x); u2[2] = bf_lo(w.y); u2[3] = bf_hi(w.y); u2[4] = bf_lo(w.z); u2[5] = bf_hi(w.z); u2[6] = bf_lo(w.w); u2[7] = bf_hi(w.w); }
        if (t >= 1) { const u32x4 w = *(const u32x4*)(a.U + (size_t)(R - 1) * 512 + c8); u1[0] = bf_lo(w.x); u1[1] = bf_hi(w.x); u1[2] = bf_lo(w.y); u1[3] = bf_hi(w.y); u1[4] = bf_lo(w.z); u1[5] = bf_hi(w.z); u1[6] = bf_lo(w.w); u1[7] = bf_hi(w.w); }
        else {
#pragma unroll
            for (int j = 0; j < 8; ++j) u1[j] = samp ? a.cache_conv[((size_t)b * 2 + 1) * 512 + c8 + j] : 0.f; }
        if (t >= 2) { const u32x4 w = *(const u32x4*)(a.U + (size_t)(R - 2) * 512 + c8); u0[0] = bf_lo(w.x); u0[1] = bf_hi(w.x); u0[2] = bf_lo(w.y); u0[3] = bf_hi(w.y); u0[4] = bf_lo(w.z); u0[5] = bf_hi(w.z); u0[6] = bf_lo(w.w); u0[7] = bf_hi(w.w); }
        else {
#pragma unroll
            for (int j = 0; j < 8; ++j) u0[j] = samp ? a.cache_conv[((size_t)b * 2 + t) * 512 + c8 + j] : 0.f; }
        { const u32x4 w = *(const u32x4*)(a.QK + (size_t)R * 2048 + 1536 + c8); bb[0] = bf_lo(w.x); bb[1] = bf_hi(w.x); bb[2] = bf_lo(w.y); bb[3] = bf_hi(w.y); bb[4] = bf_lo(w.z); bb[5] = bf_hi(w.z); bb[6] = bf_lo(w.w); bb[7] = bf_hi(w.w); }
        float o[8];
#pragma unroll
        for (int j = 0; j < 8; ++j) o[j] = bb[j] * (a.w_conv[c8 + j] * u0[j] + a.w_conv[512 + c8 + j] * u1[j] + a.w_conv[1024 + c8 + j] * u2[j]);
        u32x4 w; w.x = cvt_pk_bf16(o[0], o[1]); w.y = cvt_pk_bf16(o[2], o[3]); w.z = cvt_pk_bf16(o[4], o[5]); w.w = cvt_pk_bf16(o[6], o[7]);
        *(u32x4*)(a.MIX + (size_t)R * DM + 512 + c8) = w;
        if (t >= L - 2) { float* oc = a.out + (samp ? OUT_CS : OUT_CP) + ((size_t)b * 2 + (t - (L - 2))) * 512 + c8;
            *(f32x4*)oc = (f32x4){u2[0], u2[1], u2[2], u2[3]}; *(f32x4*)(oc + 4) = (f32x4){u2[4], u2[5], u2[6], u2[7]}; }
    }
}
__device__ __forceinline__ void final_norm(float* out, const bf16_t* XB, const float* ss3, const float* gfin, int gw, int NGW, int lane) {
    constexpr int NR = NBP * SEQ + MS;
    f32x4 g0 = ((const f32x4*)gfin)[2 * lane], g1 = ((const f32x4*)gfin)[2 * lane + 1], g2 = ((const f32x4*)gfin)[128 + 2 * lane], g3 = ((const f32x4*)gfin)[128 + 2 * lane + 1];
    for (int Rp = gw; Rp < NR; Rp += NGW) {
        int R; if (Rp < NBP * SEQ) { const int b = Rp >> 11, t = Rp & 2047; R = b * LP + NMETA + t; } else R = MP + (Rp - NBP * SEQ);
        const float rs = rsqrtf(ss3[R] * (1.0f / DM) + EPS);
        const u32x4 w0 = *((const u32x4*)(XB + (size_t)R * DM) + lane), w1 = *((const u32x4*)(XB + (size_t)R * DM) + 64 + lane);
        f32x4* yr = (f32x4*)(out + (size_t)Rp * DM);
        yr[2 * lane] = (f32x4){bf_lo(w0.x), bf_hi(w0.x), bf_lo(w0.y), bf_hi(w0.y)} * rs * g0; yr[2 * lane + 1] = (f32x4){bf_lo(w0.z), bf_hi(w0.z), bf_lo(w0.w), bf_hi(w0.w)} * rs * g1;
        yr[128 + 2 * lane] = (f32x4){bf_lo(w1.x), bf_hi(w1.x), bf_lo(w1.y), bf_hi(w1.y)} * rs * g2; yr[128 + 2 * lane + 1] = (f32x4){bf_lo(w1.z), bf_hi(w1.z), bf_lo(w1.w), bf_hi(w1.w)} * rs * g3;
    }
}

#define XB_TMO      128
#define XB_XCNT(j)  (256  + 64 * (j))
#define XB_XSUB(j)  (1280 + 64 * (j))
#define XB_XGEN(j)  (2304 + 64 * (j))
#define XB_TOP      3328
#define XB_TOPGEN   3392
#define XCD_BAR_WORDS 3456
#define XB_SPIN_CAP (1u << 18)

__device__ __forceinline__ unsigned xb_ld(unsigned* p)              { return __hip_atomic_load(p, __ATOMIC_RELAXED, __HIP_MEMORY_SCOPE_AGENT); }
__device__ __forceinline__ unsigned xb_add(unsigned* p, unsigned v) { return __hip_atomic_fetch_add(p, v, __ATOMIC_RELAXED, __HIP_MEMORY_SCOPE_AGENT); }
__device__ __forceinline__ unsigned xb_xcc_id() { return (unsigned)__builtin_amdgcn_s_getreg((3 << 11) | 20) & 0xFu; }
#define XB_SPIN(cond, bar) do { unsigned _sp = 0; while (cond) { __builtin_amdgcn_s_sleep(1); \
    if ((++_sp & 255u) == 0u) { if (xb_ld(&(bar)[XB_TMO])) break; if (_sp > XB_SPIN_CAP) { atomicAdd(&(bar)[XB_TMO], 1u); break; } } } } while (0)

struct XcdBarrier {
    unsigned* bar; unsigned x;
    volatile LAS unsigned* st;
};

__device__ __forceinline__ XcdBarrier xcd_barrier_post(unsigned* bar, volatile LAS unsigned* st) {
    XcdBarrier b; b.bar = bar; b.x = xb_xcc_id(); b.st = st;
    if (threadIdx.x == 0) (void)xb_add(&bar[XB_XCNT(b.x)], 1u);
    return b;
}
__device__ __forceinline__ void xcd_barrier_complete(unsigned* bar, unsigned x, unsigned& nloc, unsigned& nx) {
    const unsigned G = gridDim.x * gridDim.y * gridDim.z;
    unsigned sum, cnt, mine, sp = 0u;
    for (;;) {
        sum = 0u; cnt = 0u; mine = 0u;
#pragma unroll
        for (unsigned j = 0; j < 16; ++j) { const unsigned c = xb_ld(&bar[XB_XCNT(j)]); sum += c; cnt += (c > 0u) ? 1u : 0u; mine = (j == x) ? c : mine; }
        if (sum == G) break;
        __builtin_amdgcn_s_sleep(1);
        if ((++sp & 255u) == 0u) { if (xb_ld(&bar[XB_TMO])) break; if (sp > XB_SPIN_CAP) { atomicAdd(&bar[XB_TMO], 1u); break; } }
    }
    nloc = mine > 0u ? mine : 1u; nx = cnt > 0u ? cnt : 1u;
}

__device__ __forceinline__ void xcd_barrier(const XcdBarrier& b) {
    asm volatile("s_waitcnt vmcnt(0)" ::: "memory");
    __syncthreads();
    if (threadIdx.x == 0) {
        unsigned* bar = b.bar;
        __builtin_amdgcn_s_waitcnt(0);
        unsigned nloc = b.st[0], nx = b.st[1];
        if (nloc == 0u) { xcd_barrier_complete(bar, b.x, nloc, nx); b.st[0] = nloc; b.st[1] = nx; }
        const unsigned old = xb_add(&bar[XB_XSUB(b.x)], 1u);
        const unsigned gen = old / nloc;
        if (old + 1u == (gen + 1u) * nloc) {
            __builtin_amdgcn_fence(__ATOMIC_RELEASE, "agent");
            asm volatile("s_waitcnt vmcnt(0)" ::: "memory");
            const unsigned og = xb_add(&bar[XB_TOP], 1u);
            const unsigned tg = og / nx;
            if (og + 1u == (tg + 1u) * nx) xb_add(&bar[XB_TOPGEN], 1u);
            else XB_SPIN(xb_ld(&bar[XB_TOPGEN]) == tg, bar);
            __builtin_amdgcn_fence(__ATOMIC_ACQUIRE, "agent");
            xb_add(&bar[XB_XGEN(b.x)], 1u);
            asm volatile("s_waitcnt vmcnt(0)" ::: "memory");
        } else {
            XB_SPIN(xb_ld(&bar[XB_XGEN(b.x)]) == gen, bar);
            __builtin_amdgcn_fence(__ATOMIC_ACQUIRE, "agent");
            asm volatile("s_waitcnt vmcnt(0)" ::: "memory");
        }
    }
    __syncthreads();
}

struct Args { const float* in[19]; float* out; unsigned char* ws; int ph_lo, ph_hi; };
constexpr int LDS_BYTES = 147456;
__global__ void __launch_bounds__(512, 2) fwd_kernel(Args args) {
    extern __shared__ __attribute__((aligned(16))) unsigned char lds_raw[];
    LAS unsigned char* lds = (LAS unsigned char*)lds_raw;
    cg::grid_group grid = cg::this_grid();
    const int tid = threadIdx.x, lane = tid & 63, wave = __builtin_amdgcn_readfirstlane(tid >> 6);
    const int G = gridDim.x, bx = blockIdx.x;
    const int gw = bx * 8 + wave, NGW = G * 8;
    unsigned char* ws = args.ws;
    const float *x_prompt = args.in[0], *x_sample = args.in[1], *state_gla = args.in[2], *cache_conv = args.in[3], *meta = args.in[4], *norm_ffn1 = args.in[5], *w_up1 = args.in[6], *w_down1 = args.in[7],
                *norm_mix = args.in[8], *w_in = args.in[9], *w_a2 = args.in[10], *b_a = args.in[11], *g_head = args.in[12], *w_conv = args.in[13], *w_out = args.in[14], *norm_ffn2 = args.in[15],
                *w_up2 = args.in[16], *w_down2 = args.in[17], *norm_final = args.in[18];
    bf16_t* XB = (bf16_t*)(ws + WS_XB); bf16_t* ACT = (bf16_t*)(ws + WS_ACT); bf16_t* QK = (bf16_t*)(ws + WS_QK); bf16_t* U = (bf16_t*)(ws + WS_U); float* LA = (float*)(ws + WS_LA); bf16_t* MIX = (bf16_t*)(ws + WS_MIX);
    float* ss0 = (float*)(ws + WS_SS); float* ss1 = ss0 + SS_STRIDE / 4; float* ss2 = ss1 + SS_STRIDE / 4; float* ss3 = ss2 + SS_STRIDE / 4;
    const int lo = args.ph_lo, hi = args.ph_hi;
    volatile LAS unsigned* bst = (volatile LAS unsigned*)(lds + 140000);
    if (tid < 2) bst[tid] = 0u;
    __syncthreads();
    XcdBarrier xbar = xcd_barrier_post((unsigned*)(ws + WS_BAR), bst);
#define IN(k) (lo <= (k) && (k) < hi)
#define SEAM(k) do { if (IN(k) && IN((k) + 1)) { asm volatile("s_waitcnt vmcnt(0) lgkmcnt(0)" ::: "memory"); if (lo == 12345) grid.sync(); xcd_barrier(xbar); __builtin_amdgcn_fence(__ATOMIC_ACQUIRE, "agent"); asm volatile("s_waitcnt vmcnt(0)" ::: "memory"); } } while (0)
    if (IN(0)) {
        P0Args pa{x_prompt, x_sample, meta, norm_ffn1, w_up1, w_down1, norm_mix, w_in, w_a2, w_out, norm_ffn2, w_up2, w_down2, ws};
        p0_prologue(pa, lds, gw, NGW, wave, lane);
    }
    SEAM(0);
    if (IN(1)) {
        pg8::Gemm g{XB, (const bf16_t*)(ws + WS_WUP1), M, NUP, DM}; pg8::StaticOrder S; S.init(M, NUP, G, bx);
        EpiUp E{ACT, ss0};
        pg8::gemm_phase<EpiUp, pg8::StaticOrder, true, true>(lds, g, S, E);
    }
    SEAM(1);
    if (IN(2)) {
        pg8::Gemm g{ACT, (const bf16_t*)(ws + WS_WDN1), M, DM, FF}; pg8::StaticOrder S; S.init(M, DM, G, bx);
        EpiRes<0> E{x_prompt, meta, x_sample, XB, args.out, ss1};
        pg8::gemm_phase<EpiRes<0>, pg8::StaticOrder, true, true>(lds, g, S, E);
    }
    SEAM(2);
    if (IN(3)) {
        pg8::Gemm g{XB, (const bf16_t*)(ws + WS_WIN), M, NIN, DM}; pg8::StaticOrder S; S.init(M, NIN, G, bx);
        EpiWin E{QK, U, LA, ss1, b_a};
        pg8::gemm_phase<EpiWin, pg8::StaticOrder, true, true>(lds, g, S, E);
    }
    SEAM(3);
    if (IN(4)) {
        GlaArgs ga{QK, LA, U, MIX, state_gla, cache_conv, g_head, w_conv, args.out, (bf16_t*)(ws + WS_DUMMY)};
        for (int unit = bx; unit < 256; unit += G) gla_unit(ga, lds, unit, tid, wave, lane);
        if (G == 256) { if (bx >= 128) conv_pass(ga, (bx - 128) * 512 + tid, 128 * 512); }
        else conv_pass(ga, bx * 512 + tid, G * 512);
    }
    SEAM(4);
    if (IN(5)) {
        pg8::Gemm g{MIX, (const bf16_t*)(ws + WS_WOUT), M, DM, DM}; pg8::StaticOrder S; S.init(M, DM, G, bx);
        EpiRes<1> E{x_prompt, meta, x_sample, XB, args.out, ss2};
        pg8::gemm_phase<EpiRes<1>, pg8::StaticOrder, true, true>(lds, g, S, E);
    }
    SEAM(5);
    if (IN(6)) {
        pg8::Gemm g{XB, (const bf16_t*)(ws + WS_WUP2), M, NUP, DM}; pg8::StaticOrder S; S.init(M, NUP, G, bx);
        EpiUp E{ACT, ss2};
        pg8::gemm_phase<EpiUp, pg8::StaticOrder, true, true>(lds, g, S, E);
    }
    SEAM(6);
    if (IN(7)) {
        pg8::Gemm g{ACT, (const bf16_t*)(ws + WS_WDN2), M, DM, FF}; pg8::StaticOrder S; S.init(M, DM, G, bx);
        EpiRes<2> E{x_prompt, meta, x_sample, XB, args.out, ss3};
        pg8::gemm_phase<EpiRes<2>, pg8::StaticOrder, true, true>(lds, g, S, E);
    }
    SEAM(7);
    if (IN(8)) final_norm(args.out, XB, ss3, norm_final, gw, NGW, lane);
#undef IN
#undef SEAM
}

#ifndef N_LAUNCH_MODE
#define N_LAUNCH_MODE 1
#endif
extern "C" void kernel_launch(void* const* d_in, const int* in_sizes, int n_in, void* d_out, int out_size, void* d_ws, size_t ws_size, hipStream_t stream) {
    static int grid = 0;
    if (grid == 0) {
        if (n_in != 19 || ws_size < WS_END || (size_t)out_size != OUT_END) { fprintf(stderr, "kernel_launch: unexpected sizes n_in %d ws %zu out %d\n", n_in, ws_size, out_size); grid = -1; return; }
        int dev = 0, cus = 0, per_cu = 0;
        hipGetDevice(&dev); hipDeviceGetAttribute(&cus, hipDeviceAttributeMultiprocessorCount, dev);
        if (hipFuncSetAttribute((const void*)fwd_kernel, hipFuncAttributeMaxDynamicSharedMemorySize, LDS_BYTES) != hipSuccess) { fprintf(stderr, "kernel_launch: hipFuncSetAttribute failed\n"); grid = -1; return; }
        if (hipOccupancyMaxActiveBlocksPerMultiprocessor(&per_cu, (const void*)fwd_kernel, 512, LDS_BYTES) != hipSuccess || per_cu < 1) { fprintf(stderr, "kernel_launch: occupancy query says %d\n", per_cu); per_cu = 1; }
        (void)hipGetLastError();
        grid = cus * per_cu;
    }
    if (grid < 0) return;
    Args a{};
    for (int i = 0; i < 19; ++i) a.in[i] = (const float*)d_in[i];
    a.out = (float*)d_out; a.ws = (unsigned char*)d_ws;
#if N_LAUNCH_MODE == 1
    if (hipMemsetAsync((char*)d_ws + WS_BAR, 0, BAR_BYTES, stream) != hipSuccess) { fprintf(stderr, "kernel_launch: memset of the barrier words failed\n"); return; }
    a.ph_lo = 0; a.ph_hi = 9;
    void* kargs[] = {&a};
    hipError_t e = hipLaunchCooperativeKernel((const void*)fwd_kernel, dim3(grid), dim3(512), kargs, LDS_BYTES, stream);
    if (e != hipSuccess) fprintf(stderr, "cooperative launch failed: %s (grid %d)\n", hipGetErrorString(e), grid);
#else
    for (int p = 0; p < 9; ++p) { a.ph_lo = p; a.ph_hi = p + 1; hipLaunchKernelGGL(fwd_kernel, dim3(grid), dim3(512), LDS_BYTES, stream, a); }
#endif
}
```

```cpp
#include <hip/hip_runtime.h>
#include <hip/hip_cooperative_groups.h>
#include <cstdio>
#include <cstdint>
namespace cg = cooperative_groups;
namespace pg8 {
#define PG8_LAS __attribute__((address_space(3)))
typedef unsigned short bf16_t;
typedef short bf16x8 __attribute__((ext_vector_type(8)));
typedef float f32x4 __attribute__((ext_vector_type(4)));
typedef unsigned u32x4 __attribute__((ext_vector_type(4)));
constexpr int BM = 256, BK = 64, HALF = 128, HTB = HALF * BK * 2  , STAGE_BYTES = 8 * HTB, NXCD = 8, WGM = 8;

__host__ __device__ __forceinline__ int lds_byte(int r, int c) { const int st = (r >> 4) * 2 + (c >> 5), rr = r & 15, cc = c & 31, ob = rr * 64 + cc * 2; return st * 1024 + (ob ^ (((ob >> 9) & 1) << 5)); }
__host__ __device__ __forceinline__ void stage_rc(int b, int& R, int& C) { const int st = b / 1024, sb = b % 1024, swz = sb ^ (((sb >> 9) & 1) << 5); R = (st >> 1) * 16 + swz / 64; C = (st & 1) * 32 + (swz % 64) / 2; }
__host__ __device__ __forceinline__ int perm32(int rho) { const int n = rho >> 4, i = rho & 15; return 8 * (i >> 2) + 4 * n + (i & 3); }

struct Unit { int pm, pn; };
struct Gemm { const bf16_t* A; const bf16_t* Bt; int M, N, K; };

struct StaticOrder {
    int nM, nN, nwg, G, c;
    __host__ __device__ void init(int M, int N, int G_, int c_) { nM = M / BM; nN = N / BM; nwg = nM * nN; G = G_; c = c_; }
    __host__ __device__ bool next(int i, Unit& u) const {
        const long L = (long)i * G + c; if (L >= nwg) return false;
        int wgid = (int)L; { const int q = nwg / NXCD, r = nwg % NXCD, xcd = wgid % NXCD, off = wgid / NXCD; wgid = (xcd < r ? xcd * (q + 1) : r * (q + 1) + (xcd - r) * q) + off; }
        const int nig = WGM * nN, gid = wgid / nig, fm = gid * WGM, gsz = (nM - fm) < WGM ? (nM - fm) : WGM;
        u.pm = fm + ((wgid % nig) % gsz); u.pn = (wgid % nig) / gsz; return true;
    }
    __device__ __forceinline__ void a_ready(const Unit&) const {}
    __device__ __forceinline__ void done(const Unit&) const {}
};

typedef float cvt_f32x2_t __attribute__((ext_vector_type(2))); typedef __bf16 cvt_bf16x2_t __attribute__((ext_vector_type(2)));
__device__ __forceinline__ unsigned cvt_pk_bf16(float lo, float hi) { cvt_f32x2_t v = {lo, hi}; cvt_bf16x2_t b = __builtin_convertvector(v, cvt_bf16x2_t); return __builtin_bit_cast(unsigned, b); }
template <class Epi, class Sched, bool ALIGN_EPI = false, bool SP2 = false>
__device__ __forceinline__ void gemm_phase(PG8_LAS unsigned char* lds, const Gemm g, const Sched& S, const Epi& E) {
    const int tid = threadIdx.x, wid = __builtin_amdgcn_readfirstlane(tid >> 6), lane = tid & 63, wr = wid >> 2, wc = wid & 3, fr = lane & 15, fq = lane >> 4;
    const int K = g.K, nt = K / BK;
    unsigned voffA[2], voffB[2];
#pragma unroll
    for (int i = 0; i < 2; ++i) { int R, C; stage_rc(tid * 16 + i * 8192, R, C); const int Rb = Epi::PERM ? ((R & ~31) + perm32(R & 31)) : R;
        voffA[i] = (unsigned)(R * K + C) * 2u; voffB[i] = (unsigned)(Rb * K + C) * 2u; }
    const size_t kstep = (size_t)(BK * 2);
    const size_t hstep = (size_t)HALF * K * 2;
    const size_t tstep = 2 * hstep;
    const unsigned ldsw = (unsigned)wid * 1024u;
    const int aoff = lds_byte(wr * 64 + fr, fq * 8), boff = lds_byte(wc * 32 + fr, fq * 8);
#define PG8_SA(b, h) (((b) * 2 + (h)) * HTB)
#define PG8_SB(b, h) ((4 + (b) * 2 + (h)) * HTB)
#define PG8_STAGE(bufoff, gbase, voff) do { _Pragma("unroll") for (int _i = 0; _i < 2; ++_i) \
        __builtin_amdgcn_global_load_lds((const unsigned*)((const char*)(gbase) + (voff)[_i]), (PG8_LAS unsigned*)(lds + (bufoff) + ldsw + _i * 8192), 16, 0, 0); } while (0)
#define PG8_LDA(dst, b, h) do { _Pragma("unroll") for (int m = 0; m < 4; ++m) _Pragma("unroll") for (int k = 0; k < 2; ++k) dst[m][k] = *(const PG8_LAS bf16x8*)(lds + PG8_SA(b, h) + aoff + m * 2048 + k * 1024); } while (0)
#define PG8_LDB(dst, b, h) do { _Pragma("unroll") for (int n = 0; n < 2; ++n) _Pragma("unroll") for (int k = 0; k < 2; ++k) dst[n][k] = *(const PG8_LAS bf16x8*)(lds + PG8_SB(b, h) + boff + n * 2048 + k * 1024); } while (0)
#define PG8_MMA(ai, bj, At, Bt) do { __builtin_amdgcn_s_setprio(1); _Pragma("unroll") for (int m = 0; m < 4; ++m) _Pragma("unroll") for (int n = 0; n < 2; ++n) _Pragma("unroll") for (int k = 0; k < 2; ++k) \
        acc[ai][bj][m][n] = __builtin_amdgcn_mfma_f32_16x16x32_bf16(Bt[n][k], At[m][k], acc[ai][bj][m][n], 0, 0, 0); __builtin_amdgcn_s_setprio(0); } while (0)
#define PG8_WAIT_V(n) asm volatile("s_waitcnt vmcnt(" #n ")" ::: "memory")
#define PG8_WAIT_L(n) asm volatile("s_waitcnt lgkmcnt(" #n ")" ::: "memory")
#define PG8_BAR __builtin_amdgcn_s_barrier()
#define PG8_SCHED __builtin_amdgcn_sched_barrier(0)
    Unit cur, nxt; int ui = 0;
    if (!S.next(0, cur)) return;
    f32x4 acc[2][2][4][2];
#pragma unroll
    for (int a = 0; a < 2; ++a)
#pragma unroll
        for (int b = 0; b < 2; ++b)
#pragma unroll
            for (int m = 0; m < 4; ++m)
#pragma unroll
                for (int n = 0; n < 2; ++n) acc[a][b][m][n] = (f32x4){0.f, 0.f, 0.f, 0.f};
    bf16x8 At[4][2], B0[2][2], B1[2][2];
    const char* cA = (const char*)g.A + (size_t)cur.pm * tstep; const char* cB = (const char*)g.Bt + (size_t)cur.pn * tstep;
    S.a_ready(cur);
    if constexpr (SP2) {
        PG8_STAGE(PG8_SB(0, 0), cB, voffB); PG8_STAGE(PG8_SB(0, 1), cB + hstep, voffB); PG8_STAGE(PG8_SA(0, 0), cA, voffA); PG8_STAGE(PG8_SA(0, 1), cA + hstep, voffA);
        if (wr == 1) PG8_BAR;
        PG8_WAIT_V(2); PG8_BAR;
        PG8_STAGE(PG8_SB(1, 0), cB + kstep, voffB); PG8_STAGE(PG8_SA(1, 0), cA + kstep, voffA); PG8_STAGE(PG8_SB(1, 1), cB + hstep + kstep, voffB);
        PG8_WAIT_V(6); PG8_BAR;
    } else {
        PG8_STAGE(PG8_SB(0, 0), cB, voffB); PG8_STAGE(PG8_SA(0, 0), cA, voffA); PG8_STAGE(PG8_SB(0, 1), cB + hstep, voffB); PG8_STAGE(PG8_SA(0, 1), cA + hstep, voffA);
        if (wr == 1) PG8_BAR;
        PG8_WAIT_V(4); PG8_BAR;
        PG8_STAGE(PG8_SB(1, 0), cB + kstep, voffB); PG8_STAGE(PG8_SA(1, 0), cA + kstep, voffA); PG8_STAGE(PG8_SB(1, 1), cB + hstep + kstep, voffB);
        PG8_WAIT_V(6); PG8_BAR;
    }
    for (;;) {
        const bool has_next = S.next(ui + 1, nxt);
        const char* nA = has_next ? (const char*)g.A + (size_t)nxt.pm * tstep : cA; const char* nB = has_next ? (const char*)g.Bt + (size_t)nxt.pn * tstep : cB;
        for (int t = 0; t < nt; t += 2) {
            const bool last = (t == nt - 2);
            const char* a1 = cA + (size_t)(t + 1) * kstep;
            const char* a2 = last ? nA : cA + (size_t)(t + 2) * kstep; const char* b2 = last ? nB : cB + (size_t)(t + 2) * kstep;
            const char* a3 = a2 + kstep; const char* b3 = b2 + kstep;
            if (last && has_next) S.a_ready(nxt);
            if constexpr (SP2) {
            PG8_LDB(B0, 0, 0); PG8_LDB(B1, 0, 1); PG8_SCHED; PG8_LDA(At, 0, 0); PG8_STAGE(PG8_SA(1, 1), a1 + hstep, voffA);
            PG8_WAIT_V(8); PG8_WAIT_L(0); PG8_BAR; PG8_MMA(0, 0, At, B0); PG8_MMA(0, 1, At, B1); PG8_BAR; PG8_SCHED;
            PG8_LDA(At, 0, 1); PG8_STAGE(PG8_SB(0, 0), b2, voffB); PG8_STAGE(PG8_SB(0, 1), b2 + hstep, voffB); PG8_STAGE(PG8_SA(0, 0), a2, voffA);
            PG8_WAIT_V(8); PG8_WAIT_L(0); PG8_BAR; PG8_MMA(1, 0, At, B0); PG8_MMA(1, 1, At, B1); PG8_BAR; PG8_SCHED;
            PG8_LDB(B0, 1, 0); PG8_LDB(B1, 1, 1); PG8_SCHED; PG8_LDA(At, 1, 0); PG8_STAGE(PG8_SA(0, 1), a2 + hstep, voffA);
            PG8_WAIT_V(8); PG8_WAIT_L(0); PG8_BAR; PG8_MMA(0, 0, At, B0); PG8_MMA(0, 1, At, B1); PG8_BAR; PG8_SCHED;
            PG8_LDA(At, 1, 1); PG8_STAGE(PG8_SB(1, 0), b3, voffB); PG8_STAGE(PG8_SB(1, 1), b3 + hstep, voffB); PG8_STAGE(PG8_SA(1, 0), a3, voffA);
            PG8_WAIT_V(8); PG8_WAIT_L(0); PG8_BAR; PG8_MMA(1, 0, At, B0); PG8_MMA(1, 1, At, B1); PG8_BAR; PG8_SCHED;
            } else {
            PG8_LDB(B0, 0, 0); PG8_SCHED; PG8_LDA(At, 0, 0); PG8_STAGE(PG8_SA(1, 1), a1 + hstep, voffA);
            PG8_WAIT_L(8); PG8_BAR; PG8_WAIT_L(0); PG8_MMA(0, 0, At, B0); PG8_BAR; PG8_SCHED;
            PG8_LDB(B1, 0, 1); PG8_STAGE(PG8_SB(0, 0), b2, voffB);
            PG8_BAR; PG8_WAIT_L(0); PG8_MMA(0, 1, At, B1); PG8_BAR;
            PG8_LDA(At, 0, 1); PG8_STAGE(PG8_SA(0, 0), a2, voffA);
            PG8_BAR; PG8_WAIT_L(0); PG8_MMA(1, 0, At, B0); PG8_BAR; PG8_SCHED;
            PG8_STAGE(PG8_SB(0, 1), b2 + hstep, voffB);
            PG8_WAIT_V(6); PG8_BAR; PG8_MMA(1, 1, At, B1); PG8_BAR;
            PG8_LDB(B0, 1, 0); PG8_SCHED; PG8_LDA(At, 1, 0); PG8_STAGE(PG8_SA(0, 1), a2 + hstep, voffA);
            PG8_WAIT_L(8); PG8_BAR; PG8_WAIT_L(0); PG8_MMA(0, 0, At, B0); PG8_BAR; PG8_SCHED;
            PG8_LDB(B1, 1, 1); PG8_STAGE(PG8_SB(1, 0), b3, voffB);
            PG8_BAR; PG8_WAIT_L(0); PG8_MMA(0, 1, At, B1); PG8_BAR;
            PG8_LDA(At, 1, 1); PG8_STAGE(PG8_SA(1, 0), a3, voffA);
            PG8_BAR; PG8_WAIT_L(0); PG8_MMA(1, 0, At, B0); PG8_BAR; PG8_SCHED;
            PG8_STAGE(PG8_SB(1, 1), b3 + hstep, voffB);
            PG8_WAIT_V(6); PG8_BAR; PG8_MMA(1, 1, At, B1); PG8_BAR;
            }
        }
        if constexpr (ALIGN_EPI) { if (wr == 0) PG8_BAR; }
        if constexpr (!Epi::AFTER_DRAIN) { E(acc, cur, wr, wc, fr, fq); S.done(cur); }
        if (!has_next) break;
#pragma unroll
        for (int a = 0; a < 2; ++a)
#pragma unroll
            for (int b = 0; b < 2; ++b)
#pragma unroll
                for (int m = 0; m < 4; ++m)
#pragma unroll
                    for (int n = 0; n < 2; ++n) acc[a][b][m][n] = (f32x4){0.f, 0.f, 0.f, 0.f};
        cur = nxt; cA = nA; cB = nB; ++ui;
        if constexpr (ALIGN_EPI) { if (wr == 1) PG8_BAR; }
    }
    PG8_WAIT_V(0);
    if constexpr (!ALIGN_EPI) { if (wr == 0) PG8_BAR; }
    PG8_BAR;
    if constexpr (Epi::AFTER_DRAIN) { E.fused(acc, cur, wr, wc, fr, fq, lds, wid, lane); S.done(cur); }
#undef PG8_SA
#undef PG8_SB
#undef PG8_STAGE
#undef PG8_LDA
#undef PG8_LDB
#undef PG8_MMA
#undef PG8_WAIT_V
#undef PG8_WAIT_L
#undef PG8_BAR
#undef PG8_SCHED
}
}
using pg8::bf16_t; using pg8::f32x4; using pg8::bf16x8; using pg8::u32x4; using pg8::Unit; using pg8::cvt_pk_bf16;
#define LAS __attribute__((address_space(3)))
typedef unsigned u32x2 __attribute__((ext_vector_type(2)));
typedef float f32x2 __attribute__((ext_vector_type(2)));
constexpr int DM = 1024, NBP = 32, SEQ = 2048, NMETA = 16, LP = SEQ + NMETA, NBS = 32, DSEQ = 64;
constexpr int MP = NBP * LP, MS = NBS * DSEQ, M = MP + MS;
constexpr int FF = 2816, NUP = 2 * FF, NIN = 3328, DIN = 3088;
constexpr int NH = 4, DK = 64, DV = 128;
constexpr float EPS = 1e-6f;
static_assert(M % 256 == 0, "M");
constexpr size_t OUT_YP = 0, OUT_YS = (size_t)NBP * SEQ * DM, OUT_SP = OUT_YS + (size_t)MS * DM, OUT_CP = OUT_SP + (size_t)NBP * NH * DK * DV,
                 OUT_SS = OUT_CP + (size_t)NBP * 2 * 512, OUT_CS = OUT_SS + (size_t)NBS * NH * DK * DV, OUT_END = OUT_CS + (size_t)NBS * 2 * 512;
constexpr size_t MiB = 1u << 20;
constexpr size_t WS_SS = 0, SS_STRIDE = 512 * 1024;
constexpr size_t WS_WUP1 = 2 * MiB, WS_WDN1 = 13 * MiB, WS_WIN = 19 * MiB, WS_WOUT = 26 * MiB, WS_WUP2 = 28 * MiB, WS_WDN2 = 39 * MiB;
constexpr size_t WS_BAR = 46 * MiB, BAR_BYTES = 16384;
constexpr size_t WS_XB = 48 * MiB;
constexpr size_t WS_ACT = 184 * MiB;
constexpr size_t WS_QK = 184 * MiB, WS_U = 450 * MiB, WS_LA = 517 * MiB;
constexpr size_t WS_MIX = 584 * MiB, WS_DUMMY = 718 * MiB, WS_END = 719 * MiB;
static_assert(WS_ACT + (size_t)M * FF * 2 <= WS_MIX && WS_LA + (size_t)M * 256 * 4 <= WS_MIX && WS_U + (size_t)M * 512 * 2 <= WS_LA && WS_QK + (size_t)M * 2048 * 2 <= WS_U, "ws map");
static_assert(WS_XB + (size_t)M * DM * 2 <= WS_ACT && WS_MIX + (size_t)M * DM * 2 <= WS_END && WS_WDN2 + (size_t)DM * FF * 2 <= WS_XB, "ws map");

__device__ __forceinline__ const float* xin_row(const float* xp, const float* meta, const float* xs, int R) {
    if (R < MP) { const int b = R / LP, t = R - b * LP; return t < NMETA ? meta + (size_t)t * DM : xp + ((size_t)b * SEQ + (t - NMETA)) * DM; }
    return xs + (size_t)(R - MP) * DM;
}
__device__ __forceinline__ float* yout_row(float* out, int R) {
    if (R < MP) { const int b = R / LP, t = R - b * LP; return t < NMETA ? nullptr : out + ((size_t)b * SEQ + (t - NMETA)) * DM; }
    return out + OUT_YS + (size_t)(R - MP) * DM;
}
__device__ __forceinline__ float bf_lo(unsigned w) { return __uint_as_float(w << 16); }
__device__ __forceinline__ float bf_hi(unsigned w) { return __uint_as_float(w & 0xffff0000u); }
__device__ __forceinline__ float silu_f(float g) { return g * __builtin_amdgcn_rcpf(1.f + __expf(-g)); }
__device__ __forceinline__ float wave_sum(float v) {
#pragma unroll
    for (int o = 1; o < 64; o <<= 1) v += __shfl_xor(v, o);
    return v;
}

struct EpiUp {
    static constexpr bool PERM = true, AFTER_DRAIN = false;
    bf16_t* O; const float* ss;
    __device__ __forceinline__ void operator()(const f32x4 (&acc)[2][2][4][2], const Unit& u, int wr, int wc, int fr, int fq) const {
        const int row0 = u.pm * 256 + wr * 64 + fr, col0 = u.pn * 128 + wc * 32 + 8 * fq;
#pragma unroll
        for (int ai = 0; ai < 2; ++ai)
#pragma unroll
            for (int m = 0; m < 4; ++m) {
                const int row = row0 + ai * 128 + m * 16;
                const float rs = rsqrtf(ss[row] * (1.0f / DM) + EPS), nl = rs * -1.4426950408889634f, rs2 = rs * rs;
                float o[8];
#pragma unroll
                for (int n = 0; n < 2; ++n) { const f32x4 gv = acc[ai][0][m][n], uv = acc[ai][1][m][n]; const f32x4 t = gv * nl, gu = gv * uv; f32x4 r;
#pragma unroll
                    for (int j = 0; j < 4; ++j) r[j] = __builtin_amdgcn_rcpf(1.0f + __builtin_amdgcn_exp2f(t[j]));
                    const f32x4 ov = gu * (r * rs2);
#pragma unroll
                    for (int j = 0; j < 4; ++j) o[4 * n + j] = ov[j]; }
                u32x4 w; w.x = cvt_pk_bf16(o[0], o[1]); w.y = cvt_pk_bf16(o[2], o[3]); w.z = cvt_pk_bf16(o[4], o[5]); w.w = cvt_pk_bf16(o[6], o[7]);
                *(u32x4*)(O + (size_t)row * FF + col0) = w;
            }
    }
};
template <int MODE> struct EpiRes {
    static constexpr bool PERM = true, AFTER_DRAIN = false;
    const float *xp, *meta, *xs; bf16_t* XB; float* out; float* ss;
    __device__ __forceinline__ void operator()(const f32x4 (&acc)[2][2][4][2], const Unit& u, int wr, int wc, int fr, int fq) const {
        const float alpha = (MODE == 1) ? 1.0f : 0.5f;
#pragma unroll
        for (int ai = 0; ai < 2; ++ai)
#pragma unroll
            for (int m = 0; m < 4; ++m) {
                const int row = u.pm * 256 + ai * 128 + wr * 64 + m * 16 + fr;
                const float* xr = nullptr;
                if (MODE == 0) xr = xin_row(xp, meta, xs, row);
                float sq = 0.f;
#pragma unroll
                for (int bj = 0; bj < 2; ++bj) {
                    const int col = u.pn * 256 + bj * 128 + wc * 32 + 8 * fq;
                    f32x4 b0, b1;
                    if (MODE == 0) { b0 = *(const f32x4*)(xr + col); b1 = *(const f32x4*)(xr + col + 4); }
                    else { const u32x4 w = *(const u32x4*)(XB + (size_t)row * DM + col);
                        b0 = (f32x4){bf_lo(w.x), bf_hi(w.x), bf_lo(w.y), bf_hi(w.y)}; b1 = (f32x4){bf_lo(w.z), bf_hi(w.z), bf_lo(w.w), bf_hi(w.w)}; }
                    const f32x4 v0 = b0 + acc[ai][bj][m][0] * alpha, v1 = b1 + acc[ai][bj][m][1] * alpha;
                    sq += (v0[0] * v0[0] + v0[1] * v0[1]) + (v0[2] * v0[2] + v0[3] * v0[3]) + (v1[0] * v1[0] + v1[1] * v1[1]) + (v1[2] * v1[2] + v1[3] * v1[3]);
                    { u32x4 w; w.x = cvt_pk_bf16(v0[0], v0[1]); w.y = cvt_pk_bf16(v0[2], v0[3]); w.z = cvt_pk_bf16(v1[0], v1[1]); w.w = cvt_pk_bf16(v1[2], v1[3]);
                        *(u32x4*)(XB + (size_t)row * DM + col) = w; }
                }
                sq += __shfl_xor(sq, 16); sq += __shfl_xor(sq, 32);
                if (fq == 0) unsafeAtomicAdd(ss + row, sq);
            }
    }
};
__device__ __forceinline__ float log_sigmoid_f(float z) { const float e = __expf(-fabsf(z)); return fminf(z, 0.f) - __logf(1.f + e); }
struct EpiWin {
    static constexpr bool PERM = true, AFTER_DRAIN = false;
    bf16_t* QK; bf16_t* U; float* LA; const float* ss; const float* b_a;
    __device__ __forceinline__ void operator()(const f32x4 (&acc)[2][2][4][2], const Unit& u, int wr, int wc, int fr, int fq) const {
        const int pn = u.pn;
#pragma unroll
        for (int ai = 0; ai < 2; ++ai)
#pragma unroll
            for (int m = 0; m < 4; ++m) {
                const int row = u.pm * 256 + ai * 128 + wr * 64 + m * 16 + fr;
                const float rs = rsqrtf(ss[row] * (1.0f / DM) + EPS);
                if (pn < 8) {
                    const float sc = (pn == 0) ? rs * 0.125f : rs;
#pragma unroll
                    for (int bj = 0; bj < 2; ++bj) { const f32x4 v0 = acc[ai][bj][m][0] * sc, v1 = acc[ai][bj][m][1] * sc;
                        u32x4 w; w.x = cvt_pk_bf16(v0[0], v0[1]); w.y = cvt_pk_bf16(v0[2], v0[3]); w.z = cvt_pk_bf16(v1[0], v1[1]); w.w = cvt_pk_bf16(v1[2], v1[3]);
                        *(u32x4*)(QK + (size_t)row * 2048 + pn * 256 + bj * 128 + wc * 32 + 8 * fq) = w; }
                } else if (pn < 12) {
                    const float r2 = rs * rs;
                    const f32x4 v0 = acc[ai][0][m][0] * acc[ai][1][m][0] * r2, v1 = acc[ai][0][m][1] * acc[ai][1][m][1] * r2;
                    u32x4 w; w.x = cvt_pk_bf16(v0[0], v0[1]); w.y = cvt_pk_bf16(v0[2], v0[3]); w.z = cvt_pk_bf16(v1[0], v1[1]); w.w = cvt_pk_bf16(v1[2], v1[3]);
                    *(u32x4*)(U + (size_t)row * 512 + (pn - 8) * 128 + wc * 32 + 8 * fq) = w;
                } else {
#pragma unroll
                    for (int bj = 0; bj < 2; ++bj)
#pragma unroll
                        for (int n = 0; n < 2; ++n) { const int c = bj * 128 + wc * 32 + 8 * fq + 4 * n; const f32x4 bb = *(const f32x4*)(b_a + c); f32x4 o;
#pragma unroll
                            for (int j = 0; j < 4; ++j) o[j] = log_sigmoid_f(acc[ai][bj][m][n][j] * rs + bb[j]) * (1.0f / 16.0f);
                            *(f32x4*)(LA + (size_t)row * 256 + c) = o; }
                }
            }
    }
};
__device__ __forceinline__ void tr_item(const float* W, int ldw, int src_col0, const float* gain, bf16_t* WT, int K, int dst_row0, int k0, LAS float* scr, int lane) {
#pragma unroll 8
    for (int i = 0; i < 32; ++i) { const int kk = 2 * i + (lane >> 5); float w = W[(size_t)(k0 + kk) * ldw + src_col0 + (lane & 31)]; if (gain) w *= gain[k0 + kk]; scr[kk * 33 + (lane & 31)] = w; }
    asm volatile("s_waitcnt lgkmcnt(0)" ::: "memory");
    const int c = lane & 7;
#pragma unroll
    for (int j = 0; j < 4; ++j) { const int n = (lane >> 3) + 8 * j; const LAS float* s = scr + (8 * c) * 33 + n;
        u32x4 o; o.x = cvt_pk_bf16(s[0 * 33], s[1 * 33]); o.y = cvt_pk_bf16(s[2 * 33], s[3 * 33]); o.z = cvt_pk_bf16(s[4 * 33], s[5 * 33]); o.w = cvt_pk_bf16(s[6 * 33], s[7 * 33]);
        *(u32x4*)(WT + (size_t)(dst_row0 + n) * K + k0 + 8 * c) = o; }
    asm volatile("s_waitcnt lgkmcnt(0)" ::: "memory");
}
__device__ __forceinline__ int up_src_col(int n) { const int pn = n >> 8, within = n & 255; return (within >> 7) * FF + 128 * pn + (within & 127); }
__device__ __forceinline__ int win_src_col(int n) {
    if (n < 1536) return n;
    if (n < 2048) return n + 16;
    const int j = (n - 2048) >> 8, within = (n - 2048) & 255;
    return ((within >> 7) ? 2576 : 2064) + 128 * j + (within & 127);
}
struct P0Args { const float *xp, *xs, *meta, *n1, *wu1, *wd1, *n2, *win, *wa2, *wout, *n3, *wu2, *wd2; unsigned char* ws; };
__device__ __forceinline__ void p0_prologue(const P0Args& a, LAS unsigned char* lds, int gw, int NGW, int wave, int lane) {
    LAS float* scr = (LAS float*)(lds + wave * 8704);
    constexpr int I_UP = (DM / 64) * (NUP / 32), I_DN = (FF / 64) * (DM / 32), I_IN = (DM / 64) * (3072 / 32), I_OUT = (DM / 64) * (DM / 32);
    constexpr int NITEMS = 2 * I_UP + 2 * I_DN + I_IN + I_OUT;
    bf16_t* WUP1 = (bf16_t*)(a.ws + WS_WUP1); bf16_t* WDN1 = (bf16_t*)(a.ws + WS_WDN1); bf16_t* WIN = (bf16_t*)(a.ws + WS_WIN);
    bf16_t* WOUT = (bf16_t*)(a.ws + WS_WOUT); bf16_t* WUP2 = (bf16_t*)(a.ws + WS_WUP2); bf16_t* WDN2 = (bf16_t*)(a.ws + WS_WDN2);
    for (int it = gw; it < NITEMS; it += NGW) {
        int r = it;
        if (r < 2 * I_UP) { const bool second = r >= I_UP; if (second) r -= I_UP; const int nblk = NUP / 32, kb = r / nblk, nb = r % nblk;
            tr_item(second ? a.wu2 : a.wu1, NUP, up_src_col(32 * nb), second ? a.n3 : a.n1, second ? WUP2 : WUP1, DM, 32 * nb, 64 * kb, scr, lane); continue; }
        r -= 2 * I_UP;
        if (r < 2 * I_DN) { const bool second = r >= I_DN; if (second) r -= I_DN; const int nblk = DM / 32, kb = r / nblk, nb = r % nblk;
            tr_item(second ? a.wd2 : a.wd1, DM, 32 * nb, nullptr, second ? WDN2 : WDN1, FF, 32 * nb, 64 * kb, scr, lane); continue; }
        r -= 2 * I_DN;
        if (r < I_IN) { const int nblk = 3072 / 32, kb = r / nblk, nb = r % nblk;
            tr_item(a.win, DIN, win_src_col(32 * nb), a.n2, WIN, DM, 32 * nb, 64 * kb, scr, lane); continue; }
        r -= I_IN;
        { const int nblk = DM / 32, kb = r / nblk, nb = r % nblk; tr_item(a.wout, DM, 32 * nb, nullptr, WOUT, DM, 32 * nb, 64 * kb, scr, lane); }
    }
    for (int e = gw * 64 + lane; e < 256 * DM; e += NGW * 64) { const int n = e >> 10, k = e & 1023; const float* wr_ = a.win + (size_t)k * DIN + 1536; float s = 0.f;
#pragma unroll
        for (int r = 0; r < 16; ++r) s += wr_[r] * a.wa2[r * 256 + n];
        s *= a.n2[k]; const unsigned short b = (unsigned short)(cvt_pk_bf16(s, 0.f) & 0xffffu); WIN[(size_t)(3072 + n) * DM + k] = b; }
    bf16_t* XB = (bf16_t*)(a.ws + WS_XB); float* ss0 = (float*)(a.ws + WS_SS);
    for (int R = gw; R < M; R += NGW) {
        const f32x4* xr = (const f32x4*)xin_row(a.xp, a.meta, a.xs, R) + lane; f32x4 v[4]; float s = 0.f;
#pragma unroll
        for (int j = 0; j < 4; ++j) { v[j] = xr[64 * j]; s += (v[j][0] * v[j][0] + v[j][1] * v[j][1]) + (v[j][2] * v[j][2] + v[j][3] * v[j][3]); }
        s = wave_sum(s);
        u32x2* o8 = (u32x2*)(XB + (size_t)R * DM) + lane;
#pragma unroll
        for (int j = 0; j < 4; ++j) { u32x2 w; w.x = cvt_pk_bf16(v[j][0], v[j][1]); w.y = cvt_pk_bf16(v[j][2], v[j][3]); o8[64 * j] = w; }
        if (lane == 0) { ss0[R] = s; ss0[R + SS_STRIDE / 4] = 0.f; ss0[R + 2 * (SS_STRIDE / 4)] = 0.f; ss0[R + 3 * (SS_STRIDE / 4)] = 0.f; }
    }
}

struct GlaArgs { const bf16_t* QK; const float* LA; const bf16_t* U; bf16_t* MIX; const float* state_in; const float* cache_conv; const float* g_head; const float* w_conv; float* out; bf16_t* dummy; };
constexpr int RS = 144;
constexpr int VRS = 272;
constexpr int L_G = 0, L_VR = 16384, L_QT = 0, L_ATT = 9216, L_KT = 18432, L_KTT = 27648, L_G2 = 36864, L_EGL = 53248, L_SSQ = 53504, L_VT = 54016, L_ST = 72448, ST_BYTES = 128 * RS, L_SEG = 109312, L_QR = 111360, L_KR = 119552;
__device__ __forceinline__ bf16x8 ldf(LAS const unsigned char* base, int row, int ks, int fq) { return *(const LAS bf16x8*)(base + row * RS + ks * 64 + fq * 16); }
__device__ __forceinline__ void gla_unit(const GlaArgs& a, LAS unsigned char* lds, int unit, int tid, int wave, int lane) {
    const bool samp = unit >= 128; const int s = (unit & 127) >> 2, h = unit & 3;
    const int L = samp ? DSEQ : LP; const int row0 = samp ? MP + s * DSEQ : s * LP;
    const int fr = lane & 15, fq = lane >> 4, rb = wave & 3, vh = wave >> 2;
    LAS float* G = (LAS float*)(lds + L_G); LAS float* G2 = (LAS float*)(lds + L_G2); LAS float* EGL = (LAS float*)(lds + L_EGL); LAS float* SSQ = (LAS float*)(lds + L_SSQ);
    f32x4 Sacc[4], gh[4];
    const size_t sbase = (size_t)(s * NH + h) * DK * DV;
#pragma unroll
    for (int vt = 0; vt < 4; ++vt) { const int v = 64 * vh + 16 * vt + fr;
#pragma unroll
        for (int jj = 0; jj < 4; ++jj) Sacc[vt][jj] = samp ? a.state_in[sbase + (size_t)(16 * rb + 4 * fq + jj) * DV + v] : 0.f;
        u32x2 w; w.x = cvt_pk_bf16(Sacc[vt][0], Sacc[vt][1]); w.y = cvt_pk_bf16(Sacc[vt][2], Sacc[vt][3]);
        *(LAS u32x2*)(lds + L_ST + v * RS + (16 * rb + 4 * fq) * 2) = w;
        gh[vt] = *(const f32x4*)(a.g_head + 64 * vh + 16 * vt + 4 * fq); }
    const int lt = tid >> 3, ld0 = (tid & 7) * 8;
    const int vt_t = tid >> 4, vc = tid & 15;
    u32x4 pq, pk, pv0, pv1; f32x4 pl0, pl1; u32x2 rg0, rg1, rg2, rg3;
    const u32x4 z4 = (u32x4){0u, 0u, 0u, 0u}; const f32x4 zf = (f32x4){0.f, 0.f, 0.f, 0.f};
#define GL16(dst, ptr) dst = *(const u32x4*)(ptr)
#define GL16F(dst, ptr) dst = *(const f32x4*)(ptr)
#define GL8(dst, ptr) dst = *(const u32x2*)(ptr)
#define GLA_ISSUE_P(T0) do { \
        const int tq_ = min((T0) + lt, L - 1), ta_ = min((T0) + vt_t, L - 1), tb_ = min((T0) + vt_t + 32, L - 1); \
        const bf16_t* p_ = a.QK + (size_t)(row0 + tq_) * 2048 + h * 64 + ld0; GL16(pq, p_); GL16(pk, p_ + 256); \
        GL16(pv0, a.QK + (size_t)(row0 + ta_) * 2048 + 512 + h * 128 + vc * 8); GL16F(pl0, a.LA + (size_t)(row0 + ta_) * 256 + h * 64 + vc * 4); \
        GL16(pv1, a.QK + (size_t)(row0 + tb_) * 2048 + 512 + h * 128 + vc * 8); GL16F(pl1, a.LA + (size_t)(row0 + tb_) * 256 + h * 64 + vc * 4); } while (0)
#define GLA_ISSUE_R(T0) do { const bf16_t* r_ = a.QK + (size_t)(row0 + min((T0) + 16 * rb + fr, L - 1)) * 2048 + 1024 + h * 128 + 64 * vh + 4 * fq; \
        GL8(rg0, r_); GL8(rg1, r_ + 16); GL8(rg2, r_ + 32); GL8(rg3, r_ + 48); } while (0)
#define GLA_STAGE(T0) do { \
        if ((T0) + lt >= L) { pq = z4; pk = z4; } \
        if ((T0) + vt_t >= L) { pv0 = z4; pl0 = zf; } \
        if ((T0) + vt_t + 32 >= L) { pv1 = z4; pl1 = zf; } \
        *(LAS f32x4*)(G + vt_t * 64 + vc * 4) = pl0; *(LAS f32x4*)(G + (vt_t + 32) * 64 + vc * 4) = pl1; \
        *(LAS u32x4*)(lds + L_VR + vt_t * VRS + vc * 16) = pv0; *(LAS u32x4*)(lds + L_VR + (vt_t + 32) * VRS + vc * 16) = pv1; \
        *(LAS u32x4*)(lds + L_QR + tid * 16) = pq; *(LAS u32x4*)(lds + L_KR + tid * 16) = pk; } while (0)
    GLA_ISSUE_P(0); GLA_STAGE(0);
    const int nch = (L + 63) >> 6;
    for (int c = 0; c < nch; ++c) {
        const int t0 = c * 64, cur = c & 1;
        __syncthreads();
        GLA_ISSUE_R(t0); GLA_ISSUE_P(t0 + 64);
        { const int d = tid & 63; float c8[8];
#pragma unroll
            for (int e = 0; e < 8; ++e) c8[e] = G[(8 * wave + e) * 64 + d];
#pragma unroll
            for (int e = 1; e < 8; ++e) c8[e] += c8[e - 1];
#pragma unroll
            for (int e = 0; e < 8; ++e) G2[(8 * wave + e) * 64 + d] = c8[e];
            ((LAS float*)(lds + L_SEG))[wave * 64 + d] = c8[7]; }
        { const int v = tid & 127, tg = tid >> 7; unsigned w[8];
#pragma unroll
            for (int e = 0; e < 8; ++e) { const unsigned lo = *(const LAS unsigned short*)(lds + L_VR + (16 * tg + 2 * e) * VRS + v * 2), hi = *(const LAS unsigned short*)(lds + L_VR + (16 * tg + 2 * e + 1) * VRS + v * 2); w[e] = lo | (hi << 16); }
            *(LAS u32x4*)(lds + L_VT + v * RS + tg * 32) = (u32x4){w[0], w[1], w[2], w[3]}; *(LAS u32x4*)(lds + L_VT + v * RS + tg * 32 + 16) = (u32x4){w[4], w[5], w[6], w[7]}; }
        __syncthreads();
        { f32x4 g0 = *(const LAS f32x4*)(G2 + lt * 64 + ld0), g1 = *(const LAS f32x4*)(G2 + lt * 64 + ld0 + 4);
            { const LAS float* SEG = (const LAS float*)(lds + L_SEG) + ld0; const int seg = lt >> 3; f32x4 t0 = zf, t1 = zf;
#pragma unroll
                for (int s8 = 0; s8 < 8; ++s8) { const f32x4 a0 = *(const LAS f32x4*)(SEG + s8 * 64), a1 = *(const LAS f32x4*)(SEG + s8 * 64 + 4);
                    if (s8 < seg) { g0 += a0; g1 += a1; } t0 += a0; t1 += a1; }
                if (lt == 63) { f32x4 e0, e1;
#pragma unroll
                    for (int j = 0; j < 4; ++j) { e0[j] = __expf(t0[j]); e1[j] = __expf(t1[j]); }
                    *(LAS f32x4*)(EGL + ld0) = e0; *(LAS f32x4*)(EGL + ld0 + 4) = e1; } }
            const float gq[8] = {g0[0], g0[1], g0[2], g0[3], g1[0], g1[1], g1[2], g1[3]};
            const u32x4 rq = *(const LAS u32x4*)(lds + L_QR + tid * 16), rk = *(const LAS u32x4*)(lds + L_KR + tid * 16);
            const float qv[8] = {bf_lo(rq.x), bf_hi(rq.x), bf_lo(rq.y), bf_hi(rq.y), bf_lo(rq.z), bf_hi(rq.z), bf_lo(rq.w), bf_hi(rq.w)};
            const float kv[8] = {bf_lo(rk.x), bf_hi(rk.x), bf_lo(rk.y), bf_hi(rk.y), bf_lo(rk.z), bf_hi(rk.z), bf_lo(rk.w), bf_hi(rk.w)};
            float qt[8], kt[8];
#pragma unroll
            for (int e = 0; e < 8; ++e) { qt[e] = qv[e] * __expf(gq[e]); kt[e] = kv[e] * __expf(-gq[e]); }
            *(LAS u32x4*)(lds + L_QT + lt * RS + ld0 * 2) = (u32x4){cvt_pk_bf16(qt[0], qt[1]), cvt_pk_bf16(qt[2], qt[3]), cvt_pk_bf16(qt[4], qt[5]), cvt_pk_bf16(qt[6], qt[7])};
            *(LAS u32x4*)(lds + L_KT + lt * RS + ld0 * 2) = (u32x4){cvt_pk_bf16(kt[0], kt[1]), cvt_pk_bf16(kt[2], kt[3]), cvt_pk_bf16(kt[4], kt[5]), cvt_pk_bf16(kt[6], kt[7])}; }
        const int orow = t0 + 16 * rb + fr; const bool ovalid = orow < L;
        __syncthreads();
        { const int d = tid & 63; unsigned w[4];
#pragma unroll
            for (int e = 0; e < 4; ++e) { const unsigned lo = *(const LAS unsigned short*)(lds + L_KT + (8 * wave + 2 * e) * RS + d * 2), hi = *(const LAS unsigned short*)(lds + L_KT + (8 * wave + 2 * e + 1) * RS + d * 2); w[e] = lo | (hi << 16); }
            *(LAS u32x4*)(lds + L_KTT + d * RS + wave * 16) = (u32x4){w[0], w[1], w[2], w[3]}; }
#pragma unroll
        for (int tt = 0; tt < 2; ++tt) { const int tile = 2 * wave + tt, ib = tile >> 2, jb = tile & 3; f32x4 acc = zf;
            if (jb <= ib) {
#pragma unroll
                for (int ks = 0; ks < 2; ++ks) acc = __builtin_amdgcn_mfma_f32_16x16x32_bf16(ldf(lds + L_KT, 16 * jb + fr, ks, fq), ldf(lds + L_QT, 16 * ib + fr, ks, fq), acc, 0, 0, 0);
                if (jb == ib) {
#pragma unroll
                    for (int jj = 0; jj < 4; ++jj) if (4 * fq + jj > fr) acc[jj] = 0.f; } }
            u32x2 w; w.x = cvt_pk_bf16(acc[0], acc[1]); w.y = cvt_pk_bf16(acc[2], acc[3]);
            *(LAS u32x2*)(lds + L_ATT + (16 * ib + fr) * RS + (16 * jb + 4 * fq) * 2) = w; }
        __syncthreads();
        f32x4 o[4]; float sq = 0.f;
        { const bf16x8 ya0 = ldf(lds + L_ATT, 16 * rb + fr, 0, fq), ya1 = ldf(lds + L_ATT, 16 * rb + fr, 1, fq), ya2 = ldf(lds + L_QT, 16 * rb + fr, 0, fq), ya3 = ldf(lds + L_QT, 16 * rb + fr, 1, fq);
            const bf16x8 kx0 = ldf(lds + L_KTT, 16 * rb + fr, 0, fq), kx1 = ldf(lds + L_KTT, 16 * rb + fr, 1, fq);
            const f32x4 eg = *(const LAS f32x4*)(EGL + 16 * rb + 4 * fq);
            LAS const unsigned char* STc = lds + L_ST + cur * ST_BYTES; LAS unsigned char* STn = lds + L_ST + (cur ^ 1) * ST_BYTES;
#pragma unroll
            for (int vt = 0; vt < 4; ++vt) { const int v0 = 64 * vh + 16 * vt;
                const bf16x8 vx0 = ldf(lds + L_VT, v0 + fr, 0, fq), vx1 = ldf(lds + L_VT, v0 + fr, 1, fq), sx0 = ldf(STc, v0 + fr, 0, fq), sx1 = ldf(STc, v0 + fr, 1, fq);
                f32x4 acc = zf;
                acc = __builtin_amdgcn_mfma_f32_16x16x32_bf16(vx0, ya0, acc, 0, 0, 0); acc = __builtin_amdgcn_mfma_f32_16x16x32_bf16(vx1, ya1, acc, 0, 0, 0);
                acc = __builtin_amdgcn_mfma_f32_16x16x32_bf16(sx0, ya2, acc, 0, 0, 0); acc = __builtin_amdgcn_mfma_f32_16x16x32_bf16(sx1, ya3, acc, 0, 0, 0);
                o[vt] = acc; sq += (acc[0] * acc[0] + acc[1] * acc[1]) + (acc[2] * acc[2] + acc[3] * acc[3]);
                f32x4 sa = Sacc[vt];
                sa = __builtin_amdgcn_mfma_f32_16x16x32_bf16(kx0, vx0, sa, 0, 0, 0); sa = __builtin_amdgcn_mfma_f32_16x16x32_bf16(kx1, vx1, sa, 0, 0, 0);
                sa = sa * eg; Sacc[vt] = sa;
                u32x2 w; w.x = cvt_pk_bf16(sa[0], sa[1]); w.y = cvt_pk_bf16(sa[2], sa[3]);
                *(LAS u32x2*)(STn + (v0 + fr) * RS + (16 * rb + 4 * fq) * 2) = w; } }
        sq += __shfl_xor(sq, 16); sq += __shfl_xor(sq, 32);
        if (fq == 0) SSQ[vh * 64 + 16 * rb + fr] = sq;
        __syncthreads();
        { const float rs = rsqrtf((SSQ[16 * rb + fr] + SSQ[64 + 16 * rb + fr]) * (1.0f / DV) + EPS);
            GLA_STAGE(t0 + 64);
            const u32x2 rg[4] = {rg0, rg1, rg2, rg3};
            bf16_t* mrow = ovalid ? a.MIX + (size_t)(row0 + orow) * DM + h * 128 + 64 * vh + 4 * fq : a.dummy + tid * 64;
            {
#pragma unroll
                for (int vt = 0; vt < 4; ++vt) { const float r0 = bf_lo(rg[vt].x), r1 = bf_hi(rg[vt].x), r2 = bf_lo(rg[vt].y), r3 = bf_hi(rg[vt].y);
                    u32x2 w; w.x = cvt_pk_bf16(o[vt][0] * rs * gh[vt][0] * silu_f(r0), o[vt][1] * rs * gh[vt][1] * silu_f(r1)); w.y = cvt_pk_bf16(o[vt][2] * rs * gh[vt][2] * silu_f(r2), o[vt][3] * rs * gh[vt][3] * silu_f(r3));
                    *(u32x2*)(mrow + 16 * vt) = w; } } }
    }
#undef GLA_ISSUE_P
#undef GLA_ISSUE_R
#undef GLA_STAGE
#undef GL16
#undef GL16F
#undef GL8
    float* sout = a.out + (samp ? OUT_SS : OUT_SP) + sbase;
#pragma unroll
    for (int vt = 0; vt < 4; ++vt)
#pragma unroll
        for (int jj = 0; jj < 4; ++jj) sout[(size_t)(16 * rb + 4 * fq + jj) * DV + 64 * vh + 16 * vt + fr] = Sacc[vt][jj];
    __syncthreads();
}
__device__ __forceinline__ void conv_pass(const GlaArgs& a, int gtid, int nthreads) {
    for (int item = gtid; item < M * 64; item += nthreads) {
        const int R = item >> 6, c8 = (item & 63) * 8;
        int b, t, L; bool samp = R >= MP;
        if (!samp) { b = R / LP; t = R - b * LP; L = LP; } else { const int r2 = R - MP; b = r2 >> 6; t = r2 & 63; L = DSEQ; }
        float u2[8], u1[8], u0[8], bb[8];
        { const u32x4 w = *(const u32x4*)(a.U + (size_t)R * 512 + c8); u2[0] = bf_lo(w.x); u2[1] = bf_hi(w.x); u2[2] = bf_lo(w.y); u2[3] = bf_hi(w.y); u2[4] = bf_lo(w.z); u2[5] = bf_hi(w.z); u2[6] = bf_lo(w.w); u2[7] = bf_hi(w.w); }
        if (t >= 1) { const u32x4 w = *(const u32x4*)(a.U + (size_t)(R - 1) * 512 + c8); u1[0] = bf_lo(w.x); u1[1] = bf_hi(w.x); u1[2] = bf_lo(w.y); u1[3] = bf_hi(w.y); u1[4] = bf_lo(w.z); u1[5] = bf_hi(w.z); u1[6] = bf_lo(w.w); u1[7] = bf_hi(w.w); }
        else {
#pragma unroll
            for (int j = 0; j < 8; ++j) u1[j] = samp ? a.cache_conv[((size_t)b * 2 + 1) * 512 + c8 + j] : 0.f; }
        if (t >= 2) { const u32x4 w = *(const u32x4*)(a.U + (size_t)(R - 2) * 512 + c8); u0[0] = bf_lo(w.x); u0[1] = bf_hi(w.x); u0[2] = bf_lo(w.y); u0[3] = bf_hi(w.y); u0[4] = bf_lo(w.z); u0[5] = bf_hi(w.z); u0[6] = bf_lo(w.w); u0[7] = bf_hi(w.w); }
        else {
#pragma unroll
            for (int j = 0; j < 8; ++j) u0[j] = samp ? a.cache_conv[((size_t)b * 2 + t) * 512 + c8 + j] : 0.f; }
        { const u32x4 w = *(const u32x4*)(a.QK + (size_t)R * 2048 + 1536 + c8); bb[0] = bf_lo(w.x); bb[1] = bf_hi(w.x); bb[2] = bf_lo(w.y); bb[3] = bf_hi(w.y); bb[4] = bf_lo(w.z); bb[5] = bf_hi(w.z); bb[6] = bf_lo(w.w); bb[7] = bf_hi(w.w); }
        float o[8];
#pragma unroll
        for (int j = 0; j < 8; ++j) o[j] = bb[j] * (a.w_conv[c8 + j] * u0[j] + a.w_conv[512 + c8 + j] * u1[j] + a.w_conv[1024 + c8 + j] * u2[j]);
        u32x4 w; w.x = cvt_pk_bf16(o[0], o[1]); w.y = cvt_pk_bf16(o[2], o[3]); w.z = cvt_pk_bf16(o[4], o[5]); w.w = cvt_pk_bf16(o[6], o[7]);
        *(u32x4*)(a.MIX + (size_t)R * DM + 512 + c8) = w;
        if (t >= L - 2) { float* oc = a.out + (samp ? OUT_CS : OUT_CP) + ((size_t)b * 2 + (t - (L - 2))) * 512 + c8;
            *(f32x4*)oc = (f32x4){u2[0], u2[1], u2[2], u2[3]}; *(f32x4*)(oc + 4) = (f32x4){u2[4], u2[5], u2[6], u2[7]}; }
    }
}
__device__ __forceinline__ void final_norm(float* out, const bf16_t* XB, const float* ss3, const float* gfin, int gw, int NGW, int lane) {
    constexpr int NR = NBP * SEQ + MS;
    f32x4 g0 = ((const f32x4*)gfin)[2 * lane], g1 = ((const f32x4*)gfin)[2 * lane + 1], g2 = ((const f32x4*)gfin)[128 + 2 * lane], g3 = ((const f32x4*)gfin)[128 + 2 * lane + 1];
    for (int Rp = gw; Rp < NR; Rp += NGW) {
        int R; if (Rp < NBP * SEQ) { const int b = Rp >> 11, t = Rp & 2047; R = b * LP + NMETA + t; } else R = MP + (Rp - NBP * SEQ);
        const float rs = rsqrtf(ss3[R] * (1.0f / DM) + EPS);
        const u32x4 w0 = *((const u32x4*)(XB + (size_t)R * DM) + lane), w1 = *((const u32x4*)(XB + (size_t)R * DM) + 64 + lane);
        f32x4* yr = (f32x4*)(out + (size_t)Rp * DM);
        yr[2 * lane] = (f32x4){bf_lo(w0.x), bf_hi(w0.x), bf_lo(w0.y), bf_hi(w0.y)} * rs * g0; yr[2 * lane + 1] = (f32x4){bf_lo(w0.z), bf_hi(w0.z), bf_lo(w0.w), bf_hi(w0.w)} * rs * g1;
        yr[128 + 2 * lane] = (f32x4){bf_lo(w1.x), bf_hi(w1.x), bf_lo(w1.y), bf_hi(w1.y)} * rs * g2; yr[128 + 2 * lane + 1] = (f32x4){bf_lo(w1.z), bf_hi(w1.z), bf_lo(w1.w), bf_hi(w1.w)} * rs * g3;
    }
}

#define XB_TMO      128
#define XB_XCNT(j)  (256  + 64 * (j))
#define XB_XSUB(j)  (1280 + 64 * (j))
#define XB_XGEN(j)  (2304 + 64 * (j))
#define XB_TOP      3328
#define XB_TOPGEN   3392
#define XCD_BAR_WORDS 3456
#define XB_SPIN_CAP (1u << 18)

__device__ __forceinline__ unsigned xb_ld(unsigned* p)              { return __hip_atomic_load(p, __ATOMIC_RELAXED, __HIP_MEMORY_SCOPE_AGENT); }
__device__ __forceinline__ unsigned xb_add(unsigned* p, unsigned v) { return __hip_atomic_fetch_add(p, v, __ATOMIC_RELAXED, __HIP_MEMORY_SCOPE_AGENT); }
__device__ __forceinline__ unsigned xb_xcc_id() { return (unsigned)__builtin_amdgcn_s_getreg((3 << 11) | 20) & 0xFu; }
#define XB_SPIN(cond, bar) do { unsigned _sp = 0; while (cond) { __builtin_amdgcn_s_sleep(1); \
    if ((++_sp & 255u) == 0u) { if (xb_ld(&(bar)[XB_TMO])) break; if (_sp > XB_SPIN_CAP) { atomicAdd(&(bar)[XB_TMO], 1u); break; } } } } while (0)

struct XcdBarrier {
    unsigned* bar; unsigned x;
    volatile LAS unsigned* st;
};

__device__ __forceinline__ XcdBarrier xcd_barrier_post(unsigned* bar, volatile LAS unsigned* st) {
    XcdBarrier b; b.bar = bar; b.x = xb_xcc_id(); b.st = st;
    if (threadIdx.x == 0) (void)xb_add(&bar[XB_XCNT(b.x)], 1u);
    return b;
}
__device__ __forceinline__ void xcd_barrier_complete(unsigned* bar, unsigned x, unsigned& nloc, unsigned& nx) {
    const unsigned G = gridDim.x * gridDim.y * gridDim.z;
    unsigned sum, cnt, mine, sp = 0u;
    for (;;) {
        sum = 0u; cnt = 0u; mine = 0u;
#pragma unroll
        for (unsigned j = 0; j < 16; ++j) { const unsigned c = xb_ld(&bar[XB_XCNT(j)]); sum += c; cnt += (c > 0u) ? 1u : 0u; mine = (j == x) ? c : mine; }
        if (sum == G) break;
        __builtin_amdgcn_s_sleep(1);
        if ((++sp & 255u) == 0u) { if (xb_ld(&bar[XB_TMO])) break; if (sp > XB_SPIN_CAP) { atomicAdd(&bar[XB_TMO], 1u); break; } }
    }
    nloc = mine > 0u ? mine : 1u; nx = cnt > 0u ? cnt : 1u;
}

__device__ __forceinline__ void xcd_barrier(const XcdBarrier& b) {
    asm volatile("s_waitcnt vmcnt(0)" ::: "memory");
    __syncthreads();
    if (threadIdx.x == 0) {
        unsigned* bar = b.bar;
        __builtin_amdgcn_s_waitcnt(0);
        unsigned nloc = b.st[0], nx = b.st[1];
        if (nloc == 0u) { xcd_barrier_complete(bar, b.x, nloc, nx); b.st[0] = nloc; b.st[1] = nx; }
        const unsigned old = xb_add(&bar[XB_XSUB(b.x)], 1u);
        const unsigned gen = old / nloc;
        if (old + 1u == (gen + 1u) * nloc) {
            __builtin_amdgcn_fence(__ATOMIC_RELEASE, "agent");
            asm volatile("s_waitcnt vmcnt(0)" ::: "memory");
            const unsigned og = xb_add(&bar[XB_TOP], 1u);
            const unsigned tg = og / nx;
            if (og + 1u == (tg + 1u) * nx) xb_add(&bar[XB_TOPGEN], 1u);
            else XB_SPIN(xb_ld(&bar[XB_TOPGEN]) == tg, bar);
            __builtin_amdgcn_fence(__ATOMIC_ACQUIRE, "agent");
            xb_add(&bar[XB_XGEN(b.x)], 1u);
            asm volatile("s_waitcnt vmcnt(0)" ::: "memory");
        } else {
            XB_SPIN(xb_ld(&bar[XB_XGEN(b.x)]) == gen, bar);
            __builtin_amdgcn_fence(__ATOMIC_ACQUIRE, "agent");
            asm volatile("s_waitcnt vmcnt(0)" ::: "memory");
        }
    }
    __syncthreads();
}

struct Args { const float* in[19]; float* out; unsigned char* ws; int ph_lo, ph_hi; };
constexpr int LDS_BYTES = 147456;
__global__ void __launch_bounds__(512, 2) fwd_kernel(Args args) {
    extern __shared__ __attribute__((aligned(16))) unsigned char lds_raw[];
    LAS unsigned char* lds = (LAS unsigned char*)lds_raw;
    cg::grid_group grid = cg::this_grid();
    const int tid = threadIdx.x, lane = tid & 63, wave = __builtin_amdgcn_readfirstlane(tid >> 6);
    const int G = gridDim.x, bx = blockIdx.x;
    const int gw = bx * 8 + wave, NGW = G * 8;
    unsigned char* ws = args.ws;
    const float *x_prompt = args.in[0], *x_sample = args.in[1], *state_gla = args.in[2], *cache_conv = args.in[3], *meta = args.in[4], *norm_ffn1 = args.in[5], *w_up1 = args.in[6], *w_down1 = args.in[7],
                *norm_mix = args.in[8], *w_in = args.in[9], *w_a2 = args.in[10], *b_a = args.in[11], *g_head = args.in[12], *w_conv = args.in[13], *w_out = args.in[14], *norm_ffn2 = args.in[15],
                *w_up2 = args.in[16], *w_down2 = args.in[17], *norm_final = args.in[18];
    bf16_t* XB = (bf16_t*)(ws + WS_XB); bf16_t* ACT = (bf16_t*)(ws + WS_ACT); bf16_t* QK = (bf16_t*)(ws + WS_QK); bf16_t* U = (bf16_t*)(ws + WS_U); float* LA = (float*)(ws + WS_LA); bf16_t* MIX = (bf16_t*)(ws + WS_MIX);
    float* ss0 = (float*)(ws + WS_SS); float* ss1 = ss0 + SS_STRIDE / 4; float* ss2 = ss1 + SS_STRIDE / 4; float* ss3 = ss2 + SS_STRIDE / 4;
    const int lo = args.ph_lo, hi = args.ph_hi;
    volatile LAS unsigned* bst = (volatile LAS unsigned*)(lds + 140000);
    if (tid < 2) bst[tid] = 0u;
    __syncthreads();
    XcdBarrier xbar = xcd_barrier_post((unsigned*)(ws + WS_BAR), bst);
#define IN(k) (lo <= (k) && (k) < hi)
#define SEAM(k) do { if (IN(k) && IN((k) + 1)) { asm volatile("s_waitcnt vmcnt(0) lgkmcnt(0)" ::: "memory"); if (lo == 12345) grid.sync(); xcd_barrier(xbar); __builtin_amdgcn_fence(__ATOMIC_ACQUIRE, "agent"); asm volatile("s_waitcnt vmcnt(0)" ::: "memory"); } } while (0)
    if (IN(0)) {
        P0Args pa{x_prompt, x_sample, meta, norm_ffn1, w_up1, w_down1, norm_mix, w_in, w_a2, w_out, norm_ffn2, w_up2, w_down2, ws};
        p0_prologue(pa, lds, gw, NGW, wave, lane);
    }
    SEAM(0);
    if (IN(1)) {
        pg8::Gemm g{XB, (const bf16_t*)(ws + WS_WUP1), M, NUP, DM}; pg8::StaticOrder S; S.init(M, NUP, G, bx);
        EpiUp E{ACT, ss0};
        pg8::gemm_phase<EpiUp, pg8::StaticOrder, true, true>(lds, g, S, E);
    }
    SEAM(1);
    if (IN(2)) {
        pg8::Gemm g{ACT, (const bf16_t*)(ws + WS_WDN1), M, DM, FF}; pg8::StaticOrder S; S.init(M, DM, G, bx);
        EpiRes<0> E{x_prompt, meta, x_sample, XB, args.out, ss1};
        pg8::gemm_phase<EpiRes<0>, pg8::StaticOrder, true, true>(lds, g, S, E);
    }
    SEAM(2);
    if (IN(3)) {
        pg8::Gemm g{XB, (const bf16_t*)(ws + WS_WIN), M, NIN, DM}; pg8::StaticOrder S; S.init(M, NIN, G, bx);
        EpiWin E{QK, U, LA, ss1, b_a};
        pg8::gemm_phase<EpiWin, pg8::StaticOrder, true, true>(lds, g, S, E);
    }
    SEAM(3);
    if (IN(4)) {
        GlaArgs ga{QK, LA, U, MIX, state_gla, cache_conv, g_head, w_conv, args.out, (bf16_t*)(ws + WS_DUMMY)};
        for (int unit = bx; unit < 256; unit += G) gla_unit(ga, lds, unit, tid, wave, lane);
        if (G == 256) { if (bx >= 128) conv_pass(ga, (bx - 128) * 512 + tid, 128 * 512); }
        else conv_pass(ga, bx * 512 + tid, G * 512);
    }
    SEAM(4);
    if (IN(5)) {
        pg8::Gemm g{MIX, (const bf16_t*)(ws + WS_WOUT), M, DM, DM}; pg8::StaticOrder S; S.init(M, DM, G, bx);
        EpiRes<1> E{x_prompt, meta, x_sample, XB, args.out, ss2};
        pg8::gemm_phase<EpiRes<1>, pg8::StaticOrder, true, true>(lds, g, S, E);
    }
    SEAM(5);
    if (IN(6)) {
        pg8::Gemm g{XB, (const bf16_t*)(ws + WS_WUP2), M, NUP, DM}; pg8::StaticOrder S; S.init(M, NUP, G, bx);
        EpiUp E{ACT, ss2};
        pg8::gemm_phase<EpiUp, pg8::StaticOrder, true, true>(lds, g, S, E);
    }
    SEAM(6);
    if (IN(7)) {
        pg8::Gemm g{ACT, (const bf16_t*)(ws + WS_WDN2), M, DM, FF}; pg8::StaticOrder S; S.init(M, DM, G, bx);
        EpiRes<2> E{x_prompt, meta, x_sample, XB, args.out, ss3};
        pg8::gemm_phase<EpiRes<2>, pg8::StaticOrder, true, true>(lds, g, S, E);
    }
    SEAM(7);
    if (IN(8)) final_norm(args.out, XB, ss3, norm_final, gw, NGW, lane);
#undef IN
#undef SEAM
}

#ifndef N_LAUNCH_MODE
#define N_LAUNCH_MODE 1
#endif
extern "C" void kernel_launch(void* const* d_in, const int* in_sizes, int n_in, void* d_out, int out_size, void* d_ws, size_t ws_size, hipStream_t stream) {
    static int grid = 0;
    if (grid == 0) {
        if (n_in != 19 || ws_size < WS_END || (size_t)out_size != OUT_END) { fprintf(stderr, "kernel_launch: unexpected sizes n_in %d ws %zu out %d\n", n_in, ws_size, out_size); grid = -1; return; }
        int dev = 0, cus = 0, per_cu = 0;
        hipGetDevice(&dev); hipDeviceGetAttribute(&cus, hipDeviceAttributeMultiprocessorCount, dev);
        if (hipFuncSetAttribute((const void*)fwd_kernel, hipFuncAttributeMaxDynamicSharedMemorySize, LDS_BYTES) != hipSuccess) { fprintf(stderr, "kernel_launch: hipFuncSetAttribute failed\n"); grid = -1; return; }
        if (hipOccupancyMaxActiveBlocksPerMultiprocessor(&per_cu, (const void*)fwd_kernel, 512, LDS_BYTES) != hipSuccess || per_cu < 1) { fprintf(stderr, "kernel_launch: occupancy query says %d\n", per_cu); per_cu = 1; }
        (void)hipGetLastError();
        grid = cus * per_cu;
    }
    if (grid < 0) return;
    Args a{};
    for (int i = 0; i < 19; ++i) a.in[i] = (const float*)d_in[i];
    a.out = (float*)d_out; a.ws = (unsigned char*)d_ws;
#if N_LAUNCH_MODE == 1
    if (hipMemsetAsync((char*)d_ws + WS_BAR, 0, BAR_BYTES, stream) != hipSuccess) { fprintf(stderr, "kernel_launch: memset of the barrier words failed\n"); return; }
    a.ph_lo = 0; a.ph_hi = 9;
    void* kargs[] = {&a};
    hipError_t e = hipLaunchCooperativeKernel((const void*)fwd_kernel, dim3(grid), dim3(512), kargs, LDS_BYTES, stream);
    if (e != hipSuccess) fprintf(stderr, "cooperative launch failed: %s (grid %d)\n", hipGetErrorString(e), grid);
#else
    for (int p = 0; p < 9; ++p) { a.ph_lo = p; a.ph_hi = p + 1; hipLaunchKernelGGL(fwd_kernel, dim3(grid), dim3(512), LDS_BYTES, stream, a); }
#endif
}
```

```cpp
#include <hip/hip_runtime.h>
#include <hip/hip_cooperative_groups.h>
#include <cstdio>
#include <cstdint>
namespace cg = cooperative_groups;
namespace pg8 {
#define PG8_LAS __attribute__((address_space(3)))
typedef unsigned short bf16_t;
typedef short bf16x8 __attribute__((ext_vector_type(8)));
typedef float f32x4 __attribute__((ext_vector_type(4)));
typedef unsigned u32x4 __attribute__((ext_vector_type(4)));
constexpr int BM = 256, BK = 64, HALF = 128, HTB = HALF * BK * 2  , STAGE_BYTES = 8 * HTB, NXCD = 8, WGM = 8;

__host__ __device__ __forceinline__ int lds_byte(int r, int c) { const int st = (r >> 4) * 2 + (c >> 5), rr = r & 15, cc = c & 31, ob = rr * 64 + cc * 2; return st * 1024 + (ob ^ (((ob >> 9) & 1) << 5)); }
__host__ __device__ __forceinline__ void stage_rc(int b, int& R, int& C) { const int st = b / 1024, sb = b % 1024, swz = sb ^ (((sb >> 9) & 1) << 5); R = (st >> 1) * 16 + swz / 64; C = (st & 1) * 32 + (swz % 64) / 2; }
__host__ __device__ __forceinline__ int perm32(int rho) { const int n = rho >> 4, i = rho & 15; return 8 * (i >> 2) + 4 * n + (i & 3); }

struct Unit { int pm, pn; };
struct Gemm { const bf16_t* A; const bf16_t* Bt; int M, N, K; };

struct StaticOrder {
    int nM, nN, nwg, G, c;
    __host__ __device__ void init(int M, int N, int G_, int c_) { nM = M / BM; nN = N / BM; nwg = nM * nN; G = G_; c = c_; }
    __host__ __device__ bool next(int i, Unit& u) const {
        const long L = (long)i * G + c; if (L >= nwg) return false;
        int wgid = (int)L; { const int q = nwg / NXCD, r = nwg % NXCD, xcd = wgid % NXCD, off = wgid / NXCD; wgid = (xcd < r ? xcd * (q + 1) : r * (q + 1) + (xcd - r) * q) + off; }
        const int nig = WGM * nN, gid = wgid / nig, fm = gid * WGM, gsz = (nM - fm) < WGM ? (nM - fm) : WGM;
        u.pm = fm + ((wgid % nig) % gsz); u.pn = (wgid % nig) / gsz; return true;
    }
    __device__ __forceinline__ void a_ready(const Unit&) const {}
    __device__ __forceinline__ void done(const Unit&) const {}
};

typedef float cvt_f32x2_t __attribute__((ext_vector_type(2))); typedef __bf16 cvt_bf16x2_t __attribute__((ext_vector_type(2)));
__device__ __forceinline__ unsigned cvt_pk_bf16(float lo, float hi) { cvt_f32x2_t v = {lo, hi}; cvt_bf16x2_t b = __builtin_convertvector(v, cvt_bf16x2_t); return __builtin_bit_cast(unsigned, b); }
template <class Epi, class Sched, bool ALIGN_EPI = false, bool SP2 = false>
__device__ __forceinline__ void gemm_phase(PG8_LAS unsigned char* lds, const Gemm g, const Sched& S, const Epi& E) {
    const int tid = threadIdx.x, wid = __builtin_amdgcn_readfirstlane(tid >> 6), lane = tid & 63, wr = wid >> 2, wc = wid & 3, fr = lane & 15, fq = lane >> 4;
    const int K = g.K, nt = K / BK;
    unsigned voffA[2], voffB[2];
#pragma unroll
    for (int i = 0; i < 2; ++i) { int R, C; stage_rc(tid * 16 + i * 8192, R, C); const int Rb = Epi::PERM ? ((R & ~31) + perm32(R & 31)) : R;
        voffA[i] = (unsigned)(R * K + C) * 2u; voffB[i] = (unsigned)(Rb * K + C) * 2u; }
    const size_t kstep = (size_t)(BK * 2);
    const size_t hstep = (size_t)HALF * K * 2;
    const size_t tstep = 2 * hstep;
    const unsigned ldsw = (unsigned)wid * 1024u;
    const int aoff = lds_byte(wr * 64 + fr, fq * 8), boff = lds_byte(wc * 32 + fr, fq * 8);
#define PG8_SA(b, h) (((b) * 2 + (h)) * HTB)
#define PG8_SB(b, h) ((4 + (b) * 2 + (h)) * HTB)
#define PG8_STAGE(bufoff, gbase, voff) do { _Pragma("unroll") for (int _i = 0; _i < 2; ++_i) \
        __builtin_amdgcn_global_load_lds((const unsigned*)((const char*)(gbase) + (voff)[_i]), (PG8_LAS unsigned*)(lds + (bufoff) + ldsw + _i * 8192), 16, 0, 0); } while (0)
#define PG8_LDA(dst, b, h) do { _Pragma("unroll") for (int m = 0; m < 4; ++m) _Pragma("unroll") for (int k = 0; k < 2; ++k) dst[m][k] = *(const PG8_LAS bf16x8*)(lds + PG8_SA(b, h) + aoff + m * 2048 + k * 1024); } while (0)
#define PG8_LDB(dst, b, h) do { _Pragma("unroll") for (int n = 0; n < 2; ++n) _Pragma("unroll") for (int k = 0; k < 2; ++k) dst[n][k] = *(const PG8_LAS bf16x8*)(lds + PG8_SB(b, h) + boff + n * 2048 + k * 1024); } while (0)
#define PG8_MMA(ai, bj, At, Bt) do { __builtin_amdgcn_s_setprio(1); _Pragma("unroll") for (int m = 0; m < 4; ++m) _Pragma("unroll") for (int n = 0; n < 2; ++n) _Pragma("unroll") for (int k = 0; k < 2; ++k) \
        acc[ai][bj][m][n] = __builtin_amdgcn_mfma_f32_16x16x32_bf16(Bt[n][k], At[m][k], acc[ai][bj][m][n], 0, 0, 0); __builtin_amdgcn_s_setprio(0); } while (0)
#define PG8_WAIT_V(n) asm volatile("s_waitcnt vmcnt(" #n ")" ::: "memory")
#define PG8_WAIT_L(n) asm volatile("s_waitcnt lgkmcnt(" #n ")" ::: "memory")
#define PG8_BAR __builtin_amdgcn_s_barrier()
#define PG8_SCHED __builtin_amdgcn_sched_barrier(0)
    Unit cur, nxt; int ui = 0;
    if (!S.next(0, cur)) return;
    f32x4 acc[2][2][4][2];
#pragma unroll
    for (int a = 0; a < 2; ++a)
#pragma unroll
        for (int b = 0; b < 2; ++b)
#pragma unroll
            for (int m = 0; m < 4; ++m)
#pragma unroll
                for (int n = 0; n < 2; ++n) acc[a][b][m][n] = (f32x4){0.f, 0.f, 0.f, 0.f};
    bf16x8 At[4][2], B0[2][2], B1[2][2];
    const char* cA = (const char*)g.A + (size_t)cur.pm * tstep; const char* cB = (const char*)g.Bt + (size_t)cur.pn * tstep;
    S.a_ready(cur);
    if constexpr (SP2) {
        PG8_STAGE(PG8_SB(0, 0), cB, voffB); PG8_STAGE(PG8_SB(0, 1), cB + hstep, voffB); PG8_STAGE(PG8_SA(0, 0), cA, voffA); PG8_STAGE(PG8_SA(0, 1), cA + hstep, voffA);
        if (wr == 1) PG8_BAR;
        PG8_WAIT_V(2); PG8_BAR;
        PG8_STAGE(PG8_SB(1, 0), cB + kstep, voffB); PG8_STAGE(PG8_SA(1, 0), cA + kstep, voffA); PG8_STAGE(PG8_SB(1, 1), cB + hstep + kstep, voffB);
        PG8_WAIT_V(6); PG8_BAR;
    } else {
        PG8_STAGE(PG8_SB(0, 0), cB, voffB); PG8_STAGE(PG8_SA(0, 0), cA, voffA); PG8_STAGE(PG8_SB(0, 1), cB + hstep, voffB); PG8_STAGE(PG8_SA(0, 1), cA + hstep, voffA);
        if (wr == 1) PG8_BAR;
        PG8_WAIT_V(4); PG8_BAR;
        PG8_STAGE(PG8_SB(1, 0), cB + kstep, voffB); PG8_STAGE(PG8_SA(1, 0), cA + kstep, voffA); PG8_STAGE(PG8_SB(1, 1), cB + hstep + kstep, voffB);
        PG8_WAIT_V(6); PG8_BAR;
    }
    for (;;) {
        const bool has_next = S.next(ui + 1, nxt);
        const char* nA = has_next ? (const char*)g.A + (size_t)nxt.pm * tstep : cA; const char* nB = has_next ? (const char*)g.Bt + (size_t)nxt.pn * tstep : cB;
        for (int t = 0; t < nt; t += 2) {
            const bool last = (t == nt - 2);
            const char* a1 = cA + (size_t)(t + 1) * kstep;
            const char* a2 = last ? nA : cA + (size_t)(t + 2) * kstep; const char* b2 = last ? nB : cB + (size_t)(t + 2) * kstep;
            const char* a3 = a2 + kstep; const char* b3 = b2 + kstep;
            if (last && has_next) S.a_ready(nxt);
            if constexpr (SP2) {
            PG8_LDB(B0, 0, 0); PG8_LDB(B1, 0, 1); PG8_SCHED; PG8_LDA(At, 0, 0); PG8_STAGE(PG8_SA(1, 1), a1 + hstep, voffA);
            PG8_WAIT_V(8); PG8_WAIT_L(0); PG8_BAR; PG8_MMA(0, 0, At, B0); PG8_MMA(0, 1, At, B1); PG8_BAR; PG8_SCHED;
            PG8_LDA(At, 0, 1); PG8_STAGE(PG8_SB(0, 0), b2, voffB); PG8_STAGE(PG8_SB(0, 1), b2 + hstep, voffB); PG8_STAGE(PG8_SA(0, 0), a2, voffA);
            PG8_WAIT_V(8); PG8_WAIT_L(0); PG8_BAR; PG8_MMA(1, 0, At, B0); PG8_MMA(1, 1, At, B1); PG8_BAR; PG8_SCHED;
            PG8_LDB(B0, 1, 0); PG8_LDB(B1, 1, 1); PG8_SCHED; PG8_LDA(At, 1, 0); PG8_STAGE(PG8_SA(0, 1), a2 + hstep, voffA);
            PG8_WAIT_V(8); PG8_WAIT_L(0); PG8_BAR; PG8_MMA(0, 0, At, B0); PG8_MMA(0, 1, At, B1); PG8_BAR; PG8_SCHED;
            PG8_LDA(At, 1, 1); PG8_STAGE(PG8_SB(1, 0), b3, voffB); PG8_STAGE(PG8_SB(1, 1), b3 + hstep, voffB); PG8_STAGE(PG8_SA(1, 0), a3, voffA);
            PG8_WAIT_V(8); PG8_WAIT_L(0); PG8_BAR; PG8_MMA(1, 0, At, B0); PG8_MMA(1, 1, At, B1); PG8_BAR; PG8_SCHED;
            } else {
            PG8_LDB(B0, 0, 0); PG8_SCHED; PG8_LDA(At, 0, 0); PG8_STAGE(PG8_SA(1, 1), a1 + hstep, voffA);
            PG8_WAIT_L(8); PG8_BAR; PG8_WAIT_L(0); PG8_MMA(0, 0, At, B0); PG8_BAR; PG8_SCHED;
            PG8_LDB(B1, 0, 1); PG8_STAGE(PG8_SB(0, 0), b2, voffB);
            PG8_BAR; PG8_WAIT_L(0); PG8_MMA(0, 1, At, B1); PG8_BAR;
            PG8_LDA(At, 0, 1); PG8_STAGE(PG8_SA(0, 0), a2, voffA);
            PG8_BAR; PG8_WAIT_L(0); PG8_MMA(1, 0, At, B0); PG8_BAR; PG8_SCHED;
            PG8_STAGE(PG8_SB(0, 1), b2 + hstep, voffB);
            PG8_WAIT_V(6); PG8_BAR; PG8_MMA(1, 1, At, B1); PG8_BAR;
            PG8_LDB(B0, 1, 0); PG8_SCHED; PG8_LDA(At, 1, 0); PG8_STAGE(PG8_SA(0, 1), a2 + hstep, voffA);
            PG8_WAIT_L(8); PG8_BAR; PG8_WAIT_L(0); PG8_MMA(0, 0, At, B0); PG8_BAR; PG8_SCHED;
            PG8_LDB(B1, 1, 1); PG8_STAGE(PG8_SB(1, 0), b3, voffB);
            PG8_BAR; PG8_WAIT_L(0); PG8_MMA(0, 1, At, B1); PG8_BAR;
            PG8_LDA(At, 1, 1); PG8_STAGE(PG8_SA(1, 0), a3, voffA);
            PG8_BAR; PG8_WAIT_L(0); PG8_MMA(1, 0, At, B0); PG8_BAR; PG8_SCHED;
            PG8_STAGE(PG8_SB(1, 1), b3 + hstep, voffB);
            PG8_WAIT_V(6); PG8_BAR; PG8_MMA(1, 1, At, B1); PG8_BAR;
            }
        }
        if constexpr (ALIGN_EPI) { if (wr == 0) PG8_BAR; }
        if constexpr (!Epi::AFTER_DRAIN) { E(acc, cur, wr, wc, fr, fq); S.done(cur); }
        if (!has_next) break;
#pragma unroll
        for (int a = 0; a < 2; ++a)
#pragma unroll
            for (int b = 0; b < 2; ++b)
#pragma unroll
                for (int m = 0; m < 4; ++m)
#pragma unroll
                    for (int n = 0; n < 2; ++n) acc[a][b][m][n] = (f32x4){0.f, 0.f, 0.f, 0.f};
        cur = nxt; cA = nA; cB = nB; ++ui;
        if constexpr (ALIGN_EPI) { if (wr == 1) PG8_BAR; }
    }
    PG8_WAIT_V(0);
    if constexpr (!ALIGN_EPI) { if (wr == 0) PG8_BAR; }
    PG8_BAR;
    if constexpr (Epi::AFTER_DRAIN) { E.fused(acc, cur, wr, wc, fr, fq, lds, wid, lane); S.done(cur); }
#undef PG8_SA
#undef PG8_SB
#undef PG8_STAGE
#undef PG8_LDA
#undef PG8_LDB
#undef PG8_MMA
#undef PG8_WAIT_V
#undef PG8_WAIT_L
#undef PG8_BAR
#undef PG8_SCHED
}
}
using pg8::bf16_t; using pg8::f32x4; using pg8::bf16x8; using pg8::u32x4; using pg8::Unit; using pg8::cvt_pk_bf16;
#define LAS __attribute__((address_space(3)))
typedef unsigned u32x2 __attribute__((ext_vector_type(2)));
typedef float f32x2 __attribute__((ext_vector_type(2)));
constexpr int DM = 1024, NBP = 32, SEQ = 2048, NMETA = 16, LP = SEQ + NMETA, NBS = 32, DSEQ = 64;
constexpr int MP = NBP * LP, MS = NBS * DSEQ, M = MP + MS;
constexpr int FF = 2816, NUP = 2 * FF, NIN = 3328, DIN = 3088;
constexpr int NH = 4, DK = 64, DV = 128;
constexpr float EPS = 1e-6f;
static_assert(M % 256 == 0, "M");
constexpr size_t OUT_YP = 0, OUT_YS = (size_t)NBP * SEQ * DM, OUT_SP = OUT_YS + (size_t)MS * DM, OUT_CP = OUT_SP + (size_t)NBP * NH * DK * DV,
                 OUT_SS = OUT_CP + (size_t)NBP * 2 * 512, OUT_CS = OUT_SS + (size_t)NBS * NH * DK * DV, OUT_END = OUT_CS + (size_t)NBS * 2 * 512;
constexpr size_t MiB = 1u << 20;
constexpr size_t WS_SS = 0, SS_STRIDE = 512 * 1024;
constexpr size_t WS_WUP1 = 2 * MiB, WS_WDN1 = 13 * MiB, WS_WIN = 19 * MiB, WS_WOUT = 26 * MiB, WS_WUP2 = 28 * MiB, WS_WDN2 = 39 * MiB;
constexpr size_t WS_BAR = 46 * MiB, BAR_BYTES = 16384;
constexpr size_t WS_XB = 48 * MiB;
constexpr size_t WS_ACT = 184 * MiB;
constexpr size_t WS_QK = 184 * MiB, WS_U = 450 * MiB, WS_LA = 517 * MiB;
constexpr size_t WS_MIX = 584 * MiB, WS_DUMMY = 718 * MiB, WS_END = 719 * MiB;
static_assert(WS_ACT + (size_t)M * FF * 2 <= WS_MIX && WS_LA + (size_t)M * 256 * 4 <= WS_MIX && WS_U + (size_t)M * 512 * 2 <= WS_LA && WS_QK + (size_t)M * 2048 * 2 <= WS_U, "ws map");
static_assert(WS_XB + (size_t)M * DM * 2 <= WS_ACT && WS_MIX + (size_t)M * DM * 2 <= WS_END && WS_WDN2 + (size_t)DM * FF * 2 <= WS_XB, "ws map");

__device__ __forceinline__ const float* xin_row(const float* xp, const float* meta, const float* xs, int R) {
    if (R < MP) { const int b = R / LP, t = R - b * LP; return t < NMETA ? meta + (size_t)t * DM : xp + ((size_t)b * SEQ + (t - NMETA)) * DM; }
    return xs + (size_t)(R - MP) * DM;
}
__device__ __forceinline__ float* yout_row(float* out, int R) {
    if (R < MP) { const int b = R / LP, t = R - b * LP; return t < NMETA ? nullptr : out + ((size_t)b * SEQ + (t - NMETA)) * DM; }
    return out + OUT_YS + (size_t)(R - MP) * DM;
}
__device__ __forceinline__ float bf_lo(unsigned w) { return __uint_as_float(w << 16); }
__device__ __forceinline__ float bf_hi(unsigned w) { return __uint_as_float(w & 0xffff0000u); }
__device__ __forceinline__ float silu_f(float g) { return g * __builtin_amdgcn_rcpf(1.f + __expf(-g)); }
__device__ __forceinline__ float wave_sum(float v) {
#pragma unroll
    for (int o = 1; o < 64; o <<= 1) v += __shfl_xor(v, o);
    return v;
}

struct EpiUp {
    static constexpr bool PERM = true, AFTER_DRAIN = false;
    bf16_t* O; const float* ss;
    __device__ __forceinline__ void operator()(const f32x4 (&acc)[2][2][4][2], const Unit& u, int wr, int wc, int fr, int fq) const {
        const int row0 = u.pm * 256 + wr * 64 + fr, col0 = u.pn * 128 + wc * 32 + 8 * fq;
#pragma unroll
        for (int ai = 0; ai < 2; ++ai)
#pragma unroll
            for (int m = 0; m < 4; ++m) {
                const int row = row0 + ai * 128 + m * 16;
                const float rs = rsqrtf(ss[row] * (1.0f / DM) + EPS), nl = rs * -1.4426950408889634f, rs2 = rs * rs;
                float o[8];
#pragma unroll
                for (int n = 0; n < 2; ++n) { const f32x4 gv = acc[ai][0][m][n], uv = acc[ai][1][m][n]; const f32x4 t = gv * nl, gu = gv * uv; f32x4 r;
#pragma unroll
                    for (int j = 0; j < 4; ++j) r[j] = __builtin_amdgcn_rcpf(1.0f + __builtin_amdgcn_exp2f(t[j]));
                    const f32x4 ov = gu * (r * rs2);
#pragma unroll
                    for (int j = 0; j < 4; ++j) o[4 * n + j] = ov[j]; }
                u32x4 w; w.x = cvt_pk_bf16(o[0], o[1]); w.y = cvt_pk_bf16(o[2], o[3]); w.z = cvt_pk_bf16(o[4], o[5]); w.w = cvt_pk_bf16(o[6], o[7]);
                *(u32x4*)(O + (size_t)row * FF + col0) = w;
            }
    }
};
template <int MODE> struct EpiRes {
    static constexpr bool PERM = true, AFTER_DRAIN = false;
    const float *xp, *meta, *xs; bf16_t* XB; float* out; float* ss;
    __device__ __forceinline__ void operator()(const f32x4 (&acc)[2][2][4][2], const Unit& u, int wr, int wc, int fr, int fq) const {
        const float alpha = (MODE == 1) ? 1.0f : 0.5f;
#pragma unroll
        for (int ai = 0; ai < 2; ++ai)
#pragma unroll
            for (int m = 0; m < 4; ++m) {
                const int row = u.pm * 256 + ai * 128 + wr * 64 + m * 16 + fr;
                const float* xr = nullptr;
                if (MODE == 0) xr = xin_row(xp, meta, xs, row);
                float sq = 0.f;
#pragma unroll
                for (int bj = 0; bj < 2; ++bj) {
                    const int col = u.pn * 256 + bj * 128 + wc * 32 + 8 * fq;
                    f32x4 b0, b1;
                    if (MODE == 0) { b0 = *(const f32x4*)(xr + col); b1 = *(const f32x4*)(xr + col + 4); }
                    else { const u32x4 w = *(const u32x4*)(XB + (size_t)row * DM + col);
                        b0 = (f32x4){bf_lo(w.x), bf_hi(w.x), bf_lo(w.y), bf_hi(w.y)}; b1 = (f32x4){bf_lo(w.z), bf_hi(w.z), bf_lo(w.w), bf_hi(w.w)}; }
                    const f32x4 v0 = b0 + acc[ai][bj][m][0] * alpha, v1 = b1 + acc[ai][bj][m][1] * alpha;
                    sq += (v0[0] * v0[0] + v0[1] * v0[1]) + (v0[2] * v0[2] + v0[3] * v0[3]) + (v1[0] * v1[0] + v1[1] * v1[1]) + (v1[2] * v1[2] + v1[3] * v1[3]);
                    { u32x4 w; w.x = cvt_pk_bf16(v0[0], v0[1]); w.y = cvt_pk_bf16(v0[2], v0[3]); w.z = cvt_pk_bf16(v1[0], v1[1]); w.w = cvt_pk_bf16(v1[2], v1[3]);
                        *(u32x4*)(XB + (size_t)row * DM + col) = w; }
                }
                sq += __shfl_xor(sq, 16); sq += __shfl_xor(sq, 32);
                if (fq == 0) unsafeAtomicAdd(ss + row, sq);
            }
    }
};
__device__ __forceinline__ float log_sigmoid_f(float z) { const float e = __expf(-fabsf(z)); return fminf(z, 0.f) - __logf(1.f + e); }
struct EpiWin {
    static constexpr bool PERM = true, AFTER_DRAIN = false;
    bf16_t* QK; bf16_t* U; float* LA; const float* ss; const float* b_a;
    __device__ __forceinline__ void operator()(const f32x4 (&acc)[2][2][4][2], const Unit& u, int wr, int wc, int fr, int fq) const {
        const int pn = u.pn;
#pragma unroll
        for (int ai = 0; ai < 2; ++ai)
#pragma unroll
            for (int m = 0; m < 4; ++m) {
                const int row = u.pm * 256 + ai * 128 + wr * 64 + m * 16 + fr;
                const float rs = rsqrtf(ss[row] * (1.0f / DM) + EPS);
                if (pn < 8) {
                    const float sc = (pn == 0) ? rs * 0.125f : rs;
#pragma unroll
                    for (int bj = 0; bj < 2; ++bj) { const f32x4 v0 = acc[ai][bj][m][0] * sc, v1 = acc[ai][bj][m][1] * sc;
                        u32x4 w; w.x = cvt_pk_bf16(v0[0], v0[1]); w.y = cvt_pk_bf16(v0[2], v0[3]); w.z = cvt_pk_bf16(v1[0], v1[1]); w.w = cvt_pk_bf16(v1[2], v1[3]);
                        *(u32x4*)(QK + (size_t)row * 2048 + pn * 256 + bj * 128 + wc * 32 + 8 * fq) = w; }
                } else if (pn < 12) {
                    const float r2 = rs * rs;
                    const f32x4 v0 = acc[ai][0][m][0] * acc[ai][1][m][0] * r2, v1 = acc[ai][0][m][1] * acc[ai][1][m][1] * r2;
                    u32x4 w; w.x = cvt_pk_bf16(v0[0], v0[1]); w.y = cvt_pk_bf16(v0[2], v0[3]); w.z = cvt_pk_bf16(v1[0], v1[1]); w.w = cvt_pk_bf16(v1[2], v1[3]);
                    *(u32x4*)(U + (size_t)row * 512 + (pn - 8) * 128 + wc * 32 + 8 * fq) = w;
                } else {
#pragma unroll
                    for (int bj = 0; bj < 2; ++bj)
#pragma unroll
                        for (int n = 0; n < 2; ++n) { const int c = bj * 128 + wc * 32 + 8 * fq + 4 * n; const f32x4 bb = *(const f32x4*)(b_a + c); f32x4 o;
#pragma unroll
                            for (int j = 0; j < 4; ++j) o[j] = log_sigmoid_f(acc[ai][bj][m][n][j] * rs + bb[j]) * (1.0f / 16.0f);
                            *(f32x4*)(LA + (size_t)row * 256 + c) = o; }
                }
            }
    }
};
__device__ __forceinline__ void tr_item(const float* W, int ldw, int src_col0, const float* gain, bf16_t* WT, int K, int dst_row0, int k0, LAS float* scr, int lane) {
#pragma unroll 8
    for (int i = 0; i < 32; ++i) { const int kk = 2 * i + (lane >> 5); float w = W[(size_t)(k0 + kk) * ldw + src_col0 + (lane & 31)]; if (gain) w *= gain[k0 + kk]; scr[kk * 33 + (lane & 31)] = w; }
    asm volatile("s_waitcnt lgkmcnt(0)" ::: "memory");
    const int c = lane & 7;
#pragma unroll
    for (int j = 0; j < 4; ++j) { const int n = (lane >> 3) + 8 * j; const LAS float* s = scr + (8 * c) * 33 + n;
        u32x4 o; o.x = cvt_pk_bf16(s[0 * 33], s[1 * 33]); o.y = cvt_pk_bf16(s[2 * 33], s[3 * 33]); o.z = cvt_pk_bf16(s[4 * 33], s[5 * 33]); o.w = cvt_pk_bf16(s[6 * 33], s[7 * 33]);
        *(u32x4*)(WT + (size_t)(dst_row0 + n) * K + k0 + 8 * c) = o; }
    asm volatile("s_waitcnt lgkmcnt(0)" ::: "memory");
}
__device__ __forceinline__ int up_src_col(int n) { const int pn = n >> 8, within = n & 255; return (within >> 7) * FF + 128 * pn + (within & 127); }
__device__ __forceinline__ int win_src_col(int n) {
    if (n < 1536) return n;
    if (n < 2048) return n + 16;
    const int j = (n - 2048) >> 8, within = (n - 2048) & 255;
    return ((within >> 7) ? 2576 : 2064) + 128 * j + (within & 127);
}
struct P0Args { const float *xp, *xs, *meta, *n1, *wu1, *wd1, *n2, *win, *wa2, *wout, *n3, *wu2, *wd2; unsigned char* ws; };
__device__ __forceinline__ void p0_prologue(const P0Args& a, LAS unsigned char* lds, int gw, int NGW, int wave, int lane) {
    LAS float* scr = (LAS float*)(lds + wave * 8704);
    constexpr int I_UP = (DM / 64) * (NUP / 32), I_DN = (FF / 64) * (DM / 32), I_IN = (DM / 64) * (3072 / 32), I_OUT = (DM / 64) * (DM / 32);
    constexpr int NITEMS = 2 * I_UP + 2 * I_DN + I_IN + I_OUT;
    bf16_t* WUP1 = (bf16_t*)(a.ws + WS_WUP1); bf16_t* WDN1 = (bf16_t*)(a.ws + WS_WDN1); bf16_t* WIN = (bf16_t*)(a.ws + WS_WIN);
    bf16_t* WOUT = (bf16_t*)(a.ws + WS_WOUT); bf16_t* WUP2 = (bf16_t*)(a.ws + WS_WUP2); bf16_t* WDN2 = (bf16_t*)(a.ws + WS_WDN2);
    for (int it = gw; it < NITEMS; it += NGW) {
        int r = it;
        if (r < 2 * I_UP) { const bool second = r >= I_UP; if (second) r -= I_UP; const int nblk = NUP / 32, kb = r / nblk, nb = r % nblk;
            tr_item(second ? a.wu2 : a.wu1, NUP, up_src_col(32 * nb), second ? a.n3 : a.n1, second ? WUP2 : WUP1, DM, 32 * nb, 64 * kb, scr, lane); continue; }
        r -= 2 * I_UP;
        if (r < 2 * I_DN) { const bool second = r >= I_DN; if (second) r -= I_DN; const int nblk = DM / 32, kb = r / nblk, nb = r % nblk;
            tr_item(second ? a.wd2 : a.wd1, DM, 32 * nb, nullptr, second ? WDN2 : WDN1, FF, 32 * nb, 64 * kb, scr, lane); continue; }
        r -= 2 * I_DN;
        if (r < I_IN) { const int nblk = 3072 / 32, kb = r / nblk, nb = r % nblk;
            tr_item(a.win, DIN, win_src_col(32 * nb), a.n2, WIN, DM, 32 * nb, 64 * kb, scr, lane); continue; }
        r -= I_IN;
        { const int nblk = DM / 32, kb = r / nblk, nb = r % nblk; tr_item(a.wout, DM, 32 * nb, nullptr, WOUT, DM, 32 * nb, 64 * kb, scr, lane); }
    }
    for (int e = gw * 64 + lane; e < 256 * DM; e += NGW * 64) { const int n = e >> 10, k = e & 1023; const float* wr_ = a.win + (size_t)k * DIN + 1536; float s = 0.f;
#pragma unroll
        for (int r = 0; r < 16; ++r) s += wr_[r] * a.wa2[r * 256 + n];
        s *= a.n2[k]; const unsigned short b = (unsigned short)(cvt_pk_bf16(s, 0.f) & 0xffffu); WIN[(size_t)(3072 + n) * DM + k] = b; }
    bf16_t* XB = (bf16_t*)(a.ws + WS_XB); float* ss0 = (float*)(a.ws + WS_SS);
    for (int R = gw; R < M; R += NGW) {
        const f32x4* xr = (const f32x4*)xin_row(a.xp, a.meta, a.xs, R) + lane; f32x4 v[4]; float s = 0.f;
#pragma unroll
        for (int j = 0; j < 4; ++j) { v[j] = xr[64 * j]; s += (v[j][0] * v[j][0] + v[j][1] * v[j][1]) + (v[j][2] * v[j][2] + v[j][3] * v[j][3]); }
        s = wave_sum(s);
        u32x2* o8 = (u32x2*)(XB + (size_t)R * DM) + lane;
#pragma unroll
        for (int j = 0; j < 4; ++j) { u32x2 w; w.x = cvt_pk_bf16(v[j][0], v[j][1]); w.y = cvt_pk_bf16(v[j][2], v[j][3]); o8[64 * j] = w; }
        if (lane == 0) { ss0[R] = s; ss0[R + SS_STRIDE / 4] = 0.f; ss0[R + 2 * (SS_STRIDE / 4)] = 0.f; ss0[R + 3 * (SS_STRIDE / 4)] = 0.f; }
    }
}

struct GlaArgs { const bf16_t* QK; const float* LA; const bf16_t* U; bf16_t* MIX; const float* state_in; const float* cache_conv; const float* g_head; const float* w_conv; float* out; bf16_t* dummy; };
constexpr int RS = 144;
constexpr int VRS = 272;
constexpr int L_G = 0, L_VR = 16384, L_QT = 0, L_ATT = 9216, L_KT = 18432, L_KTT = 27648, L_G2 = 36864, L_EGL = 53248, L_SSQ = 53504, L_VT = 54016, L_ST = 72448, ST_BYTES = 128 * RS, L_SEG = 109312, L_QR = 111360, L_KR = 119552;
__device__ __forceinline__ bf16x8 ldf(LAS const unsigned char* base, int row, int ks, int fq) { return *(const LAS bf16x8*)(base + row * RS + ks * 64 + fq * 16); }
__device__ __forceinline__ void gla_unit(const GlaArgs& a, LAS unsigned char* lds, int unit, int tid, int wave, int lane) {
    const bool samp = unit >= 128; const int s = (unit & 127) >> 2, h = unit & 3;
    const int L = samp ? DSEQ : LP; const int row0 = samp ? MP + s * DSEQ : s * LP;
    const int fr = lane & 15, fq = lane >> 4, rb = wave & 3, vh = wave >> 2;
    LAS float* G = (LAS float*)(lds + L_G); LAS float* G2 = (LAS float*)(lds + L_G2); LAS float* EGL = (LAS float*)(lds + L_EGL); LAS float* SSQ = (LAS float*)(lds + L_SSQ);
    f32x4 Sacc[4], gh[4];
    const size_t sbase = (size_t)(s * NH + h) * DK * DV;
#pragma unroll
    for (int vt = 0; vt < 4; ++vt) { const int v = 64 * vh + 16 * vt + fr;
#pragma unroll
        for (int jj = 0; jj < 4; ++jj) Sacc[vt][jj] = samp ? a.state_in[sbase + (size_t)(16 * rb + 4 * fq + jj) * DV + v] : 0.f;
        u32x2 w; w.x = cvt_pk_bf16(Sacc[vt][0], Sacc[vt][1]); w.y = cvt_pk_bf16(Sacc[vt][2], Sacc[vt][3]);
        *(LAS u32x2*)(lds + L_ST + v * RS + (16 * rb + 4 * fq) * 2) = w;
        gh[vt] = *(const f32x4*)(a.g_head + 64 * vh + 16 * vt + 4 * fq); }
    const int lt = tid >> 3, ld0 = (tid & 7) * 8;
    const int vt_t = tid >> 4, vc = tid & 15;
    u32x4 pq, pk, pv0, pv1; f32x4 pl0, pl1; u32x2 rg0, rg1, rg2, rg3;
    const u32x4 z4 = (u32x4){0u, 0u, 0u, 0u}; const f32x4 zf = (f32x4){0.f, 0.f, 0.f, 0.f};
#define GL16(dst, ptr) dst = *(const u32x4*)(ptr)
#define GL16F(dst, ptr) dst = *(const f32x4*)(ptr)
#define GL8(dst, ptr) dst = *(const u32x2*)(ptr)
#define GLA_ISSUE_P(T0) do { \
        const int tq_ = min((T0) + lt, L - 1), ta_ = min((T0) + vt_t, L - 1), tb_ = min((T0) + vt_t + 32, L - 1); \
        const bf16_t* p_ = a.QK + (size_t)(row0 + tq_) * 2048 + h * 64 + ld0; GL16(pq, p_); GL16(pk, p_ + 256); \
        GL16(pv0, a.QK + (size_t)(row0 + ta_) * 2048 + 512 + h * 128 + vc * 8); GL16F(pl0, a.LA + (size_t)(row0 + ta_) * 256 + h * 64 + vc * 4); \
        GL16(pv1, a.QK + (size_t)(row0 + tb_) * 2048 + 512 + h * 128 + vc * 8); GL16F(pl1, a.LA + (size_t)(row0 + tb_) * 256 + h * 64 + vc * 4); } while (0)
#define GLA_ISSUE_R(T0) do { const bf16_t* r_ = a.QK + (size_t)(row0 + min((T0) + 16 * rb + fr, L - 1)) * 2048 + 1024 + h * 128 + 64 * vh + 4 * fq; \
        GL8(rg0, r_); GL8(rg1, r_ + 16); GL8(rg2, r_ + 32); GL8(rg3, r_ + 48); } while (0)
#define GLA_STAGE(T0) do { \
        if ((T0) + lt >= L) { pq = z4; pk = z4; } \
        if ((T0) + vt_t >= L) { pv0 = z4; pl0 = zf; } \
        if ((T0) + vt_t + 32 >= L) { pv1 = z4; pl1 = zf; } \
        *(LAS f32x4*)(G + vt_t * 64 + vc * 4) = pl0; *(LAS f32x4*)(G + (vt_t + 32) * 64 + vc * 4) = pl1; \
        *(LAS u32x4*)(lds + L_VR + vt_t * VRS + vc * 16) = pv0; *(LAS u32x4*)(lds + L_VR + (vt_t + 32) * VRS + vc * 16) = pv1; \
        *(LAS u32x4*)(lds + L_QR + tid * 16) = pq; *(LAS u32x4*)(lds + L_KR + tid * 16) = pk; } while (0)
    GLA_ISSUE_P(0); GLA_STAGE(0);
    const int nch = (L + 63) >> 6;
    for (int c = 0; c < nch; ++c) {
        const int t0 = c * 64, cur = c & 1;
        __syncthreads();
        GLA_ISSUE_R(t0); GLA_ISSUE_P(t0 + 64);
        { const int d = tid & 63; float c8[8];
#pragma unroll
            for (int e = 0; e < 8; ++e) c8[e] = G[(8 * wave + e) * 64 + d];
#pragma unroll
            for (int e = 1; e < 8; ++e) c8[e] += c8[e - 1];
#pragma unroll
            for (int e = 0; e < 8; ++e) G2[(8 * wave + e) * 64 + d] = c8[e];
            ((LAS float*)(lds + L_SEG))[wave * 64 + d] = c8[7]; }
        { const int v = tid & 127, tg = tid >> 7; unsigned w[8];
#pragma unroll
            for (int e = 0; e < 8; ++e) { const unsigned lo = *(const LAS unsigned short*)(lds + L_VR + (16 * tg + 2 * e) * VRS + v * 2), hi = *(const LAS unsigned short*)(lds + L_VR + (16 * tg + 2 * e + 1) * VRS + v * 2); w[e] = lo | (hi << 16); }
            *(LAS u32x4*)(lds + L_VT + v * RS + tg * 32) = (u32x4){w[0], w[1], w[2], w[3]}; *(LAS u32x4*)(lds + L_VT + v * RS + tg * 32 + 16) = (u32x4){w[4], w[5], w[6], w[7]}; }
        __syncthreads();
        { f32x4 g0 = *(const LAS f32x4*)(G2 + lt * 64 + ld0), g1 = *(const LAS f32x4*)(G2 + lt * 64 + ld0 + 4);
            { const LAS float* SEG = (const LAS float*)(lds + L_SEG) + ld0; const int seg = lt >> 3; f32x4 t0 = zf, t1 = zf;
#pragma unroll
                for (int s8 = 0; s8 < 8; ++s8) { const f32x4 a0 = *(const LAS f32x4*)(SEG + s8 * 64), a1 = *(const LAS f32x4*)(SEG + s8 * 64 + 4);
                    if (s8 < seg) { g0 += a0; g1 += a1; } t0 += a0; t1 += a1; }
                if (lt == 63) { f32x4 e0, e1;
#pragma unroll
                    for (int j = 0; j < 4; ++j) { e0[j] = __expf(t0[j]); e1[j] = __expf(t1[j]); }
                    *(LAS f32x4*)(EGL + ld0) = e0; *(LAS f32x4*)(EGL + ld0 + 4) = e1; } }
            const float gq[8] = {g0[0], g0[1], g0[2], g0[3], g1[0], g1[1], g1[2], g1[3]};
            const u32x4 rq = *(const LAS u32x4*)(lds + L_QR + tid * 16), rk = *(const LAS u32x4*)(lds + L_KR + tid * 16);
            const float qv[8] = {bf_lo(rq.x), bf_hi(rq.x), bf_lo(rq.y), bf_hi(rq.y), bf_lo(rq.z), bf_hi(rq.z), bf_lo(rq.w), bf_hi(rq.w)};
            const float kv[8] = {bf_lo(rk.x), bf_hi(rk.x), bf_lo(rk.y), bf_hi(rk.y), bf_lo(rk.z), bf_hi(rk.z), bf_lo(rk.w), bf_hi(rk.w)};
            float qt[8], kt[8];
#pragma unroll
            for (int e = 0; e < 8; ++e) { qt[e] = qv[e] * __expf(gq[e]); kt[e] = kv[e] * __expf(-gq[e]); }
            *(LAS u32x4*)(lds + L_QT + lt * RS + ld0 * 2) = (u32x4){cvt_pk_bf16(qt[0], qt[1]), cvt_pk_bf16(qt[2], qt[3]), cvt_pk_bf16(qt[4], qt[5]), cvt_pk_bf16(qt[6], qt[7])};
            *(LAS u32x4*)(lds + L_KT + lt * RS + ld0 * 2) = (u32x4){cvt_pk_bf16(kt[0], kt[1]), cvt_pk_bf16(kt[2], kt[3]), cvt_pk_bf16(kt[4], kt[5]), cvt_pk_bf16(kt[6], kt[7])}; }
        const int orow = t0 + 16 * rb + fr; const bool ovalid = orow < L;
        __syncthreads();
        { const int d = tid & 63; unsigned w[4];
#pragma unroll
            for (int e = 0; e < 4; ++e) { const unsigned lo = *(const LAS unsigned short*)(lds + L_KT + (8 * wave + 2 * e) * RS + d * 2), hi = *(const LAS unsigned short*)(lds + L_KT + (8 * wave + 2 * e + 1) * RS + d * 2); w[e] = lo | (hi << 16); }
            *(LAS u32x4*)(lds + L_KTT + d * RS + wave * 16) = (u32x4){w[0], w[1], w[2], w[3]}; }
#pragma unroll
        for (int tt = 0; tt < 2; ++tt) { const int tile = 2 * wave + tt, ib = tile >> 2, jb = tile & 3; f32x4 acc = zf;
            if (jb <= ib) {
#pragma unroll
                for (int ks = 0; ks < 2; ++ks) acc = __builtin_amdgcn_mfma_f32_16x16x32_bf16(ldf(lds + L_KT, 16 * jb + fr, ks, fq), ldf(lds + L_QT, 16 * ib + fr, ks, fq), acc, 0, 0, 0);
                if (jb == ib) {
#pragma unroll
                    for (int jj = 0; jj < 4; ++jj) if (4 * fq + jj > fr) acc[jj] = 0.f; } }
            u32x2 w; w.x = cvt_pk_bf16(acc[0], acc[1]); w.y = cvt_pk_bf16(acc[2], acc[3]);
            *(LAS u32x2*)(lds + L_ATT + (16 * ib + fr) * RS + (16 * jb + 4 * fq) * 2) = w; }
        __syncthreads();
        f32x4 o[4]; float sq = 0.f;
        { const bf16x8 ya0 = ldf(lds + L_ATT, 16 * rb + fr, 0, fq), ya1 = ldf(lds + L_ATT, 16 * rb + fr, 1, fq), ya2 = ldf(lds + L_QT, 16 * rb + fr, 0, fq), ya3 = ldf(lds + L_QT, 16 * rb + fr, 1, fq);
            const bf16x8 kx0 = ldf(lds + L_KTT, 16 * rb + fr, 0, fq), kx1 = ldf(lds + L_KTT, 16 * rb + fr, 1, fq);
            const f32x4 eg = *(const LAS f32x4*)(EGL + 16 * rb + 4 * fq);
            LAS const unsigned char* STc = lds + L_ST + cur * ST_BYTES; LAS unsigned char* STn = lds + L_ST + (cur ^ 1) * ST_BYTES;
#pragma unroll
            for (int vt = 0; vt < 4; ++vt) { const int v0 = 64 * vh + 16 * vt;
                const bf16x8 vx0 = ldf(lds + L_VT, v0 + fr, 0, fq), vx1 = ldf(lds + L_VT, v0 + fr, 1, fq), sx0 = ldf(STc, v0 + fr, 0, fq), sx1 = ldf(STc, v0 + fr, 1, fq);
                f32x4 acc = zf;
                acc = __builtin_amdgcn_mfma_f32_16x16x32_bf16(vx0, ya0, acc, 0, 0, 0); acc = __builtin_amdgcn_mfma_f32_16x16x32_bf16(vx1, ya1, acc, 0, 0, 0);
                acc = __builtin_amdgcn_mfma_f32_16x16x32_bf16(sx0, ya2, acc, 0, 0, 0); acc = __builtin_amdgcn_mfma_f32_16x16x32_bf16(sx1, ya3, acc, 0, 0, 0);
                o[vt] = acc; sq += (acc[0] * acc[0] + acc[1] * acc[1]) + (acc[2] * acc[2] + acc[3] * acc[3]);
                f32x4 sa = Sacc[vt];
                sa = __builtin_amdgcn_mfma_f32_16x16x32_bf16(kx0, vx0, sa, 0, 0, 0); sa = __builtin_amdgcn_mfma_f32_16x16x32_bf16(kx1, vx1, sa, 0, 0, 0);
                sa = sa * eg; Sacc[vt] = sa;
                u32x2 w; w.x = cvt_pk_bf16(sa[0], sa[1]); w.y = cvt_pk_bf16(sa[2], sa[3]);
                *(LAS u32x2*)(STn + (v0 + fr) * RS + (16 * rb + 4 * fq) * 2) = w; } }
        sq += __shfl_xor(sq, 16); sq += __shfl_xor(sq, 32);
        if (fq == 0) SSQ[vh * 64 + 16 * rb + fr] = sq;
        __syncthreads();
        { const float rs = rsqrtf((SSQ[16 * rb + fr] + SSQ[64 + 16 * rb + fr]) * (1.0f / DV) + EPS);
            GLA_STAGE(t0 + 64);
            const u32x2 rg[4] = {rg0, rg1, rg2, rg3};
            bf16_t* mrow = ovalid ? a.MIX + (size_t)(row0 + orow) * DM + h * 128 + 64 * vh + 4 * fq : a.dummy + tid * 64;
            {
#pragma unroll
                for (int vt = 0; vt < 4; ++vt) { const float r0 = bf_lo(rg[vt].x), r1 = bf_hi(rg[vt].x), r2 = bf_lo(rg[vt].y), r3 = bf_hi(rg[vt].y);
                    u32x2 w; w.x = cvt_pk_bf16(o[vt][0] * rs * gh[vt][0] * silu_f(r0), o[vt][1] * rs * gh[vt][1] * silu_f(r1)); w.y = cvt_pk_bf16(o[vt][2] * rs * gh[vt][2] * silu_f(r2), o[vt][3] * rs * gh[vt][3] * silu_f(r3));
                    *(u32x2*)(mrow + 16 * vt) = w; } } }
    }
#undef GLA_ISSUE_P
#undef GLA_ISSUE_R
#undef GLA_STAGE
#undef GL16
#undef GL16F
#undef GL8
    float* sout = a.out + (samp ? OUT_SS : OUT_SP) + sbase;
#pragma unroll
    for (int vt = 0; vt < 4; ++vt)
#pragma unroll
        for (int jj = 0; jj < 4; ++jj) sout[(size_t)(16 * rb + 4 * fq + jj) * DV + 64 * vh + 16 * vt + fr] = Sacc[vt][jj];
    __syncthreads();
}
__device__ __forceinline__ void conv_pass(const GlaArgs& a, int gtid, int nthreads) {
    for (int item = gtid; item < M * 64; item += nthreads) {
        const int R = item >> 6, c8 = (item & 63) * 8;
        int b, t, L; bool samp = R >= MP;
        if (!samp) { b = R / LP; t = R - b * LP; L = LP; } else { const int r2 = R - MP; b = r2 >> 6; t = r2 & 63; L = DSEQ; }
        float u2[8], u1[8], u0[8], bb[8];
        { const u32x4 w = *(const u32x4*)(a.U + (size_t)R * 512 + c8); u2[0] = bf_lo(w.x); u2[1] = bf_hi(w.x); u2[2] = bf_lo(w.y); u2[3] = bf_hi(w.y); u2[4] = bf_lo(w.z); u2[5] = bf_hi(w.z); u2[6] = bf_lo(w.w); u2[7] = bf_hi(w.w); }
        if (t >= 1) { const u32x4 w = *(const u32x4*)(a.U + (size_t)(R - 1) * 512 + c8); u1[0] = bf_lo(w.x); u1[1] = bf_hi(w.x); u1[2] = bf_lo(w.y); u1[3] = bf_hi(w.y); u1[4] = bf_lo(w.z); u1[5] = bf_hi(w.z); u1[6] = bf_lo(w.w); u1[7] = bf_hi(w.w); }
        else {
#pragma unroll
            for (int j = 0; j < 8; ++j) u1[j] = samp ? a.cache_conv[((size_t)b * 2 + 1) * 512 + c8 + j] : 0.f; }
        if (t >= 2) { const u32x4 w = *(const u32x4*)(a.U + (size_t)(R - 2) * 512 + c8); u0[0] = bf_lo(w.x); u0[1] = bf_hi(w.x); u0[2] = bf_lo(w.y); u0[3] = bf_hi(w.y); u0[4] = bf_lo(w.z); u0[5] = bf_hi(w.z); u0[6] = bf_lo(w.w); u0[7] = bf_hi(w.w); }
        else {
#pragma unroll
            for (int j = 0; j < 8; ++j) u0[j] = samp ? a.cache_conv[((size_t)b * 2 + t) * 512 + c8 + j] : 0.f; }
        { const u32x4 w = *(const u32x4*)(a.QK + (size_t)R * 2048 + 1536 + c8); bb[0] = bf_lo(w.x); bb[1] = bf_hi(w.x); bb[2] = bf_lo(w.y); bb[3] = bf_hi(w.y); bb[4] = bf_lo(w.z); bb[5] = bf_hi(w.z); bb[6] = bf_lo(w.w); bb[7] = bf_hi(w.w); }
        float o[8];
#pragma unroll
        for (int j = 0; j < 8; ++j) o[j] = bb[j] * (a.w_conv[c8 + j] * u0[j] + a.w_conv[512 + c8 + j] * u1[j] + a.w_conv[1024 + c8 + j] * u2[j]);
        u32x4 w; w.x = cvt_pk_bf16(o[0], o[1]); w.y = cvt_pk_bf16(o[2], o[3]); w.z = cvt_pk_bf16(o[4], o[5]); w.w = cvt_pk_bf16(o[6], o[7]);
        *(u32x4*)(a.MIX + (size_t)R * DM + 512 + c8) = w;
        if (t >= L - 2) { float* oc = a.out + (samp ? OUT_CS : OUT_CP) + ((size_t)b * 2 + (t - (L - 2))) * 512 + c8;
            *(f32x4*)oc = (f32x4){u2[0], u2[1], u2[2], u2[3]}; *(f32x4*)(oc + 4) = (f32x4){u2[4], u2[5], u2[6], u2[7]}; }
    }
}
__device__ __forceinline__ void final_norm(float* out, const bf16_t* XB, const float* ss3, const float* gfin, int gw, int NGW, int lane) {
    constexpr int NR = NBP * SEQ + MS;
    f32x4 g0 = ((const f32x4*)gfin)[2 * lane], g1 = ((const f32x4*)gfin)[2 * lane + 1], g2 = ((const f32x4*)gfin)[128 + 2 * lane], g3 = ((const f32x4*)gfin)[128 + 2 * lane + 1];
    for (int Rp = gw; Rp < NR; Rp += NGW) {
        int R; if (Rp < NBP * SEQ) { const int b = Rp >> 11, t = Rp & 2047; R = b * LP + NMETA + t; } else R = MP + (Rp - NBP * SEQ);
        const float rs = rsqrtf(ss3[R] * (1.0f / DM) + EPS);
        const u32x4 w0 = *((const u32x4*)(XB + (size_t)R * DM) + lane), w1 = *((const u32x4*)(XB + (size_t)R * DM) + 64 + lane);
        f32x4* yr = (f32x4*)(out + (size_t)Rp * DM);
        yr[2 * lane] = (f32x4){bf_lo(w0.x), bf_hi(w0.x), bf_lo(w0.y), bf_hi(w0.y)} * rs * g0; yr[2 * lane + 1] = (f32x4){bf_lo(w0.z), bf_hi(w0.z), bf_lo(w0.w), bf_hi(w0.w)} * rs * g1;
        yr[128 + 2 * lane] = (f32x4){bf_lo(w1.x), bf_hi(w1.x), bf_lo(w1.y), bf_hi(w1.y)} * rs * g2; yr[128 + 2 * lane + 1] = (f32x4){bf_lo(w1.z), bf_hi(w1.z), bf_lo(w1.w), bf_hi(w1.w)} * rs * g3;
    }
}

#define XB_TMO      128
#define XB_XCNT(j)  (256  + 64 * (j))
#define XB_XSUB(j)  (1280 + 64 * (j))
#define XB_XGEN(j)  (2304 + 64 * (j))
#define XB_TOP      3328
#define XB_TOPGEN   3392
#define XCD_BAR_WORDS 3456
#define XB_SPIN_CAP (1u << 18)

__device__ __forceinline__ unsigned xb_ld(unsigned* p)              { return __hip_atomic_load(p, __ATOMIC_RELAXED, __HIP_MEMORY_SCOPE_AGENT); }
__device__ __forceinline__ unsigned xb_add(unsigned* p, unsigned v) { return __hip_atomic_fetch_add(p, v, __ATOMIC_RELAXED, __HIP_MEMORY_SCOPE_AGENT); }
__device__ __forceinline__ unsigned xb_xcc_id() { return (unsigned)__builtin_amdgcn_s_getreg((3 << 11) | 20) & 0xFu; }
#define XB_SPIN(cond, bar) do { unsigned _sp = 0; while (cond) { __builtin_amdgcn_s_sleep(1); \
    if ((++_sp & 255u) == 0u) { if (xb_ld(&(bar)[XB_TMO])) break; if (_sp > XB_SPIN_CAP) { atomicAdd(&(bar)[XB_TMO], 1u); break; } } } } while (0)

struct XcdBarrier {
    unsigned* bar; unsigned x;
    volatile LAS unsigned* st;
};

__device__ __forceinline__ XcdBarrier xcd_barrier_post(unsigned* bar, volatile LAS unsigned* st) {
    XcdBarrier b; b.bar = bar; b.x = xb_xcc_id(); b.st = st;
    if (threadIdx.x == 0) (void)xb_add(&bar[XB_XCNT(b.x)], 1u);
    return b;
}
__device__ __forceinline__ void xcd_barrier_complete(unsigned* bar, unsigned x, unsigned& nloc, unsigned& nx) {
    const unsigned G = gridDim.x * gridDim.y * gridDim.z;
    unsigned sum, cnt, mine, sp = 0u;
    for (;;) {
        sum = 0u; cnt = 0u; mine = 0u;
#pragma unroll
        for (unsigned j = 0; j < 16; ++j) { const unsigned c = xb_ld(&bar[XB_XCNT(j)]); sum += c; cnt += (c > 0u) ? 1u : 0u; mine = (j == x) ? c : mine; }
        if (sum == G) break;
        __builtin_amdgcn_s_sleep(1);
        if ((++sp & 255u) == 0u) { if (xb_ld(&bar[XB_TMO])) break; if (sp > XB_SPIN_CAP) { atomicAdd(&bar[XB_TMO], 1u); break; } }
    }
    nloc = mine > 0u ? mine : 1u; nx = cnt > 0u ? cnt : 1u;
}

__device__ __forceinline__ void xcd_barrier(const XcdBarrier& b) {
    asm volatile("s_waitcnt vmcnt(0)" ::: "memory");
    __syncthreads();
    if (threadIdx.x == 0) {
        unsigned* bar = b.bar;
        __builtin_amdgcn_s_waitcnt(0);
        unsigned nloc = b.st[0], nx = b.st[1];
        if (nloc == 0u) { xcd_barrier_complete(bar, b.x, nloc, nx); b.st[0] = nloc; b.st[1] = nx; }
        const unsigned old = xb_add(&bar[XB_XSUB(b.x)], 1u);
        const unsigned gen = old / nloc;
        if (old + 1u == (gen + 1u) * nloc) {
            __builtin_amdgcn_fence(__ATOMIC_RELEASE, "agent");
            asm volatile("s_waitcnt vmcnt(0)" ::: "memory");
            const unsigned og = xb_add(&bar[XB_TOP], 1u);
            const unsigned tg = og / nx;
            if (og + 1u == (tg + 1u) * nx) xb_add(&bar[XB_TOPGEN], 1u);
            else XB_SPIN(xb_ld(&bar[XB_TOPGEN]) == tg, bar);
            __builtin_amdgcn_fence(__ATOMIC_ACQUIRE, "agent");
            xb_add(&bar[XB_XGEN(b.x)], 1u);
            asm volatile("s_waitcnt vmcnt(0)" ::: "memory");
        } else {
            XB_SPIN(xb_ld(&bar[XB_XGEN(b.x)]) == gen, bar);
            __builtin_amdgcn_fence(__ATOMIC_ACQUIRE, "agent");
            asm volatile("s_waitcnt vmcnt(0)" ::: "memory");
        }
    }
    __syncthreads();
}

struct Args { const float* in[19]; float* out; unsigned char* ws; int ph_lo, ph_hi; };
constexpr int LDS_BYTES = 147456;
__global__ void __launch_bounds__(512, 2) fwd_kernel(Args args) {
    extern __shared__ __attribute__((aligned(16))) unsigned char lds_raw[];
    LAS unsigned char* lds = (LAS unsigned char*)lds_raw;
    cg::grid_group grid = cg::this_grid();
    const int tid = threadIdx.x, lane = tid & 63, wave = __builtin_amdgcn_readfirstlane(tid >> 6);
    const int G = gridDim.x, bx = blockIdx.x;
    const int gw = bx * 8 + wave, NGW = G * 8;
    unsigned char* ws = args.ws;
    const float *x_prompt = args.in[0], *x_sample = args.in[1], *state_gla = args.in[2], *cache_conv = args.in[3], *meta = args.in[4], *norm_ffn1 = args.in[5], *w_up1 = args.in[6], *w_down1 = args.in[7],
                *norm_mix = args.in[8], *w_in = args.in[9], *w_a2 = args.in[10], *b_a = args.in[11], *g_head = args.in[12], *w_conv = args.in[13], *w_out = args.in[14], *norm_ffn2 = args.in[15],
                *w_up2 = args.in[16], *w_down2 = args.in[17], *norm_final = args.in[18];
    bf16_t* XB = (bf16_t*)(ws + WS_XB); bf16_t* ACT = (bf16_t*)(ws + WS_ACT); bf16_t* QK = (bf16_t*)(ws + WS_QK); bf16_t* U = (bf16_t*)(ws + WS_U); float* LA = (float*)(ws + WS_LA); bf16_t* MIX = (bf16_t*)(ws + WS_MIX);
    float* ss0 = (float*)(ws + WS_SS); float* ss1 = ss0 + SS_STRIDE / 4; float* ss2 = ss1 + SS_STRIDE / 4; float* ss3 = ss2 + SS_STRIDE / 4;
    const int lo = args.ph_lo, hi = args.ph_hi;
    volatile LAS unsigned* bst = (volatile LAS unsigned*)(lds + 140000);
    if (tid < 2) bst[tid] = 0u;
    __syncthreads();
    XcdBarrier xbar = xcd_barrier_post((unsigned*)(ws + WS_BAR), bst);
#define IN(k) (lo <= (k) && (k) < hi)
#define SEAM(k) do { if (IN(k) && IN((k) + 1)) { asm volatile("s_waitcnt vmcnt(0) lgkmcnt(0)" ::: "memory"); if (lo == 12345) grid.sync(); xcd_barrier(xbar); } } while (0)
    if (IN(0)) {
        P0Args pa{x_prompt, x_sample, meta, norm_ffn1, w_up1, w_down1, norm_mix, w_in, w_a2, w_out, norm_ffn2, w_up2, w_down2, ws};
        p0_prologue(pa, lds, gw, NGW, wave, lane);
    }
    SEAM(0);
    if (IN(1)) {
        pg8::Gemm g{XB, (const bf16_t*)(ws + WS_WUP1), M, NUP, DM}; pg8::StaticOrder S; S.init(M, NUP, G, bx);
        EpiUp E{ACT, ss0};
        pg8::gemm_phase<EpiUp, pg8::StaticOrder, true, true>(lds, g, S, E);
    }
    SEAM(1);
    if (IN(2)) {
        pg8::Gemm g{ACT, (const bf16_t*)(ws + WS_WDN1), M, DM, FF}; pg8::StaticOrder S; S.init(M, DM, G, bx);
        EpiRes<0> E{x_prompt, meta, x_sample, XB, args.out, ss1};
        pg8::gemm_phase<EpiRes<0>, pg8::StaticOrder, true, true>(lds, g, S, E);
    }
    SEAM(2);
    if (IN(3)) {
        pg8::Gemm g{XB, (const bf16_t*)(ws + WS_WIN), M, NIN, DM}; pg8::StaticOrder S; S.init(M, NIN, G, bx);
        EpiWin E{QK, U, LA, ss1, b_a};
        pg8::gemm_phase<EpiWin, pg8::StaticOrder, true, true>(lds, g, S, E);
    }
    SEAM(3);
    if (IN(4)) {
        GlaArgs ga{QK, LA, U, MIX, state_gla, cache_conv, g_head, w_conv, args.out, (bf16_t*)(ws + WS_DUMMY)};
        for (int unit = bx; unit < 256; unit += G) gla_unit(ga, lds, unit, tid, wave, lane);
        if (G == 256) { if (bx >= 128) conv_pass(ga, (bx - 128) * 512 + tid, 128 * 512); }
        else conv_pass(ga, bx * 512 + tid, G * 512);
    }
    SEAM(4);
    if (IN(5)) {
        pg8::Gemm g{MIX, (const bf16_t*)(ws + WS_WOUT), M, DM, DM}; pg8::StaticOrder S; S.init(M, DM, G, bx);
        EpiRes<1> E{x_prompt, meta, x_sample, XB, args.out, ss2};
        pg8::gemm_phase<EpiRes<1>, pg8::StaticOrder, true, true>(lds, g, S, E);
    }
    SEAM(5);
    if (IN(6)) {
        pg8::Gemm g{XB, (const bf16_t*)(ws + WS_WUP2), M, NUP, DM}; pg8::StaticOrder S; S.init(M, NUP, G, bx);
        EpiUp E{ACT, ss2};
        pg8::gemm_phase<EpiUp, pg8::StaticOrder, true, true>(lds, g, S, E);
    }
    SEAM(6);
    if (IN(7)) {
        pg8::Gemm g{ACT, (const bf16_t*)(ws + WS_WDN2), M, DM, FF}; pg8::StaticOrder S; S.init(M, DM, G, bx);
        EpiRes<2> E{x_prompt, meta, x_sample, XB, args.out, ss3};
        pg8::gemm_phase<EpiRes<2>, pg8::StaticOrder, true, true>(lds, g, S, E);
    }
    SEAM(7);
    if (IN(8)) final_norm(args.out, XB, ss3, norm_final, gw, NGW, lane);
#undef IN
#undef SEAM
}

#ifndef N_LAUNCH_MODE
#define N_LAUNCH_MODE 1
#endif
extern "C" void kernel_launch(void* const* d_in, const int* in_sizes, int n_in, void* d_out, int out_size, void* d_ws, size_t ws_size, hipStream_t stream) {
    static int grid = 0;
    if (grid == 0) {
        if (n_in != 19 || ws_size < WS_END || (size_t)out_size != OUT_END) { fprintf(stderr, "kernel_launch: unexpected sizes n_in %d ws %zu out %d\n", n_in, ws_size, out_size); grid = -1; return; }
        int dev = 0, cus = 0, per_cu = 0;
        hipGetDevice(&dev); hipDeviceGetAttribute(&cus, hipDeviceAttributeMultiprocessorCount, dev);
        if (hipFuncSetAttribute((const void*)fwd_kernel, hipFuncAttributeMaxDynamicSharedMemorySize, LDS_BYTES) != hipSuccess) { fprintf(stderr, "kernel_launch: hipFuncSetAttribute failed\n"); grid = -1; return; }
        if (hipOccupancyMaxActiveBlocksPerMultiprocessor(&per_cu, (const void*)fwd_kernel, 512, LDS_BYTES) != hipSuccess || per_cu < 1) { fprintf(stderr, "kernel_launch: occupancy query says %d\n", per_cu); per_cu = 1; }
        (void)hipGetLastError();
        grid = cus * per_cu;
    }
    if (grid < 0) return;
    Args a{};
    for (int i = 0; i < 19; ++i) a.in[i] = (const float*)d_in[i];
    a.out = (float*)d_out; a.ws = (unsigned char*)d_ws;
#if N_LAUNCH_MODE == 1
    if (hipMemsetAsync((char*)d_ws + WS_BAR, 0, BAR_BYTES, stream) != hipSuccess) { fprintf(stderr, "kernel_launch: memset of the barrier words failed\n"); return; }
    a.ph_lo = 0; a.ph_hi = 9;
    void* kargs[] = {&a};
    hipError_t e = hipLaunchCooperativeKernel((const void*)fwd_kernel, dim3(grid), dim3(512), kargs, LDS_BYTES, stream);
    if (e != hipSuccess) fprintf(stderr, "cooperative launch failed: %s (grid %d)\n", hipGetErrorString(e), grid);
#else
    for (int p = 0; p < 9; ++p) { a.ph_lo = p; a.ph_hi = p + 1; hipLaunchKernelGGL(fwd_kernel, dim3(grid), dim3(512), LDS_BYTES, stream, a); }
#endif
}
```

```cpp
#include <hip/hip_runtime.h>
#include <hip/hip_cooperative_groups.h>
#include <cstdio>
#include <cstdint>
namespace cg = cooperative_groups;
namespace pg8 {
#define PG8_LAS __attribute__((address_space(3)))
typedef unsigned short bf16_t;
typedef short bf16x8 __attribute__((ext_vector_type(8)));
typedef float f32x4 __attribute__((ext_vector_type(4)));
typedef unsigned u32x4 __attribute__((ext_vector_type(4)));
constexpr int BM = 256, BK = 64, HALF = 128, HTB = HALF * BK * 2  , STAGE_BYTES = 8 * HTB, NXCD = 8, WGM = 4;

__host__ __device__ __forceinline__ int lds_byte(int r, int c) { const int st = (r >> 4) * 2 + (c >> 5), rr = r & 15, cc = c & 31, ob = rr * 64 + cc * 2; return st * 1024 + (ob ^ (((ob >> 9) & 1) << 5)); }
__host__ __device__ __forceinline__ void stage_rc(int b, int& R, int& C) { const int st = b / 1024, sb = b % 1024, swz = sb ^ (((sb >> 9) & 1) << 5); R = (st >> 1) * 16 + swz / 64; C = (st & 1) * 32 + (swz % 64) / 2; }
__host__ __device__ __forceinline__ int perm32(int rho) { const int n = rho >> 4, i = rho & 15; return 8 * (i >> 2) + 4 * n + (i & 3); }

struct Unit { int pm, pn; };
struct Gemm { const bf16_t* A; const bf16_t* Bt; int M, N, K; };

struct StaticOrder {
    int nM, nN, nwg, G, c;
    __host__ __device__ void init(int M, int N, int G_, int c_) { nM = M / BM; nN = N / BM; nwg = nM * nN; G = G_; c = c_; }
    __host__ __device__ bool next(int i, Unit& u) const {
        const long L = (long)i * G + c; if (L >= nwg) return false;
        int wgid = (int)L; { const int q = nwg / NXCD, r = nwg % NXCD, xcd = wgid % NXCD, off = wgid / NXCD; wgid = (xcd < r ? xcd * (q + 1) : r * (q + 1) + (xcd - r) * q) + off; }
        const int nig = WGM * nN, gid = wgid / nig, fm = gid * WGM, gsz = (nM - fm) < WGM ? (nM - fm) : WGM;
        u.pm = fm + ((wgid % nig) % gsz); u.pn = (wgid % nig) / gsz; return true;
    }
    __device__ __forceinline__ void a_ready(const Unit&) const {}
    __device__ __forceinline__ void done(const Unit&) const {}
};

typedef float cvt_f32x2_t __attribute__((ext_vector_type(2))); typedef __bf16 cvt_bf16x2_t __attribute__((ext_vector_type(2)));
__device__ __forceinline__ unsigned cvt_pk_bf16(float lo, float hi) { cvt_f32x2_t v = {lo, hi}; cvt_bf16x2_t b = __builtin_convertvector(v, cvt_bf16x2_t); return __builtin_bit_cast(unsigned, b); }
template <class Epi, class Sched, bool ALIGN_EPI = false, bool SP2 = false>
__device__ __forceinline__ void gemm_phase(PG8_LAS unsigned char* lds, const Gemm g, const Sched& S, const Epi& E) {
    const int tid = threadIdx.x, wid = __builtin_amdgcn_readfirstlane(tid >> 6), lane = tid & 63, wr = wid >> 2, wc = wid & 3, fr = lane & 15, fq = lane >> 4;
    const int K = g.K, nt = K / BK;
    unsigned voffA[2], voffB[2];
#pragma unroll
    for (int i = 0; i < 2; ++i) { int R, C; stage_rc(tid * 16 + i * 8192, R, C); const int Rb = Epi::PERM ? ((R & ~31) + perm32(R & 31)) : R;
        voffA[i] = (unsigned)(R * K + C) * 2u; voffB[i] = (unsigned)(Rb * K + C) * 2u; }
    const size_t kstep = (size_t)(BK * 2);
    const size_t hstep = (size_t)HALF * K * 2;
    const size_t tstep = 2 * hstep;
    const unsigned ldsw = (unsigned)wid * 1024u;
    const int aoff = lds_byte(wr * 64 + fr, fq * 8), boff = lds_byte(wc * 32 + fr, fq * 8);
#define PG8_SA(b, h) (((b) * 2 + (h)) * HTB)
#define PG8_SB(b, h) ((4 + (b) * 2 + (h)) * HTB)
#define PG8_STAGE(bufoff, gbase, voff) do { _Pragma("unroll") for (int _i = 0; _i < 2; ++_i) \
        __builtin_amdgcn_global_load_lds((const unsigned*)((const char*)(gbase) + (voff)[_i]), (PG8_LAS unsigned*)(lds + (bufoff) + ldsw + _i * 8192), 16, 0, 0); } while (0)
#define PG8_LDA(dst, b, h) do { _Pragma("unroll") for (int m = 0; m < 4; ++m) _Pragma("unroll") for (int k = 0; k < 2; ++k) dst[m][k] = *(const PG8_LAS bf16x8*)(lds + PG8_SA(b, h) + aoff + m * 2048 + k * 1024); } while (0)
#define PG8_LDB(dst, b, h) do { _Pragma("unroll") for (int n = 0; n < 2; ++n) _Pragma("unroll") for (int k = 0; k < 2; ++k) dst[n][k] = *(const PG8_LAS bf16x8*)(lds + PG8_SB(b, h) + boff + n * 2048 + k * 1024); } while (0)
#define PG8_MMA(ai, bj, At, Bt) do { __builtin_amdgcn_s_setprio(1); _Pragma("unroll") for (int m = 0; m < 4; ++m) _Pragma("unroll") for (int n = 0; n < 2; ++n) _Pragma("unroll") for (int k = 0; k < 2; ++k) \
        acc[ai][bj][m][n] = __builtin_amdgcn_mfma_f32_16x16x32_bf16(Bt[n][k], At[m][k], acc[ai][bj][m][n], 0, 0, 0); __builtin_amdgcn_s_setprio(0); } while (0)
#define PG8_WAIT_V(n) asm volatile("s_waitcnt vmcnt(" #n ")" ::: "memory")
#define PG8_WAIT_L(n) asm volatile("s_waitcnt lgkmcnt(" #n ")" ::: "memory")
#define PG8_BAR __builtin_amdgcn_s_barrier()
#define PG8_SCHED __builtin_amdgcn_sched_barrier(0)
    Unit cur, nxt; int ui = 0;
    if (!S.next(0, cur)) return;
    f32x4 acc[2][2][4][2];
#pragma unroll
    for (int a = 0; a < 2; ++a)
#pragma unroll
        for (int b = 0; b < 2; ++b)
#pragma unroll
            for (int m = 0; m < 4; ++m)
#pragma unroll
                for (int n = 0; n < 2; ++n) acc[a][b][m][n] = (f32x4){0.f, 0.f, 0.f, 0.f};
    bf16x8 At[4][2], B0[2][2], B1[2][2];
    const char* cA = (const char*)g.A + (size_t)cur.pm * tstep; const char* cB = (const char*)g.Bt + (size_t)cur.pn * tstep;
    S.a_ready(cur);
    if constexpr (SP2) {
        PG8_STAGE(PG8_SB(0, 0), cB, voffB); PG8_STAGE(PG8_SB(0, 1), cB + hstep, voffB); PG8_STAGE(PG8_SA(0, 0), cA, voffA); PG8_STAGE(PG8_SA(0, 1), cA + hstep, voffA);
        if (wr == 1) PG8_BAR;
        PG8_WAIT_V(2); PG8_BAR;
        PG8_STAGE(PG8_SB(1, 0), cB + kstep, voffB); PG8_STAGE(PG8_SA(1, 0), cA + kstep, voffA); PG8_STAGE(PG8_SB(1, 1), cB + hstep + kstep, voffB);
        PG8_WAIT_V(6); PG8_BAR;
    } else {
        PG8_STAGE(PG8_SB(0, 0), cB, voffB); PG8_STAGE(PG8_SA(0, 0), cA, voffA); PG8_STAGE(PG8_SB(0, 1), cB + hstep, voffB); PG8_STAGE(PG8_SA(0, 1), cA + hstep, voffA);
        if (wr == 1) PG8_BAR;
        PG8_WAIT_V(4); PG8_BAR;
        PG8_STAGE(PG8_SB(1, 0), cB + kstep, voffB); PG8_STAGE(PG8_SA(1, 0), cA + kstep, voffA); PG8_STAGE(PG8_SB(1, 1), cB + hstep + kstep, voffB);
        PG8_WAIT_V(6); PG8_BAR;
    }
    for (;;) {
        const bool has_next = S.next(ui + 1, nxt);
        const char* nA = has_next ? (const char*)g.A + (size_t)nxt.pm * tstep : cA; const char* nB = has_next ? (const char*)g.Bt + (size_t)nxt.pn * tstep : cB;
        for (int t = 0; t < nt; t += 2) {
            const bool last = (t == nt - 2);
            const char* a1 = cA + (size_t)(t + 1) * kstep;
            const char* a2 = last ? nA : cA + (size_t)(t + 2) * kstep; const char* b2 = last ? nB : cB + (size_t)(t + 2) * kstep;
            const char* a3 = a2 + kstep; const char* b3 = b2 + kstep;
            if (last && has_next) S.a_ready(nxt);
            if constexpr (SP2) {
            PG8_LDB(B0, 0, 0); PG8_LDB(B1, 0, 1); PG8_SCHED; PG8_LDA(At, 0, 0); PG8_STAGE(PG8_SA(1, 1), a1 + hstep, voffA);
            PG8_WAIT_V(8); PG8_WAIT_L(0); PG8_BAR; PG8_MMA(0, 0, At, B0); PG8_MMA(0, 1, At, B1); PG8_BAR; PG8_SCHED;
            PG8_LDA(At, 0, 1); PG8_STAGE(PG8_SB(0, 0), b2, voffB); PG8_STAGE(PG8_SB(0, 1), b2 + hstep, voffB); PG8_STAGE(PG8_SA(0, 0), a2, voffA);
            PG8_WAIT_V(8); PG8_WAIT_L(0); PG8_BAR; PG8_MMA(1, 0, At, B0); PG8_MMA(1, 1, At, B1); PG8_BAR; PG8_SCHED;
            PG8_LDB(B0, 1, 0); PG8_LDB(B1, 1, 1); PG8_SCHED; PG8_LDA(At, 1, 0); PG8_STAGE(PG8_SA(0, 1), a2 + hstep, voffA);
            PG8_WAIT_V(8); PG8_WAIT_L(0); PG8_BAR; PG8_MMA(0, 0, At, B0); PG8_MMA(0, 1, At, B1); PG8_BAR; PG8_SCHED;
            PG8_LDA(At, 1, 1); PG8_STAGE(PG8_SB(1, 0), b3, voffB); PG8_STAGE(PG8_SB(1, 1), b3 + hstep, voffB); PG8_STAGE(PG8_SA(1, 0), a3, voffA);
            PG8_WAIT_V(8); PG8_WAIT_L(0); PG8_BAR; PG8_MMA(1, 0, At, B0); PG8_MMA(1, 1, At, B1); PG8_BAR; PG8_SCHED;
            } else {
            PG8_LDB(B0, 0, 0); PG8_SCHED; PG8_LDA(At, 0, 0); PG8_STAGE(PG8_SA(1, 1), a1 + hstep, voffA);
            PG8_WAIT_L(8); PG8_BAR; PG8_WAIT_L(0); PG8_MMA(0, 0, At, B0); PG8_BAR; PG8_SCHED;
            PG8_LDB(B1, 0, 1); PG8_STAGE(PG8_SB(0, 0), b2, voffB);
            PG8_BAR; PG8_WAIT_L(0); PG8_MMA(0, 1, At, B1); PG8_BAR;
            PG8_LDA(At, 0, 1); PG8_STAGE(PG8_SA(0, 0), a2, voffA);
            PG8_BAR; PG8_WAIT_L(0); PG8_MMA(1, 0, At, B0); PG8_BAR; PG8_SCHED;
            PG8_STAGE(PG8_SB(0, 1), b2 + hstep, voffB);
            PG8_WAIT_V(6); PG8_BAR; PG8_MMA(1, 1, At, B1); PG8_BAR;
            PG8_LDB(B0, 1, 0); PG8_SCHED; PG8_LDA(At, 1, 0); PG8_STAGE(PG8_SA(0, 1), a2 + hstep, voffA);
            PG8_WAIT_L(8); PG8_BAR; PG8_WAIT_L(0); PG8_MMA(0, 0, At, B0); PG8_BAR; PG8_SCHED;
            PG8_LDB(B1, 1, 1); PG8_STAGE(PG8_SB(1, 0), b3, voffB);
            PG8_BAR; PG8_WAIT_L(0); PG8_MMA(0, 1, At, B1); PG8_BAR;
            PG8_LDA(At, 1, 1); PG8_STAGE(PG8_SA(1, 0), a3, voffA);
            PG8_BAR; PG8_WAIT_L(0); PG8_MMA(1, 0, At, B0); PG8_BAR; PG8_SCHED;
            PG8_STAGE(PG8_SB(1, 1), b3 + hstep, voffB);
            PG8_WAIT_V(6); PG8_BAR; PG8_MMA(1, 1, At, B1); PG8_BAR;
            }
        }
        if constexpr (ALIGN_EPI) { if (wr == 0) PG8_BAR; }
        if constexpr (!Epi::AFTER_DRAIN) { E(acc, cur, wr, wc, fr, fq); S.done(cur); }
        if (!has_next) break;
#pragma unroll
        for (int a = 0; a < 2; ++a)
#pragma unroll
            for (int b = 0; b < 2; ++b)
#pragma unroll
                for (int m = 0; m < 4; ++m)
#pragma unroll
                    for (int n = 0; n < 2; ++n) acc[a][b][m][n] = (f32x4){0.f, 0.f, 0.f, 0.f};
        cur = nxt; cA = nA; cB = nB; ++ui;
        if constexpr (ALIGN_EPI) { if (wr == 1) PG8_BAR; }
    }
    PG8_WAIT_V(0);
    if constexpr (!ALIGN_EPI) { if (wr == 0) PG8_BAR; }
    PG8_BAR;
    if constexpr (Epi::AFTER_DRAIN) { E.fused(acc, cur, wr, wc, fr, fq, lds, wid, lane); S.done(cur); }
#undef PG8_SA
#undef PG8_SB
#undef PG8_STAGE
#undef PG8_LDA
#undef PG8_LDB
#undef PG8_MMA
#undef PG8_WAIT_V
#undef PG8_WAIT_L
#undef PG8_BAR
#undef PG8_SCHED
}
}
using pg8::bf16_t; using pg8::f32x4; using pg8::bf16x8; using pg8::u32x4; using pg8::Unit; using pg8::cvt_pk_bf16;
#define LAS __attribute__((address_space(3)))
typedef unsigned u32x2 __attribute__((ext_vector_type(2)));
typedef float f32x2 __attribute__((ext_vector_type(2)));
constexpr int DM = 1024, NBP = 32, SEQ = 2048, NMETA = 16, LP = SEQ + NMETA, NBS = 32, DSEQ = 64;
constexpr int MP = NBP * LP, MS = NBS * DSEQ, M = MP + MS;
constexpr int FF = 2816, NUP = 2 * FF, NIN = 3328, DIN = 3088;
constexpr int NH = 4, DK = 64, DV = 128;
constexpr float EPS = 1e-6f;
static_assert(M % 256 == 0, "M");
constexpr size_t OUT_YP = 0, OUT_YS = (size_t)NBP * SEQ * DM, OUT_SP = OUT_YS + (size_t)MS * DM, OUT_CP = OUT_SP + (size_t)NBP * NH * DK * DV,
                 OUT_SS = OUT_CP + (size_t)NBP * 2 * 512, OUT_CS = OUT_SS + (size_t)NBS * NH * DK * DV, OUT_END = OUT_CS + (size_t)NBS * 2 * 512;
constexpr size_t MiB = 1u << 20;
constexpr size_t WS_SS = 0, SS_STRIDE = 512 * 1024;
constexpr size_t WS_WUP1 = 2 * MiB, WS_WDN1 = 13 * MiB, WS_WIN = 19 * MiB, WS_WOUT = 26 * MiB, WS_WUP2 = 28 * MiB, WS_WDN2 = 39 * MiB;
constexpr size_t WS_BAR = 46 * MiB, BAR_BYTES = 16384;
constexpr size_t WS_XB = 48 * MiB;
constexpr size_t WS_ACT = 184 * MiB;
constexpr size_t WS_QK = 184 * MiB, WS_U = 450 * MiB, WS_LA = 517 * MiB;
constexpr size_t WS_MIX = 584 * MiB, WS_DUMMY = 718 * MiB, WS_END = 719 * MiB;
static_assert(WS_ACT + (size_t)M * FF * 2 <= WS_MIX && WS_LA + (size_t)M * 256 * 4 <= WS_MIX && WS_U + (size_t)M * 512 * 2 <= WS_LA && WS_QK + (size_t)M * 2048 * 2 <= WS_U, "ws map");
static_assert(WS_XB + (size_t)M * DM * 2 <= WS_ACT && WS_MIX + (size_t)M * DM * 2 <= WS_END && WS_WDN2 + (size_t)DM * FF * 2 <= WS_XB, "ws map");

__device__ __forceinline__ const float* xin_row(const float* xp, const float* meta, const float* xs, int R) {
    if (R < MP) { const int b = R / LP, t = R - b * LP; return t < NMETA ? meta + (size_t)t * DM : xp + ((size_t)b * SEQ + (t - NMETA)) * DM; }
    return xs + (size_t)(R - MP) * DM;
}
__device__ __forceinline__ float* yout_row(float* out, int R) {
    if (R < MP) { const int b = R / LP, t = R - b * LP; return t < NMETA ? nullptr : out + ((size_t)b * SEQ + (t - NMETA)) * DM; }
    return out + OUT_YS + (size_t)(R - MP) * DM;
}
__device__ __forceinline__ float bf_lo(unsigned w) { return __uint_as_float(w << 16); }
__device__ __forceinline__ float bf_hi(unsigned w) { return __uint_as_float(w & 0xffff0000u); }
__device__ __forceinline__ float silu_f(float g) { return g * __builtin_amdgcn_rcpf(1.f + __expf(-g)); }
__device__ __forceinline__ float wave_sum(float v) {
#pragma unroll
    for (int o = 1; o < 64; o <<= 1) v += __shfl_xor(v, o);
    return v;
}

struct EpiUp {
    static constexpr bool PERM = true, AFTER_DRAIN = false;
    bf16_t* O; const float* ss;
    __device__ __forceinline__ void operator()(const f32x4 (&acc)[2][2][4][2], const Unit& u, int wr, int wc, int fr, int fq) const {
        const int row0 = u.pm * 256 + wr * 64 + fr, col0 = u.pn * 128 + wc * 32 + 8 * fq;
#pragma unroll
        for (int ai = 0; ai < 2; ++ai)
#pragma unroll
            for (int m = 0; m < 4; ++m) {
                const int row = row0 + ai * 128 + m * 16;
                const float rs = rsqrtf(ss[row] * (1.0f / DM) + EPS), nl = rs * -1.4426950408889634f, rs2 = rs * rs;
                float o[8];
#pragma unroll
                for (int n = 0; n < 2; ++n) { const f32x4 gv = acc[ai][0][m][n], uv = acc[ai][1][m][n]; const f32x4 t = gv * nl, gu = gv * uv; f32x4 r;
#pragma unroll
                    for (int j = 0; j < 4; ++j) r[j] = __builtin_amdgcn_rcpf(1.0f + __builtin_amdgcn_exp2f(t[j]));
                    const f32x4 ov = gu * (r * rs2);
#pragma unroll
                    for (int j = 0; j < 4; ++j) o[4 * n + j] = ov[j]; }
                u32x4 w; w.x = cvt_pk_bf16(o[0], o[1]); w.y = cvt_pk_bf16(o[2], o[3]); w.z = cvt_pk_bf16(o[4], o[5]); w.w = cvt_pk_bf16(o[6], o[7]);
                *(u32x4*)(O + (size_t)row * FF + col0) = w;
            }
    }
};
template <int MODE> struct EpiRes {
    static constexpr bool PERM = true, AFTER_DRAIN = false;
    const float *xp, *meta, *xs; bf16_t* XB; float* out; float* ss;
    __device__ __forceinline__ void operator()(const f32x4 (&acc)[2][2][4][2], const Unit& u, int wr, int wc, int fr, int fq) const {
        const float alpha = (MODE == 1) ? 1.0f : 0.5f;
#pragma unroll
        for (int ai = 0; ai < 2; ++ai)
#pragma unroll
            for (int m = 0; m < 4; ++m) {
                const int row = u.pm * 256 + ai * 128 + wr * 64 + m * 16 + fr;
                const float* xr = nullptr;
                if (MODE == 0) xr = xin_row(xp, meta, xs, row);
                float sq = 0.f;
#pragma unroll
                for (int bj = 0; bj < 2; ++bj) {
                    const int col = u.pn * 256 + bj * 128 + wc * 32 + 8 * fq;
                    f32x4 b0, b1;
                    if (MODE == 0) { b0 = *(const f32x4*)(xr + col); b1 = *(const f32x4*)(xr + col + 4); }
                    else { const u32x4 w = *(const u32x4*)(XB + (size_t)row * DM + col);
                        b0 = (f32x4){bf_lo(w.x), bf_hi(w.x), bf_lo(w.y), bf_hi(w.y)}; b1 = (f32x4){bf_lo(w.z), bf_hi(w.z), bf_lo(w.w), bf_hi(w.w)}; }
                    const f32x4 v0 = b0 + acc[ai][bj][m][0] * alpha, v1 = b1 + acc[ai][bj][m][1] * alpha;
                    sq += (v0[0] * v0[0] + v0[1] * v0[1]) + (v0[2] * v0[2] + v0[3] * v0[3]) + (v1[0] * v1[0] + v1[1] * v1[1]) + (v1[2] * v1[2] + v1[3] * v1[3]);
                    { u32x4 w; w.x = cvt_pk_bf16(v0[0], v0[1]); w.y = cvt_pk_bf16(v0[2], v0[3]); w.z = cvt_pk_bf16(v1[0], v1[1]); w.w = cvt_pk_bf16(v1[2], v1[3]);
                        *(u32x4*)(XB + (size_t)row * DM + col) = w; }
                }
                sq += __shfl_xor(sq, 16); sq += __shfl_xor(sq, 32);
                if (fq == 0) unsafeAtomicAdd(ss + row, sq);
            }
    }
};
__device__ __forceinline__ float log_sigmoid_f(float z) { const float e = __expf(-fabsf(z)); return fminf(z, 0.f) - __logf(1.f + e); }
struct EpiWin {
    static constexpr bool PERM = true, AFTER_DRAIN = false;
    bf16_t* QK; bf16_t* U; float* LA; const float* ss; const float* b_a;
    __device__ __forceinline__ void operator()(const f32x4 (&acc)[2][2][4][2], const Unit& u, int wr, int wc, int fr, int fq) const {
        const int pn = u.pn;
#pragma unroll
        for (int ai = 0; ai < 2; ++ai)
#pragma unroll
            for (int m = 0; m < 4; ++m) {
                const int row = u.pm * 256 + ai * 128 + wr * 64 + m * 16 + fr;
                const float rs = rsqrtf(ss[row] * (1.0f / DM) + EPS);
                if (pn < 8) {
                    const float sc = (pn == 0) ? rs * 0.125f : rs;
#pragma unroll
                    for (int bj = 0; bj < 2; ++bj) { const f32x4 v0 = acc[ai][bj][m][0] * sc, v1 = acc[ai][bj][m][1] * sc;
                        u32x4 w; w.x = cvt_pk_bf16(v0[0], v0[1]); w.y = cvt_pk_bf16(v0[2], v0[3]); w.z = cvt_pk_bf16(v1[0], v1[1]); w.w = cvt_pk_bf16(v1[2], v1[3]);
                        *(u32x4*)(QK + (size_t)row * 2048 + pn * 256 + bj * 128 + wc * 32 + 8 * fq) = w; }
                } else if (pn < 12) {
                    const float r2 = rs * rs;
                    const f32x4 v0 = acc[ai][0][m][0] * acc[ai][1][m][0] * r2, v1 = acc[ai][0][m][1] * acc[ai][1][m][1] * r2;
                    u32x4 w; w.x = cvt_pk_bf16(v0[0], v0[1]); w.y = cvt_pk_bf16(v0[2], v0[3]); w.z = cvt_pk_bf16(v1[0], v1[1]); w.w = cvt_pk_bf16(v1[2], v1[3]);
                    *(u32x4*)(U + (size_t)row * 512 + (pn - 8) * 128 + wc * 32 + 8 * fq) = w;
                } else {
#pragma unroll
                    for (int bj = 0; bj < 2; ++bj)
#pragma unroll
                        for (int n = 0; n < 2; ++n) { const int c = bj * 128 + wc * 32 + 8 * fq + 4 * n; const f32x4 bb = *(const f32x4*)(b_a + c); f32x4 o;
#pragma unroll
                            for (int j = 0; j < 4; ++j) o[j] = log_sigmoid_f(acc[ai][bj][m][n][j] * rs + bb[j]) * (1.0f / 16.0f);
                            *(f32x4*)(LA + (size_t)row * 256 + c) = o; }
                }
            }
    }
};
__device__ __forceinline__ void tr_item(const float* W, int ldw, int src_col0, const float* gain, bf16_t* WT, int K, int dst_row0, int k0, LAS float* scr, int lane) {
#pragma unroll 8
    for (int i = 0; i < 32; ++i) { const int kk = 2 * i + (lane >> 5); float w = W[(size_t)(k0 + kk) * ldw + src_col0 + (lane & 31)]; if (gain) w *= gain[k0 + kk]; scr[kk * 33 + (lane & 31)] = w; }
    asm volatile("s_waitcnt lgkmcnt(0)" ::: "memory");
    const int c = lane & 7;
#pragma unroll
    for (int j = 0; j < 4; ++j) { const int n = (lane >> 3) + 8 * j; const LAS float* s = scr + (8 * c) * 33 + n;
        u32x4 o; o.x = cvt_pk_bf16(s[0 * 33], s[1 * 33]); o.y = cvt_pk_bf16(s[2 * 33], s[3 * 33]); o.z = cvt_pk_bf16(s[4 * 33], s[5 * 33]); o.w = cvt_pk_bf16(s[6 * 33], s[7 * 33]);
        *(u32x4*)(WT + (size_t)(dst_row0 + n) * K + k0 + 8 * c) = o; }
    asm volatile("s_waitcnt lgkmcnt(0)" ::: "memory");
}
__device__ __forceinline__ int up_src_col(int n) { const int pn = n >> 8, within = n & 255; return (within >> 7) * FF + 128 * pn + (within & 127); }
__device__ __forceinline__ int win_src_col(int n) {
    if (n < 1536) return n;
    if (n < 2048) return n + 16;
    const int j = (n - 2048) >> 8, within = (n - 2048) & 255;
    return ((within >> 7) ? 2576 : 2064) + 128 * j + (within & 127);
}
struct P0Args { const float *xp, *xs, *meta, *n1, *wu1, *wd1, *n2, *win, *wa2, *wout, *n3, *wu2, *wd2; unsigned char* ws; };
__device__ __forceinline__ void p0_prologue(const P0Args& a, LAS unsigned char* lds, int gw, int NGW, int wave, int lane) {
    LAS float* scr = (LAS float*)(lds + wave * 8704);
    constexpr int I_UP = (DM / 64) * (NUP / 32), I_DN = (FF / 64) * (DM / 32), I_IN = (DM / 64) * (3072 / 32), I_OUT = (DM / 64) * (DM / 32);
    constexpr int NITEMS = 2 * I_UP + 2 * I_DN + I_IN + I_OUT;
    bf16_t* WUP1 = (bf16_t*)(a.ws + WS_WUP1); bf16_t* WDN1 = (bf16_t*)(a.ws + WS_WDN1); bf16_t* WIN = (bf16_t*)(a.ws + WS_WIN);
    bf16_t* WOUT = (bf16_t*)(a.ws + WS_WOUT); bf16_t* WUP2 = (bf16_t*)(a.ws + WS_WUP2); bf16_t* WDN2 = (bf16_t*)(a.ws + WS_WDN2);
    for (int it = gw; it < NITEMS; it += NGW) {
        int r = it;
        if (r < 2 * I_UP) { const bool second = r >= I_UP; if (second) r -= I_UP; const int nblk = NUP / 32, kb = r / nblk, nb = r % nblk;
            tr_item(second ? a.wu2 : a.wu1, NUP, up_src_col(32 * nb), second ? a.n3 : a.n1, second ? WUP2 : WUP1, DM, 32 * nb, 64 * kb, scr, lane); continue; }
        r -= 2 * I_UP;
        if (r < 2 * I_DN) { const bool second = r >= I_DN; if (second) r -= I_DN; const int nblk = DM / 32, kb = r / nblk, nb = r % nblk;
            tr_item(second ? a.wd2 : a.wd1, DM, 32 * nb, nullptr, second ? WDN2 : WDN1, FF, 32 * nb, 64 * kb, scr, lane); continue; }
        r -= 2 * I_DN;
        if (r < I_IN) { const int nblk = 3072 / 32, kb = r / nblk, nb = r % nblk;
            tr_item(a.win, DIN, win_src_col(32 * nb), a.n2, WIN, DM, 32 * nb, 64 * kb, scr, lane); continue; }
        r -= I_IN;
        { const int nblk = DM / 32, kb = r / nblk, nb = r % nblk; tr_item(a.wout, DM, 32 * nb, nullptr, WOUT, DM, 32 * nb, 64 * kb, scr, lane); }
    }
    for (int e = gw * 64 + lane; e < 256 * DM; e += NGW * 64) { const int n = e >> 10, k = e & 1023; const float* wr_ = a.win + (size_t)k * DIN + 1536; float s = 0.f;
#pragma unroll
        for (int r = 0; r < 16; ++r) s += wr_[r] * a.wa2[r * 256 + n];
        s *= a.n2[k]; const unsigned short b = (unsigned short)(cvt_pk_bf16(s, 0.f) & 0xffffu); WIN[(size_t)(3072 + n) * DM + k] = b; }
    bf16_t* XB = (bf16_t*)(a.ws + WS_XB); float* ss0 = (float*)(a.ws + WS_SS);
    for (int R = gw; R < M; R += NGW) {
        const f32x4* xr = (const f32x4*)xin_row(a.xp, a.meta, a.xs, R) + lane; f32x4 v[4]; float s = 0.f;
#pragma unroll
        for (int j = 0; j < 4; ++j) { v[j] = xr[64 * j]; s += (v[j][0] * v[j][0] + v[j][1] * v[j][1]) + (v[j][2] * v[j][2] + v[j][3] * v[j][3]); }
        s = wave_sum(s);
        u32x2* o8 = (u32x2*)(XB + (size_t)R * DM) + lane;
#pragma unroll
        for (int j = 0; j < 4; ++j) { u32x2 w; w.x = cvt_pk_bf16(v[j][0], v[j][1]); w.y = cvt_pk_bf16(v[j][2], v[j][3]); o8[64 * j] = w; }
        if (lane == 0) { ss0[R] = s; ss0[R + SS_STRIDE / 4] = 0.f; ss0[R + 2 * (SS_STRIDE / 4)] = 0.f; ss0[R + 3 * (SS_STRIDE / 4)] = 0.f; }
    }
}

struct GlaArgs { const bf16_t* QK; const float* LA; const bf16_t* U; bf16_t* MIX; const float* state_in; const float* cache_conv; const float* g_head; const float* w_conv; float* out; bf16_t* dummy; };
constexpr int RS = 144;
constexpr int VRS = 272;
constexpr int L_G = 0, L_VR = 16384, L_QT = 0, L_ATT = 9216, L_KT = 18432, L_KTT = 27648, L_G2 = 36864, L_EGL = 53248, L_SSQ = 53504, L_VT = 54016, L_ST = 72448, ST_BYTES = 128 * RS, L_SEG = 109312, L_QR = 111360, L_KR = 119552;
__device__ __forceinline__ bf16x8 ldf(LAS const unsigned char* base, int row, int ks, int fq) { return *(const LAS bf16x8*)(base + row * RS + ks * 64 + fq * 16); }
__device__ __forceinline__ void gla_unit(const GlaArgs& a, LAS unsigned char* lds, int unit, int tid, int wave, int lane) {
    const bool samp = unit >= 128; const int s = (unit & 127) >> 2, h = unit & 3;
    const int L = samp ? DSEQ : LP; const int row0 = samp ? MP + s * DSEQ : s * LP;
    const int fr = lane & 15, fq = lane >> 4, rb = wave & 3, vh = wave >> 2;
    LAS float* G = (LAS float*)(lds + L_G); LAS float* G2 = (LAS float*)(lds + L_G2); LAS float* EGL = (LAS float*)(lds + L_EGL); LAS float* SSQ = (LAS float*)(lds + L_SSQ);
    f32x4 Sacc[4], gh[4];
    const size_t sbase = (size_t)(s * NH + h) * DK * DV;
#pragma unroll
    for (int vt = 0; vt < 4; ++vt) { const int v = 64 * vh + 16 * vt + fr;
#pragma unroll
        for (int jj = 0; jj < 4; ++jj) Sacc[vt][jj] = samp ? a.state_in[sbase + (size_t)(16 * rb + 4 * fq + jj) * DV + v] : 0.f;
        u32x2 w; w.x = cvt_pk_bf16(Sacc[vt][0], Sacc[vt][1]); w.y = cvt_pk_bf16(Sacc[vt][2], Sacc[vt][3]);
        *(LAS u32x2*)(lds + L_ST + v * RS + (16 * rb + 4 * fq) * 2) = w;
        gh[vt] = *(const f32x4*)(a.g_head + 64 * vh + 16 * vt + 4 * fq); }
    const int lt = tid >> 3, ld0 = (tid & 7) * 8;
    const int vt_t = tid >> 4, vc = tid & 15;
    u32x4 pq, pk, pv0, pv1; f32x4 pl0, pl1; u32x2 rg0, rg1, rg2, rg3;
    const u32x4 z4 = (u32x4){0u, 0u, 0u, 0u}; const f32x4 zf = (f32x4){0.f, 0.f, 0.f, 0.f};
#define GL16(dst, ptr) dst = *(const u32x4*)(ptr)
#define GL16F(dst, ptr) dst = *(const f32x4*)(ptr)
#define GL8(dst, ptr) dst = *(const u32x2*)(ptr)
#define GLA_ISSUE_P(T0) do { \
        const int tq_ = min((T0) + lt, L - 1), ta_ = min((T0) + vt_t, L - 1), tb_ = min((T0) + vt_t + 32, L - 1); \
        const bf16_t* p_ = a.QK + (size_t)(row0 + tq_) * 2048 + h * 64 + ld0; GL16(pq, p_); GL16(pk, p_ + 256); \
        GL16(pv0, a.QK + (size_t)(row0 + ta_) * 2048 + 512 + h * 128 + vc * 8); GL16F(pl0, a.LA + (size_t)(row0 + ta_) * 256 + h * 64 + vc * 4); \
        GL16(pv1, a.QK + (size_t)(row0 + tb_) * 2048 + 512 + h * 128 + vc * 8); GL16F(pl1, a.LA + (size_t)(row0 + tb_) * 256 + h * 64 + vc * 4); } while (0)
#define GLA_ISSUE_R(T0) do { const bf16_t* r_ = a.QK + (size_t)(row0 + min((T0) + 16 * rb + fr, L - 1)) * 2048 + 1024 + h * 128 + 64 * vh + 4 * fq; \
        GL8(rg0, r_); GL8(rg1, r_ + 16); GL8(rg2, r_ + 32); GL8(rg3, r_ + 48); } while (0)
#define GLA_STAGE(T0) do { \
        if ((T0) + lt >= L) { pq = z4; pk = z4; } \
        if ((T0) + vt_t >= L) { pv0 = z4; pl0 = zf; } \
        if ((T0) + vt_t + 32 >= L) { pv1 = z4; pl1 = zf; } \
        *(LAS f32x4*)(G + vt_t * 64 + vc * 4) = pl0; *(LAS f32x4*)(G + (vt_t + 32) * 64 + vc * 4) = pl1; \
        *(LAS u32x4*)(lds + L_VR + vt_t * VRS + vc * 16) = pv0; *(LAS u32x4*)(lds + L_VR + (vt_t + 32) * VRS + vc * 16) = pv1; \
        *(LAS u32x4*)(lds + L_QR + tid * 16) = pq; *(LAS u32x4*)(lds + L_KR + tid * 16) = pk; } while (0)
    GLA_ISSUE_P(0); GLA_STAGE(0);
    const int nch = (L + 63) >> 6;
    for (int c = 0; c < nch; ++c) {
        const int t0 = c * 64, cur = c & 1;
        __syncthreads();
        GLA_ISSUE_R(t0); GLA_ISSUE_P(t0 + 64);
        { const int d = tid & 63; float c8[8];
#pragma unroll
            for (int e = 0; e < 8; ++e) c8[e] = G[(8 * wave + e) * 64 + d];
#pragma unroll
            for (int e = 1; e < 8; ++e) c8[e] += c8[e - 1];
#pragma unroll
            for (int e = 0; e < 8; ++e) G2[(8 * wave + e) * 64 + d] = c8[e];
            ((LAS float*)(lds + L_SEG))[wave * 64 + d] = c8[7]; }
        { const int v = tid & 127, tg = tid >> 7; unsigned w[8];
#pragma unroll
            for (int e = 0; e < 8; ++e) { const unsigned lo = *(const LAS unsigned short*)(lds + L_VR + (16 * tg + 2 * e) * VRS + v * 2), hi = *(const LAS unsigned short*)(lds + L_VR + (16 * tg + 2 * e + 1) * VRS + v * 2); w[e] = lo | (hi << 16); }
            *(LAS u32x4*)(lds + L_VT + v * RS + tg * 32) = (u32x4){w[0], w[1], w[2], w[3]}; *(LAS u32x4*)(lds + L_VT + v * RS + tg * 32 + 16) = (u32x4){w[4], w[5], w[6], w[7]}; }
        __syncthreads();
        { f32x4 g0 = *(const LAS f32x4*)(G2 + lt * 64 + ld0), g1 = *(const LAS f32x4*)(G2 + lt * 64 + ld0 + 4);
            { const LAS float* SEG = (const LAS float*)(lds + L_SEG) + ld0; const int seg = lt >> 3; f32x4 t0 = zf, t1 = zf;
#pragma unroll
                for (int s8 = 0; s8 < 8; ++s8) { const f32x4 a0 = *(const LAS f32x4*)(SEG + s8 * 64), a1 = *(const LAS f32x4*)(SEG + s8 * 64 + 4);
                    if (s8 < seg) { g0 += a0; g1 += a1; } t0 += a0; t1 += a1; }
                if (lt == 63) { f32x4 e0, e1;
#pragma unroll
                    for (int j = 0; j < 4; ++j) { e0[j] = __expf(t0[j]); e1[j] = __expf(t1[j]); }
                    *(LAS f32x4*)(EGL + ld0) = e0; *(LAS f32x4*)(EGL + ld0 + 4) = e1; } }
            const float gq[8] = {g0[0], g0[1], g0[2], g0[3], g1[0], g1[1], g1[2], g1[3]};
            const u32x4 rq = *(const LAS u32x4*)(lds + L_QR + tid * 16), rk = *(const LAS u32x4*)(lds + L_KR + tid * 16);
            const float qv[8] = {bf_lo(rq.x), bf_hi(rq.x), bf_lo(rq.y), bf_hi(rq.y), bf_lo(rq.z), bf_hi(rq.z), bf_lo(rq.w), bf_hi(rq.w)};
            const float kv[8] = {bf_lo(rk.x), bf_hi(rk.x), bf_lo(rk.y), bf_hi(rk.y), bf_lo(rk.z), bf_hi(rk.z), bf_lo(rk.w), bf_hi(rk.w)};
            float qt[8], kt[8];
#pragma unroll
            for (int e = 0; e < 8; ++e) { qt[e] = qv[e] * __expf(gq[e]); kt[e] = kv[e] * __expf(-gq[e]); }
            *(LAS u32x4*)(lds + L_QT + lt * RS + ld0 * 2) = (u32x4){cvt_pk_bf16(qt[0], qt[1]), cvt_pk_bf16(qt[2], qt[3]), cvt_pk_bf16(qt[4], qt[5]), cvt_pk_bf16(qt[6], qt[7])};
            *(LAS u32x4*)(lds + L_KT + lt * RS + ld0 * 2) = (u32x4){cvt_pk_bf16(kt[0], kt[1]), cvt_pk_bf16(kt[2], kt[3]), cvt_pk_bf16(kt[4], kt[5]), cvt_pk_bf16(kt[6], kt[7])}; }
        const int orow = t0 + 16 * rb + fr; const bool ovalid = orow < L;
        __syncthreads();
        { const int d = tid & 63; unsigned w[4];
#pragma unroll
            for (int e = 0; e < 4; ++e) { const unsigned lo = *(const LAS unsigned short*)(lds + L_KT + (8 * wave + 2 * e) * RS + d * 2), hi = *(const LAS unsigned short*)(lds + L_KT + (8 * wave + 2 * e + 1) * RS + d * 2); w[e] = lo | (hi << 16); }
            *(LAS u32x4*)(lds + L_KTT + d * RS + wave * 16) = (u32x4){w[0], w[1], w[2], w[3]}; }
#pragma unroll
        for (int tt = 0; tt < 2; ++tt) { const int tile = 2 * wave + tt, ib = tile >> 2, jb = tile & 3; f32x4 acc = zf;
            if (jb <= ib) {
#pragma unroll
                for (int ks = 0; ks < 2; ++ks) acc = __builtin_amdgcn_mfma_f32_16x16x32_bf16(ldf(lds + L_KT, 16 * jb + fr, ks, fq), ldf(lds + L_QT, 16 * ib + fr, ks, fq), acc, 0, 0, 0);
                if (jb == ib) {
#pragma unroll
                    for (int jj = 0; jj < 4; ++jj) if (4 * fq + jj > fr) acc[jj] = 0.f; } }
            u32x2 w; w.x = cvt_pk_bf16(acc[0], acc[1]); w.y = cvt_pk_bf16(acc[2], acc[3]);
            *(LAS u32x2*)(lds + L_ATT + (16 * ib + fr) * RS + (16 * jb + 4 * fq) * 2) = w; }
        __syncthreads();
        f32x4 o[4]; float sq = 0.f;
        { const bf16x8 ya0 = ldf(lds + L_ATT, 16 * rb + fr, 0, fq), ya1 = ldf(lds + L_ATT, 16 * rb + fr, 1, fq), ya2 = ldf(lds + L_QT, 16 * rb + fr, 0, fq), ya3 = ldf(lds + L_QT, 16 * rb + fr, 1, fq);
            const bf16x8 kx0 = ldf(lds + L_KTT, 16 * rb + fr, 0, fq), kx1 = ldf(lds + L_KTT, 16 * rb + fr, 1, fq);
            const f32x4 eg = *(const LAS f32x4*)(EGL + 16 * rb + 4 * fq);
            LAS const unsigned char* STc = lds + L_ST + cur * ST_BYTES; LAS unsigned char* STn = lds + L_ST + (cur ^ 1) * ST_BYTES;
#pragma unroll
            for (int vt = 0; vt < 4; ++vt) { const int v0 = 64 * vh + 16 * vt;
                const bf16x8 vx0 = ldf(lds + L_VT, v0 + fr, 0, fq), vx1 = ldf(lds + L_VT, v0 + fr, 1, fq), sx0 = ldf(STc, v0 + fr, 0, fq), sx1 = ldf(STc, v0 + fr, 1, fq);
                f32x4 acc = zf;
                acc = __builtin_amdgcn_mfma_f32_16x16x32_bf16(vx0, ya0, acc, 0, 0, 0); acc = __builtin_amdgcn_mfma_f32_16x16x32_bf16(vx1, ya1, acc, 0, 0, 0);
                acc = __builtin_amdgcn_mfma_f32_16x16x32_bf16(sx0, ya2, acc, 0, 0, 0); acc = __builtin_amdgcn_mfma_f32_16x16x32_bf16(sx1, ya3, acc, 0, 0, 0);
                o[vt] = acc; sq += (acc[0] * acc[0] + acc[1] * acc[1]) + (acc[2] * acc[2] + acc[3] * acc[3]);
                f32x4 sa = Sacc[vt];
                sa = __builtin_amdgcn_mfma_f32_16x16x32_bf16(kx0, vx0, sa, 0, 0, 0); sa = __builtin_amdgcn_mfma_f32_16x16x32_bf16(kx1, vx1, sa, 0, 0, 0);
                sa = sa * eg; Sacc[vt] = sa;
                u32x2 w; w.x = cvt_pk_bf16(sa[0], sa[1]); w.y = cvt_pk_bf16(sa[2], sa[3]);
                *(LAS u32x2*)(STn + (v0 + fr) * RS + (16 * rb + 4 * fq) * 2) = w; } }
        sq += __shfl_xor(sq, 16); sq += __shfl_xor(sq, 32);
        if (fq == 0) SSQ[vh * 64 + 16 * rb + fr] = sq;
        __syncthreads();
        { const float rs = rsqrtf((SSQ[16 * rb + fr] + SSQ[64 + 16 * rb + fr]) * (1.0f / DV) + EPS);
            GLA_STAGE(t0 + 64);
            const u32x2 rg[4] = {rg0, rg1, rg2, rg3};
            bf16_t* mrow = ovalid ? a.MIX + (size_t)(row0 + orow) * DM + h * 128 + 64 * vh + 4 * fq : a.dummy + tid * 64;
            {
#pragma unroll
                for (int vt = 0; vt < 4; ++vt) { const float r0 = bf_lo(rg[vt].x), r1 = bf_hi(rg[vt].x), r2 = bf_lo(rg[vt].y), r3 = bf_hi(rg[vt].y);
                    u32x2 w; w.x = cvt_pk_bf16(o[vt][0] * rs * gh[vt][0] * silu_f(r0), o[vt][1] * rs * gh[vt][1] * silu_f(r1)); w.y = cvt_pk_bf16(o[vt][2] * rs * gh[vt][2] * silu_f(r2), o[vt][3] * rs * gh[vt][3] * silu_f(r3));
                    *(u32x2*)(mrow + 16 * vt) = w; } } }
    }
#undef GLA_ISSUE_P
#undef GLA_ISSUE_R
#undef GLA_STAGE
#undef GL16
#undef GL16F
#undef GL8
    float* sout = a.out + (samp ? OUT_SS : OUT_SP) + sbase;
#pragma unroll
    for (int vt = 0; vt < 4; ++vt)
#pragma unroll
        for (int jj = 0; jj < 4; ++jj) sout[(size_t)(16 * rb + 4 * fq + jj) * DV + 64 * vh + 16 * vt + fr] = Sacc[vt][jj];
    __syncthreads();
}
__device__ __forceinline__ void conv_pass(const GlaArgs& a, int gtid, int nthreads) {
    for (int item = gtid; item < M * 64; item += nthreads) {
        const int R = item >> 6, c8 = (item & 63) * 8;
        int b, t, L; bool samp = R >= MP;
        if (!samp) { b = R / LP; t = R - b * LP; L = LP; } else { const int r2 = R - MP; b = r2 >> 6; t = r2 & 63; L = DSEQ; }
        float u2[8], u1[8], u0[8], bb[8];
        { const u32x4 w = *(const u32x4*)(a.U + (size_t)R * 512 + c8); u2[0] = bf_lo(w.x); u2[1] = bf_hi(w.x); u2[2] = bf_lo(w.y); u2[3] = bf_hi(w.y); u2[4] = bf_lo(w.z); u2[5] = bf_hi(w.z); u2[6] = bf_lo(w.w); u2[7] = bf_hi(w.w); }
        if (t >= 1) { const u32x4 w = *(const u32x4*)(a.U + (size_t)(R - 1) * 512 + c8); u1[0] = bf_lo(w.x); u1[1] = bf_hi(w.x); u1[2] = bf_lo(w.y); u1[3] = bf_hi(w.y); u1[4] = bf_lo(w.z); u1[5] = bf_hi(w.z); u1[6] = bf_lo(w.w); u1[7] = bf_hi(w.w); }
        else {
#pragma unroll
            for (int j = 0; j < 8; ++j) u1[j] = samp ? a.cache_conv[((size_t)b * 2 + 1) * 512 + c8 + j] : 0.f; }
        if (t >= 2) { const u32x4 w = *(const u32x4*)(a.U + (size_t)(R - 2) * 512 + c8); u0[0] = bf_lo(w.x); u0[1] = bf_hi(w.x); u0[2] = bf_lo(w.y); u0[3] = bf_hi(w.y); u0[4] = bf_lo(w.z); u0[5] = bf_hi(w.z); u0[6] = bf_lo(w.w); u0[7] = bf_hi(w.w); }
        else {
#pragma unroll
            for (int j = 0; j < 8; ++j) u0[j] = samp ? a.cache_conv[((size_t)b * 2 + t) * 512 + c8 + j] : 0.f; }
        { const u32x4 w = *(const u32x4*)(a.QK + (size_t)R * 2048 + 1536 + c8); bb[0] = bf_lo(w.x); bb[1] = bf_hi(w.x); bb[2] = bf_lo(w.y); bb[3] = bf_hi(w.y); bb[4] = bf_lo(w.z); bb[5] = bf_hi(w.z); bb[6] = bf_lo(w.w); bb[7] = bf_hi(w.w); }
        float o[8];
#pragma unroll
        for (int j = 0; j < 8; ++j) o[j] = bb[j] * (a.w_conv[c8 + j] * u0[j] + a.w_conv[512 + c8 + j] * u1[j] + a.w_conv[1024 + c8 + j] * u2[j]);
        u32x4 w; w.x = cvt_pk_bf16(o[0], o[1]); w.y = cvt_pk_bf16(o[2], o[3]); w.z = cvt_pk_bf16(o[4], o[5]); w.w = cvt_pk_bf16(o[6], o[7]);
        *(u32x4*)(a.MIX + (size_t)R * DM + 512 + c8) = w;
        if (t >= L - 2) { float* oc = a.out + (samp ? OUT_CS : OUT_CP) + ((size_t)b * 2 + (t - (L - 2))) * 512 + c8;
            *(f32x4*)oc = (f32x4){u2[0], u2[1], u2[2], u2[3]}; *(f32x4*)(oc + 4) = (f32x4){u2[4], u2[5], u2[6], u2[7]}; }
    }
}
__device__ __forceinline__ void final_norm(float* out, const bf16_t* XB, const float* ss3, const float* gfin, int gw, int NGW, int lane) {
    constexpr int NR = NBP * SEQ + MS;
    f32x4 g0 = ((const f32x4*)gfin)[2 * lane], g1 = ((const f32x4*)gfin)[2 * lane + 1], g2 = ((const f32x4*)gfin)[128 + 2 * lane], g3 = ((const f32x4*)gfin)[128 + 2 * lane + 1];
    for (int Rp = gw; Rp < NR; Rp += NGW) {
        int R; if (Rp < NBP * SEQ) { const int b = Rp >> 11, t = Rp & 2047; R = b * LP + NMETA + t; } else R = MP + (Rp - NBP * SEQ);
        const float rs = rsqrtf(ss3[R] * (1.0f / DM) + EPS);
        const u32x4 w0 = *((const u32x4*)(XB + (size_t)R * DM) + lane), w1 = *((const u32x4*)(XB + (size_t)R * DM) + 64 + lane);
        f32x4* yr = (f32x4*)(out + (size_t)Rp * DM);
        yr[2 * lane] = (f32x4){bf_lo(w0.x), bf_hi(w0.x), bf_lo(w0.y), bf_hi(w0.y)} * rs * g0; yr[2 * lane + 1] = (f32x4){bf_lo(w0.z), bf_hi(w0.z), bf_lo(w0.w), bf_hi(w0.w)} * rs * g1;
        yr[128 + 2 * lane] = (f32x4){bf_lo(w1.x), bf_hi(w1.x), bf_lo(w1.y), bf_hi(w1.y)} * rs * g2; yr[128 + 2 * lane + 1] = (f32x4){bf_lo(w1.z), bf_hi(w1.z), bf_lo(w1.w), bf_hi(w1.w)} * rs * g3;
    }
}

#define XB_TMO      128
#define XB_XCNT(j)  (256  + 64 * (j))
#define XB_XSUB(j)  (1280 + 64 * (j))
#define XB_XGEN(j)  (2304 + 64 * (j))
#define XB_TOP      3328
#define XB_TOPGEN   3392
#define XCD_BAR_WORDS 3456
#define XB_SPIN_CAP (1u << 18)

__device__ __forceinline__ unsigned xb_ld(unsigned* p)              { return __hip_atomic_load(p, __ATOMIC_RELAXED, __HIP_MEMORY_SCOPE_AGENT); }
__device__ __forceinline__ unsigned xb_add(unsigned* p, unsigned v) { return __hip_atomic_fetch_add(p, v, __ATOMIC_RELAXED, __HIP_MEMORY_SCOPE_AGENT); }
__device__ __forceinline__ unsigned xb_xcc_id() { return (unsigned)__builtin_amdgcn_s_getreg((3 << 11) | 20) & 0xFu; }
#define XB_SPIN(cond, bar) do { unsigned _sp = 0; while (cond) { __builtin_amdgcn_s_sleep(1); \
    if ((++_sp & 255u) == 0u) { if (xb_ld(&(bar)[XB_TMO])) break; if (_sp > XB_SPIN_CAP) { atomicAdd(&(bar)[XB_TMO], 1u); break; } } } } while (0)

struct XcdBarrier {
    unsigned* bar; unsigned x;
    volatile LAS unsigned* st;
};

__device__ __forceinline__ XcdBarrier xcd_barrier_post(unsigned* bar, volatile LAS unsigned* st) {
    XcdBarrier b; b.bar = bar; b.x = xb_xcc_id(); b.st = st;
    if (threadIdx.x == 0) (void)xb_add(&bar[XB_XCNT(b.x)], 1u);
    return b;
}
__device__ __forceinline__ void xcd_barrier_complete(unsigned* bar, unsigned x, unsigned& nloc, unsigned& nx) {
    const unsigned G = gridDim.x * gridDim.y * gridDim.z;
    unsigned sum, cnt, mine, sp = 0u;
    for (;;) {
        sum = 0u; cnt = 0u; mine = 0u;
#pragma unroll
        for (unsigned j = 0; j < 16; ++j) { const unsigned c = xb_ld(&bar[XB_XCNT(j)]); sum += c; cnt += (c > 0u) ? 1u : 0u; mine = (j == x) ? c : mine; }
        if (sum == G) break;
        __builtin_amdgcn_s_sleep(1);
        if ((++sp & 255u) == 0u) { if (xb_ld(&bar[XB_TMO])) break; if (sp > XB_SPIN_CAP) { atomicAdd(&bar[XB_TMO], 1u); break; } }
    }
    nloc = mine > 0u ? mine : 1u; nx = cnt > 0u ? cnt : 1u;
}

__device__ __forceinline__ void xcd_barrier(const XcdBarrier& b) {
    asm volatile("s_waitcnt vmcnt(0)" ::: "memory");
    __syncthreads();
    if (threadIdx.x == 0) {
        unsigned* bar = b.bar;
        __builtin_amdgcn_s_waitcnt(0);
        unsigned nloc = b.st[0], nx = b.st[1];
        if (nloc == 0u) { xcd_barrier_complete(bar, b.x, nloc, nx); b.st[0] = nloc; b.st[1] = nx; }
        const unsigned old = xb_add(&bar[XB_XSUB(b.x)], 1u);
        const unsigned gen = old / nloc;
        if (old + 1u == (gen + 1u) * nloc) {
            __builtin_amdgcn_fence(__ATOMIC_RELEASE, "agent");
            asm volatile("s_waitcnt vmcnt(0)" ::: "memory");
            const unsigned og = xb_add(&bar[XB_TOP], 1u);
            const unsigned tg = og / nx;
            if (og + 1u == (tg + 1u) * nx) xb_add(&bar[XB_TOPGEN], 1u);
            else XB_SPIN(xb_ld(&bar[XB_TOPGEN]) == tg, bar);
            __builtin_amdgcn_fence(__ATOMIC_ACQUIRE, "agent");
            xb_add(&bar[XB_XGEN(b.x)], 1u);
            asm volatile("s_waitcnt vmcnt(0)" ::: "memory");
        } else {
            XB_SPIN(xb_ld(&bar[XB_XGEN(b.x)]) == gen, bar);
            __builtin_amdgcn_fence(__ATOMIC_ACQUIRE, "agent");
            asm volatile("s_waitcnt vmcnt(0)" ::: "memory");
        }
    }
    __syncthreads();
}

struct Args { const float* in[19]; float* out; unsigned char* ws; int ph_lo, ph_hi; };
constexpr int LDS_BYTES = 147456;
__global__ void __launch_bounds__(512, 2) fwd_kernel(Args args) {
    extern __shared__ __attribute__((aligned(16))) unsigned char lds_raw[];
    LAS unsigned char* lds = (LAS unsigned char*)lds_raw;
    cg::grid_group grid = cg::this_grid();
    const int tid = threadIdx.x, lane = tid & 63, wave = __builtin_amdgcn_readfirstlane(tid >> 6);
    const int G = gridDim.x, bx = blockIdx.x;
    const int gw = bx * 8 + wave, NGW = G * 8;
    unsigned char* ws = args.ws;
    const float *x_prompt = args.in[0], *x_sample = args.in[1], *state_gla = args.in[2], *cache_conv = args.in[3], *meta = args.in[4], *norm_ffn1 = args.in[5], *w_up1 = args.in[6], *w_down1 = args.in[7],
                *norm_mix = args.in[8], *w_in = args.in[9], *w_a2 = args.in[10], *b_a = args.in[11], *g_head = args.in[12], *w_conv = args.in[13], *w_out = args.in[14], *norm_ffn2 = args.in[15],
                *w_up2 = args.in[16], *w_down2 = args.in[17], *norm_final = args.in[18];
    bf16_t* XB = (bf16_t*)(ws + WS_XB); bf16_t* ACT = (bf16_t*)(ws + WS_ACT); bf16_t* QK = (bf16_t*)(ws + WS_QK); bf16_t* U = (bf16_t*)(ws + WS_U); float* LA = (float*)(ws + WS_LA); bf16_t* MIX = (bf16_t*)(ws + WS_MIX);
    float* ss0 = (float*)(ws + WS_SS); float* ss1 = ss0 + SS_STRIDE / 4; float* ss2 = ss1 + SS_STRIDE / 4; float* ss3 = ss2 + SS_STRIDE / 4;
    const int lo = args.ph_lo, hi = args.ph_hi;
    volatile LAS unsigned* bst = (volatile LAS unsigned*)(lds + 140000);
    if (tid < 2) bst[tid] = 0u;
    __syncthreads();
    XcdBarrier xbar = xcd_barrier_post((unsigned*)(ws + WS_BAR), bst);
#define IN(k) (lo <= (k) && (k) < hi)
#define SEAM(k) do { if (IN(k) && IN((k) + 1)) { asm volatile("s_waitcnt vmcnt(0) lgkmcnt(0)" ::: "memory"); if (lo == 12345) grid.sync(); xcd_barrier(xbar); } } while (0)
    if (IN(0)) {
        P0Args pa{x_prompt, x_sample, meta, norm_ffn1, w_up1, w_down1, norm_mix, w_in, w_a2, w_out, norm_ffn2, w_up2, w_down2, ws};
        p0_prologue(pa, lds, gw, NGW, wave, lane);
    }
    SEAM(0);
    if (IN(1)) {
        pg8::Gemm g{XB, (const bf16_t*)(ws + WS_WUP1), M, NUP, DM}; pg8::StaticOrder S; S.init(M, NUP, G, bx);
        EpiUp E{ACT, ss0};
        pg8::gemm_phase<EpiUp, pg8::StaticOrder, true, true>(lds, g, S, E);
    }
    SEAM(1);
    if (IN(2)) {
        pg8::Gemm g{ACT, (const bf16_t*)(ws + WS_WDN1), M, DM, FF}; pg8::StaticOrder S; S.init(M, DM, G, bx);
        EpiRes<0> E{x_prompt, meta, x_sample, XB, args.out, ss1};
        pg8::gemm_phase<EpiRes<0>, pg8::StaticOrder, true, true>(lds, g, S, E);
    }
    SEAM(2);
    if (IN(3)) {
        pg8::Gemm g{XB, (const bf16_t*)(ws + WS_WIN), M, NIN, DM}; pg8::StaticOrder S; S.init(M, NIN, G, bx);
        EpiWin E{QK, U, LA, ss1, b_a};
        pg8::gemm_phase<EpiWin, pg8::StaticOrder, true, true>(lds, g, S, E);
    }
    SEAM(3);
    if (IN(4)) {
        GlaArgs ga{QK, LA, U, MIX, state_gla, cache_conv, g_head, w_conv, args.out, (bf16_t*)(ws + WS_DUMMY)};
        for (int unit = bx; unit < 256; unit += G) gla_unit(ga, lds, unit, tid, wave, lane);
        if (G == 256) { if (bx >= 128) conv_pass(ga, (bx - 128) * 512 + tid, 128 * 512); }
        else conv_pass(ga, bx * 512 + tid, G * 512);
    }
    SEAM(4);
    if (IN(5)) {
        pg8::Gemm g{MIX, (const bf16_t*)(ws + WS_WOUT), M, DM, DM}; pg8::StaticOrder S; S.init(M, DM, G, bx);
        EpiRes<1> E{x_prompt, meta, x_sample, XB, args.out, ss2};
        pg8::gemm_phase<EpiRes<1>, pg8::StaticOrder, true, true>(lds, g, S, E);
    }
    SEAM(5);
    if (IN(6)) {
        pg8::Gemm g{XB, (const bf16_t*)(ws + WS_WUP2), M, NUP, DM}; pg8::StaticOrder S; S.init(M, NUP, G, bx);
        EpiUp E{ACT, ss2};
        pg8::gemm_phase<EpiUp, pg8::StaticOrder, true, true>(lds, g, S, E);
    }
    SEAM(6);
    if (IN(7)) {
        pg8::Gemm g{ACT, (const bf16_t*)(ws + WS_WDN2), M, DM, FF}; pg8::StaticOrder S; S.init(M, DM, G, bx);
        EpiRes<2> E{x_prompt, meta, x_sample, XB, args.out, ss3};
        pg8::gemm_phase<EpiRes<2>, pg8::StaticOrder, true, true>(lds, g, S, E);
    }
    SEAM(7);
    if (IN(8)) final_norm(args.out, XB, ss3, norm_final, gw, NGW, lane);
#undef IN
#undef SEAM
}

#ifndef N_LAUNCH_MODE
#define N_LAUNCH_MODE 1
#endif
extern "C" void kernel_launch(void* const* d_in, const int* in_sizes, int n_in, void* d_out, int out_size, void* d_ws, size_t ws_size, hipStream_t stream) {
    static int grid = 0;
    if (grid == 0) {
        if (n_in != 19 || ws_size < WS_END || (size_t)out_size != OUT_END) { fprintf(stderr, "kernel_launch: unexpected sizes n_in %d ws %zu out %d\n", n_in, ws_size, out_size); grid = -1; return; }
        int dev = 0, cus = 0, per_cu = 0;
        hipGetDevice(&dev); hipDeviceGetAttribute(&cus, hipDeviceAttributeMultiprocessorCount, dev);
        if (hipFuncSetAttribute((const void*)fwd_kernel, hipFuncAttributeMaxDynamicSharedMemorySize, LDS_BYTES) != hipSuccess) { fprintf(stderr, "kernel_launch: hipFuncSetAttribute failed\n"); grid = -1; return; }
        if (hipOccupancyMaxActiveBlocksPerMultiprocessor(&per_cu, (const void*)fwd_kernel, 512, LDS_BYTES) != hipSuccess || per_cu < 1) { fprintf(stderr, "kernel_launch: occupancy query says %d\n", per_cu); per_cu = 1; }
        (void)hipGetLastError();
        grid = cus * per_cu;
    }
    if (grid < 0) return;
    Args a{};
    for (int i = 0; i < 19; ++i) a.in[i] = (const float*)d_in[i];
    a.out = (float*)d_out; a.ws = (unsigned char*)d_ws;
#if N_LAUNCH_MODE == 1
    if (hipMemsetAsync((char*)d_ws + WS_BAR, 0, BAR_BYTES, stream) != hipSuccess) { fprintf(stderr, "kernel_launch: memset of the barrier words failed\n"); return; }
    a.ph_lo = 0; a.ph_hi = 9;
    void* kargs[] = {&a};
    hipError_t e = hipLaunchCooperativeKernel((const void*)fwd_kernel, dim3(grid), dim3(512), kargs, LDS_BYTES, stream);
    if (e != hipSuccess) fprintf(stderr, "cooperative launch failed: %s (grid %d)\n", hipGetErrorString(e), grid);
#else
    for (int p = 0; p < 9; ++p) { a.ph_lo = p; a.ph_hi = p + 1; hipLaunchKernelGGL(fwd_kernel, dim3(grid), dim3(512), LDS_BYTES, stream, a); }
#endif
}
```
